# Optimizing an MI355X kernel written in HIP

```python
import math
import jax, jax.numpy as jnp
from jax import lax
import numpy as np

D_MODEL = 1024
BATCH = 8
SEQ = 2048
DEPTH = 4
DEC_BATCH = 128
DEC_SEQ = 1
PAST_LEN = 8192
PAGE_SIZE = 128

N_EVEN = (DEPTH + 1) // 2
N_ODD = DEPTH // 2

S5_WIDTH = D_MODEL // 2
S5_GROUP = 16
S5_GROUPS = S5_WIDTH // S5_GROUP
S5_STATE = 64
SWA_HEADS = 8
SWA_KV_HEADS = 2
SWA_HEAD_DIM = 64
SWA_WIDTH = SWA_HEADS * SWA_HEAD_DIM
WINDOW = 128
SWA_BLOCK = WINDOW
D_IN_EVEN = S5_WIDTH + SWA_WIDTH + 2 * SWA_KV_HEADS * SWA_HEAD_DIM
D_MIX_EVEN = S5_WIDTH + SWA_WIDTH
SSD_INNER = 2 * D_MODEL
SSD_HEAD_DIM = 64
SSD_HEADS = SSD_INNER // SSD_HEAD_DIM
SSD_GROUPS = 4
SSD_STATE = 128
SSD_CONV = 4
SSD_CHUNK = 128
SSD_CONV_DIM = SSD_INNER + 2 * SSD_GROUPS * SSD_STATE
D_IN_ODD = SSD_INNER + SSD_CONV_DIM + SSD_HEADS
PEER_HEADS = 8
PEER_KEYS = 128
PEER_EXPERTS = PEER_KEYS * PEER_KEYS
PEER_DK = 256
PEER_TOPK = 16
PEER_BLOCK = 256
DN_ALPHA = (2 * DEPTH) ** 0.25
DN_BETA = (8 * DEPTH) ** -0.25
LN_EPS = 1e-5
RMS_EPS = 1e-5
NEG_INF = -1e30

kernel_name = 'hybrid_s5_swa_ssd_peer_step'


def _layernorm(x, g, b):
    xf = x.astype(jnp.float32)
    mu = jnp.mean(xf, axis=-1, keepdims=True)
    var = jnp.mean(jnp.square(xf - mu), axis=-1, keepdims=True)
    y = (xf - mu) * lax.rsqrt(var + LN_EPS) * g.astype(jnp.float32) + b.astype(jnp.float32)
    return y.astype(x.dtype)


def _cmul(ar, ai, br, bi):
    return ar * br - ai * bi, ar * bi + ai * br


def _s5(u, h0_re, h0_im, lam_re, lam_im, log_dt, b_re, b_im, c_re, c_im, d_skip, w_glu):
    f32 = jnp.float32
    bsz, L, _ = u.shape
    uf = u.astype(f32)
    ug = uf.reshape(bsz, L, S5_GROUPS, S5_GROUP)
    lr, li = lam_re.astype(f32), lam_im.astype(f32)
    dt = jnp.exp(log_dt.astype(f32))[:, None]
    mag = jnp.exp(lr * dt)
    ab_re, ab_im = mag * jnp.cos(li * dt), mag * jnp.sin(li * dt)
    den = lr * lr + li * li
    nr, ni = ab_re - 1.0, ab_im
    coef_re = (nr * lr + ni * li) / den
    coef_im = (ni * lr - nr * li) / den
    bb_re, bb_im = _cmul(coef_re[..., None], coef_im[..., None], b_re.astype(f32), b_im.astype(f32))
    bu_re = jnp.einsum('blgc,gpc->blgp', ug, bb_re)
    bu_im = jnp.einsum('blgc,gpc->blgp', ug, bb_im)
    h0r, h0i = _cmul(ab_re, ab_im, h0_re.astype(f32), h0_im.astype(f32))
    bu_re = bu_re.at[:, 0].add(h0r)
    bu_im = bu_im.at[:, 0].add(h0i)
    a_re = jnp.broadcast_to(ab_re, bu_re.shape)
    a_im = jnp.broadcast_to(ab_im, bu_im.shape)

    def combine(e1, e2):
        a1r, a1i, b1r, b1i = e1
        a2r, a2i, b2r, b2i = e2
        ar, ai = _cmul(a2r, a2i, a1r, a1i)
        tr, ti = _cmul(a2r, a2i, b1r, b1i)
        return ar, ai, tr + b2r, ti + b2i

    _, _, h_re, h_im = lax.associative_scan(combine, (a_re, a_im, bu_re, bu_im), axis=1)
    y = (jnp.einsum('blgp,gcp->blgc', h_re, c_re.astype(f32))
         - jnp.einsum('blgp,gcp->blgc', h_im, c_im.astype(f32)))
    y = y.reshape(bsz, L, S5_WIDTH) + d_skip.astype(f32) * uf
    g = jax.nn.gelu(y)
    out = g * jax.nn.sigmoid(g @ w_glu.astype(f32))
    return out.astype(u.dtype), h_re[:, -1].astype(h0_re.dtype), h_im[:, -1].astype(h0_im.dtype)


def _alibi_slopes():
    return 2.0 ** (-8.0 * jnp.arange(1, SWA_HEADS + 1, dtype=jnp.float32) / SWA_HEADS)


def _swa(q, k, v, k_buf, v_buf, start, sinks):
    f32 = jnp.float32
    bsz, L = q.shape[0], q.shape[1]
    w = k_buf.shape[1]
    rep = SWA_HEADS // SWA_KV_HEADS
    k_cat = jnp.concatenate([k_buf.astype(k.dtype), k], axis=1)
    v_cat = jnp.concatenate([v_buf.astype(v.dtype), v], axis=1)
    new_k, new_v = k_cat[:, -w:], v_cat[:, -w:]
    nb = -(-L // SWA_BLOCK)
    lp = nb * SWA_BLOCK
    pad = lp - L
    qp = jnp.pad(q, ((0, 0), (0, pad), (0, 0), (0, 0)))
    kp = jnp.pad(k_cat, ((0, 0), (0, pad), (0, 0), (0, 0)))
    vp = jnp.pad(v_cat, ((0, 0), (0, pad), (0, 0), (0, 0)))
    qb = qp.reshape(bsz, nb, SWA_BLOCK, SWA_KV_HEADS, rep, SWA_HEAD_DIM).astype(f32)
    kb = kp.reshape(bsz, nb + 1, SWA_BLOCK, SWA_KV_HEADS, SWA_HEAD_DIM)
    vb = vp.reshape(bsz, nb + 1, SWA_BLOCK, SWA_KV_HEADS, SWA_HEAD_DIM)
    kb = jnp.concatenate([kb[:, :-1], kb[:, 1:]], axis=2).astype(f32)
    vb = jnp.concatenate([vb[:, :-1], vb[:, 1:]], axis=2).astype(f32)
    qpos = start + jnp.arange(lp, dtype=jnp.int32).reshape(nb, SWA_BLOCK)
    kpos_all = start - w + jnp.arange(w + lp, dtype=jnp.int32).reshape(nb + 1, SWA_BLOCK)
    kpos = jnp.concatenate([kpos_all[:-1], kpos_all[1:]], axis=1)
    dist = qpos[:, :, None] - kpos[:, None, :]
    valid = (dist >= 0) & (dist < WINDOW) & (kpos[:, None, :] >= 0)
    s = jnp.einsum('bnqgrd,bnkgd->bngrqk', qb, kb) * (SWA_HEAD_DIM ** -0.5)
    slopes = _alibi_slopes().reshape(SWA_KV_HEADS, rep)[None, None, :, :, None, None]
    s = s - slopes * dist[None, :, None, None].astype(f32)
    s = jnp.where(valid[None, :, None, None], s, NEG_INF)
    sink = sinks.astype(f32).reshape(SWA_KV_HEADS, rep)[None, None, :, :, None, None]
    m = jnp.maximum(jnp.max(s, axis=-1, keepdims=True), sink)
    p = jnp.exp(s - m)
    p = p / (jnp.sum(p, axis=-1, keepdims=True) + jnp.exp(sink - m))
    o = jnp.einsum('bngrqk,bnkgd->bnqgrd', p, vb)
    o = o.reshape(bsz, lp, SWA_WIDTH)[:, :L]
    return o.astype(q.dtype), new_k.astype(k_buf.dtype), new_v.astype(v_buf.dtype)


def _even_mixer(x, h_re, h_im, k_buf, v_buf, start, w_in, lam_re, lam_im, log_dt,
                b_re, b_im, c_re, c_im, s5_d, w_glu, sinks, w_out):
    bsz, L, _ = x.shape
    kv_w = SWA_KV_HEADS * SWA_HEAD_DIM
    proj = x @ w_in
    u_a, q, k, v = jnp.split(proj, [S5_WIDTH, S5_WIDTH + SWA_WIDTH, S5_WIDTH + SWA_WIDTH + kv_w], axis=-1)
    y_a, h_re, h_im = _s5(u_a, h_re, h_im, lam_re, lam_im, log_dt, b_re, b_im, c_re, c_im, s5_d, w_glu)
    q = q.reshape(bsz, L, SWA_HEADS, SWA_HEAD_DIM)
    k = k.reshape(bsz, L, SWA_KV_HEADS, SWA_HEAD_DIM)
    v = v.reshape(bsz, L, SWA_KV_HEADS, SWA_HEAD_DIM)
    y_b, k_buf, v_buf = _swa(q, k, v, k_buf, v_buf, start, sinks)
    out = jnp.concatenate([y_a, y_b], axis=-1) @ w_out
    return out, h_re, h_im, k_buf, v_buf


def _causal_conv(xbc, buf, w, b):
    L = xbc.shape[1]
    xp = jnp.concatenate([buf.astype(xbc.dtype), xbc], axis=1)
    y = xp[:, 0:L] * w[0]
    for tap in range(1, SSD_CONV):
        y = y + xp[:, tap:tap + L] * w[tap]
    return jax.nn.silu(y + b), xp[:, -(SSD_CONV - 1):].astype(buf.dtype)


def _ssd(x, dt, a, bm, cm, s0):
    bsz, L = x.shape[0], x.shape[1]
    r = SSD_HEADS // SSD_GROUPS
    q = min(SSD_CHUNK, L)
    nc = -(-L // q)
    pad = nc * q - L
    x = jnp.pad(x, ((0, 0), (0, pad), (0, 0), (0, 0))).reshape(bsz, nc, q, SSD_GROUPS, r, SSD_HEAD_DIM)
    dt = jnp.pad(dt, ((0, 0), (0, pad), (0, 0))).reshape(bsz, nc, q, SSD_GROUPS, r)
    bm = jnp.pad(bm, ((0, 0), (0, pad), (0, 0), (0, 0))).reshape(bsz, nc, q, SSD_GROUPS, SSD_STATE)
    cm = jnp.pad(cm, ((0, 0), (0, pad), (0, 0), (0, 0))).reshape(bsz, nc, q, SSD_GROUPS, SSD_STATE)
    acs = jnp.cumsum(dt * a.reshape(SSD_GROUPS, r), axis=2)
    seg = acs[:, :, :, None] - acs[:, :, None, :]
    causal = (jnp.arange(q)[:, None] >= jnp.arange(q)[None, :])[None, None, :, :, None, None]
    decay = jnp.where(causal, jnp.exp(jnp.where(causal, seg, 0.0)), 0.0)
    cb = jnp.einsum('bctgn,bcsgn->bctsg', cm, bm)
    dx = dt[..., None] * x
    y_diag = jnp.einsum('bctsgr,bcsgrp->bctgrp', cb[..., None] * decay, dx)
    dstate = jnp.exp(acs[:, :, -1:] - acs)
    states = jnp.einsum('bcsgn,bcsgrp->bcgrpn', bm, dstate[..., None] * dx)
    chunk_decay = jnp.exp(acs[:, :, -1])

    def step(carry, inp):
        dec, st = inp
        return dec[..., None, None] * carry + st, carry

    init = s0.reshape(bsz, SSD_GROUPS, r, SSD_HEAD_DIM, SSD_STATE)
    final, s_in = lax.scan(step, init, (jnp.moveaxis(chunk_decay, 1, 0), jnp.moveaxis(states, 1, 0)))
    s_in = jnp.moveaxis(s_in, 0, 1)
    y_off = jnp.einsum('bctgn,bcgrpn->bctgrp', cm, s_in) * jnp.exp(acs)[..., None]
    y = (y_diag + y_off).reshape(bsz, nc * q, SSD_HEADS, SSD_HEAD_DIM)[:, :L]
    return y, final.reshape(bsz, SSD_HEADS, SSD_HEAD_DIM, SSD_STATE)


def _odd_mixer(x, ssm_state, conv_buf, w_in, conv_w, conv_b, dt_bias, a_log, d_skip, norm_w, w_out):
    f32 = jnp.float32
    bsz, L, _ = x.shape
    proj = x @ w_in
    z, xbc, dt_raw = jnp.split(proj, [SSD_INNER, SSD_INNER + SSD_CONV_DIM], axis=-1)
    xbc, conv_buf = _causal_conv(xbc, conv_buf, conv_w, conv_b)
    xs, bm, cm = jnp.split(xbc.astype(f32), [SSD_INNER, SSD_INNER + SSD_GROUPS * SSD_STATE], axis=-1)
    xs = xs.reshape(bsz, L, SSD_HEADS, SSD_HEAD_DIM)
    bm = bm.reshape(bsz, L, SSD_GROUPS, SSD_STATE)
    cm = cm.reshape(bsz, L, SSD_GROUPS, SSD_STATE)
    dt = jax.nn.softplus(dt_raw.astype(f32) + dt_bias.astype(f32))
    a = -jnp.exp(a_log.astype(f32))
    y, new_state = _ssd(xs, dt, a, bm, cm, ssm_state.astype(f32))
    y = y + d_skip.astype(f32)[:, None] * xs
    y = y.reshape(bsz, L, SSD_INNER) * jax.nn.silu(z.astype(f32))
    y = y * lax.rsqrt(jnp.mean(jnp.square(y), axis=-1, keepdims=True) + RMS_EPS) * norm_w.astype(f32)
    out = y.astype(x.dtype) @ w_out
    return out, new_state.astype(ssm_state.dtype), conv_buf


def _peer(x, w_q, k1, k2, u_tab, v_tab):
    shape = x.shape
    xt = x.reshape(-1, D_MODEL)
    t = xt.shape[0]
    blk = min(PEER_BLOCK, t)
    nb = -(-t // blk)
    xb = jnp.pad(xt, ((0, nb * blk - t), (0, 0))).reshape(nb, blk, D_MODEL)
    half = PEER_DK // 2

    def block(xc):
        q = (xc @ w_q).reshape(blk, PEER_HEADS, PEER_DK)
        s1 = jnp.einsum('thd,hkd->thk', q[..., :half], k1).astype(jnp.float32)
        s2 = jnp.einsum('thd,hkd->thk', q[..., half:], k2).astype(jnp.float32)
        v1, i1 = lax.top_k(s1, PEER_TOPK)
        v2, i2 = lax.top_k(s2, PEER_TOPK)
        cand = (v1[..., :, None] + v2[..., None, :]).reshape(blk, PEER_HEADS, PEER_TOPK * PEER_TOPK)
        cidx = (i1[..., :, None] * PEER_KEYS + i2[..., None, :]).reshape(blk, PEER_HEADS, PEER_TOPK * PEER_TOPK)
        sv, pos = lax.top_k(cand, PEER_TOPK)
        idx = jnp.take_along_axis(cidx, pos, axis=-1)
        gates = jax.nn.softmax(sv, axis=-1)
        u_sel = jnp.take(u_tab, idx, axis=0)
        h = jnp.einsum('thkd,td->thk', u_sel, xc).astype(jnp.float32)
        act = (jax.nn.gelu(h) * gates).astype(xc.dtype)
        v_sel = jnp.take(v_tab, idx, axis=0)
        return jnp.einsum('thk,thkd->td', act, v_sel)

    y = lax.map(block, xb).reshape(nb * blk, D_MODEL)[:t]
    return y.reshape(shape).astype(x.dtype)


def _trunk(x, s5_re, s5_im, k_buf, v_buf, ssm, conv, start, even_w, odd_w, chan_w):
    (w_in_e, lam_re, lam_im, log_dt, b_re, b_im, c_re, c_im, s5_d, w_glu, sinks, w_out_e) = even_w
    (w_in_o, conv_w, conv_b, dt_bias, a_log, ssd_d, norm_w, w_out_o) = odd_w
    (ln1_g, ln1_b, ln2_g, ln2_b, w_q, k1, k2, u_tab, v_tab) = chan_w
    n_re, n_im, n_k, n_v, n_ssm, n_conv = [], [], [], [], [], []
    for layer in range(DEPTH):
        i = layer // 2
        if layer % 2 == 0:
            mix, hr, hi, kb, vb = _even_mixer(x, s5_re[i], s5_im[i], k_buf[i], v_buf[i], start, w_in_e[i],
                                              lam_re[i], lam_im[i], log_dt[i], b_re[i], b_im[i], c_re[i],
                                              c_im[i], s5_d[i], w_glu[i], sinks[i], w_out_e[i])
            n_re.append(hr)
            n_im.append(hi)
            n_k.append(kb)
            n_v.append(vb)
        else:
            mix, st, cb = _odd_mixer(x, ssm[i], conv[i], w_in_o[i], conv_w[i], conv_b[i], dt_bias[i],
                                     a_log[i], ssd_d[i], norm_w[i], w_out_o[i])
            n_ssm.append(st)
            n_conv.append(cb)
        x = _layernorm(DN_ALPHA * x + mix, ln1_g[layer], ln1_b[layer])
        x = _layernorm(DN_ALPHA * x + _peer(x, w_q[layer], k1[layer], k2[layer], u_tab[layer], v_tab[layer]),
                       ln2_g[layer], ln2_b[layer])
    return (x, jnp.stack(n_re), jnp.stack(n_im), jnp.stack(n_k), jnp.stack(n_v),
            jnp.stack(n_ssm), jnp.stack(n_conv))


def setup_inputs(seed: int = 0) -> dict:
    key = jax.random.key(seed)
    ks = iter(jax.random.split(key, 48))
    f32 = jnp.float32

    def nrm(shape, scale):
        return jax.random.normal(next(ks), shape, f32) * scale

    w_buf = min(WINDOW, PAST_LEN)
    inp = {}
    inp['x_prompt'] = nrm((BATCH, SEQ, D_MODEL), 1.0)
    inp['x_sample'] = nrm((DEC_BATCH, DEC_SEQ, D_MODEL), 1.0)
    inp['state_s5_re'] = nrm((N_EVEN, DEC_BATCH, S5_GROUPS, S5_STATE), 0.3)
    inp['state_s5_im'] = nrm((N_EVEN, DEC_BATCH, S5_GROUPS, S5_STATE), 0.3)
    inp['cache_swa_k'] = nrm((N_EVEN, DEC_BATCH, w_buf, SWA_KV_HEADS, SWA_HEAD_DIM), 1.0)
    inp['cache_swa_v'] = nrm((N_EVEN, DEC_BATCH, w_buf, SWA_KV_HEADS, SWA_HEAD_DIM), 1.0)
    inp['state_ssd'] = nrm((N_ODD, DEC_BATCH, SSD_HEADS, SSD_HEAD_DIM, SSD_STATE), 0.1)
    inp['state_conv'] = nrm((N_ODD, DEC_BATCH, SSD_CONV - 1, SSD_CONV_DIM), 1.0)
    inp['w_in_even'] = nrm((N_EVEN, D_MODEL, D_IN_EVEN), D_MODEL ** -0.5)
    inp['s5_lambda_re'] = -0.5 + nrm((N_EVEN, S5_GROUPS, S5_STATE), 0.01)
    inp['s5_lambda_im'] = (math.pi * jnp.arange(S5_STATE, dtype=f32))[None, None, :] + nrm((N_EVEN, S5_GROUPS, S5_STATE), 0.01)
    inp['s5_log_dt'] = jax.random.uniform(next(ks), (N_EVEN, S5_GROUPS), f32, math.log(1e-3), math.log(1e-1))
    inp['s5_b_re'] = nrm((N_EVEN, S5_GROUPS, S5_STATE, S5_GROUP), (2 * S5_GROUP) ** -0.5)
    inp['s5_b_im'] = nrm((N_EVEN, S5_GROUPS, S5_STATE, S5_GROUP), (2 * S5_GROUP) ** -0.5)
    inp['s5_c_re'] = nrm((N_EVEN, S5_GROUPS, S5_GROUP, S5_STATE), (2 * S5_STATE) ** -0.5)
    inp['s5_c_im'] = nrm((N_EVEN, S5_GROUPS, S5_GROUP, S5_STATE), (2 * S5_STATE) ** -0.5)
    inp['s5_d'] = nrm((N_EVEN, S5_WIDTH), 1.0)
    inp['s5_w_glu'] = nrm((N_EVEN, S5_WIDTH, S5_WIDTH), S5_WIDTH ** -0.5)
    inp['swa_sinks'] = nrm((N_EVEN, SWA_HEADS), 0.5)
    inp['w_out_even'] = nrm((N_EVEN, D_MIX_EVEN, D_MODEL), DN_BETA * D_MIX_EVEN ** -0.5)
    inp['w_in_odd'] = nrm((N_ODD, D_MODEL, D_IN_ODD), D_MODEL ** -0.5)
    inp['ssd_conv_w'] = nrm((N_ODD, SSD_CONV, SSD_CONV_DIM), SSD_CONV ** -0.5)
    inp['ssd_conv_b'] = nrm((N_ODD, SSD_CONV_DIM), 0.01)
    dt0 = jnp.exp(jax.random.uniform(next(ks), (N_ODD, SSD_HEADS), f32, math.log(1e-3), math.log(1e-1)))
    inp['ssd_dt_bias'] = dt0 + jnp.log(-jnp.expm1(-dt0))
    inp['ssd_a_log'] = jnp.log(jax.random.uniform(next(ks), (N_ODD, SSD_HEADS), f32, 1.0, 16.0))
    inp['ssd_d'] = 1.0 + nrm((N_ODD, SSD_HEADS), 0.1)
    inp['ssd_norm_w'] = 1.0 + nrm((N_ODD, SSD_INNER), 0.01)
    inp['w_out_odd'] = nrm((N_ODD, SSD_INNER, D_MODEL), DN_BETA * SSD_INNER ** -0.5)
    inp['ln1_g'] = 1.0 + nrm((DEPTH, D_MODEL), 0.01)
    inp['ln1_b'] = nrm((DEPTH, D_MODEL), 0.01)
    inp['ln2_g'] = 1.0 + nrm((DEPTH, D_MODEL), 0.01)
    inp['ln2_b'] = nrm((DEPTH, D_MODEL), 0.01)
    inp['peer_w_q'] = nrm((DEPTH, D_MODEL, PEER_HEADS * PEER_DK), D_MODEL ** -0.5)
    inp['peer_k1'] = nrm((DEPTH, PEER_HEADS, PEER_KEYS, PEER_DK // 2), (PEER_DK // 2) ** -0.5)
    inp['peer_k2'] = nrm((DEPTH, PEER_HEADS, PEER_KEYS, PEER_DK // 2), (PEER_DK // 2) ** -0.5)
    inp['peer_u'] = nrm((DEPTH, PEER_EXPERTS, D_MODEL), D_MODEL ** -0.5)
    inp['peer_v'] = nrm((DEPTH, PEER_EXPERTS, D_MODEL), DN_BETA * PEER_HEADS ** -0.5)
    return inp


def reference(x_prompt, x_sample, state_s5_re, state_s5_im, cache_swa_k, cache_swa_v, state_ssd, state_conv,
              w_in_even, s5_lambda_re, s5_lambda_im, s5_log_dt, s5_b_re, s5_b_im, s5_c_re, s5_c_im, s5_d,
              s5_w_glu, swa_sinks, w_out_even,
              w_in_odd, ssd_conv_w, ssd_conv_b, ssd_dt_bias, ssd_a_log, ssd_d, ssd_norm_w, w_out_odd,
              ln1_g, ln1_b, ln2_g, ln2_b, peer_w_q, peer_k1, peer_k2, peer_u, peer_v):
    even_w = (w_in_even, s5_lambda_re, s5_lambda_im, s5_log_dt, s5_b_re, s5_b_im, s5_c_re, s5_c_im,
              s5_d, s5_w_glu, swa_sinks, w_out_even)
    odd_w = (w_in_odd, ssd_conv_w, ssd_conv_b, ssd_dt_bias, ssd_a_log, ssd_d, ssd_norm_w, w_out_odd)
    chan_w = (ln1_g, ln1_b, ln2_g, ln2_b, peer_w_q, peer_k1, peer_k2, peer_u, peer_v)
    bp = x_prompt.shape[0]
    dty = x_prompt.dtype
    z_s5 = jnp.zeros((N_EVEN, bp, S5_GROUPS, S5_STATE), dty)
    z_kv = jnp.zeros((N_EVEN, bp, WINDOW, SWA_KV_HEADS, SWA_HEAD_DIM), dty)
    z_ssm = jnp.zeros((N_ODD, bp, SSD_HEADS, SSD_HEAD_DIM, SSD_STATE), dty)
    z_conv = jnp.zeros((N_ODD, bp, SSD_CONV - 1, SSD_CONV_DIM), dty)
    y_prompt, p_s5_re, p_s5_im, p_swa_k, p_swa_v, p_ssd, p_conv = _trunk(
        x_prompt, z_s5, z_s5, z_kv, z_kv, z_ssm, z_conv, 0, even_w, odd_w, chan_w)
    y_sample, s_s5_re, s_s5_im, s_swa_k, s_swa_v, s_ssd, s_conv = _trunk(
        x_sample, state_s5_re, state_s5_im, cache_swa_k, cache_swa_v, state_ssd, state_conv, PAST_LEN,
        even_w, odd_w, chan_w)
    return (y_prompt, y_sample, p_s5_re, p_s5_im, p_swa_k, p_swa_v, p_ssd, p_conv,
            s_s5_re, s_s5_im, s_swa_k, s_swa_v, s_ssd, s_conv)
```

```cpp
#include <hip/hip_runtime.h>
#include <hip/hip_cooperative_groups.h>
#include <cstdio>
#include <cstdint>
namespace cg = cooperative_groups;

typedef unsigned short u16;
typedef __attribute__((ext_vector_type(8))) short bf16x8;
typedef __attribute__((ext_vector_type(4))) short bf16x4;
typedef __attribute__((ext_vector_type(4))) float f32x4;
typedef __attribute__((ext_vector_type(2))) __bf16 bf2;
typedef __attribute__((ext_vector_type(4))) unsigned u32x4;

#define DI __device__ __forceinline__

constexpr int T = 16512, TP = 16384, NSMP = 128;
constexpr float ALPHA = 1.681792830507429f;

constexpr size_t O_Y = 0;
constexpr size_t O_PS5RE = (size_t)T * 1024;
constexpr size_t O_PS5IM = O_PS5RE + 32768;
constexpr size_t O_PSWAK = O_PS5IM + 32768;
constexpr size_t O_PSWAV = O_PSWAK + 262144;
constexpr size_t O_PSSD = O_PSWAV + 262144;
constexpr size_t O_PCONV = O_PSSD + 4194304;
constexpr size_t O_SS5RE = O_PCONV + 147456;
constexpr size_t O_SS5IM = O_SS5RE + 524288;
constexpr size_t O_SSWAK = O_SS5IM + 524288;
constexpr size_t O_SSWAV = O_SSWAK + 4194304;
constexpr size_t O_SSSD = O_SSWAV + 4194304;
constexpr size_t O_SCONV = O_SSSD + 67108864;

constexpr size_t WS_BAR = 0;
constexpr size_t WS_X = 16384;
constexpr size_t WS_XB = WS_X + (size_t)T * 1024 * 4;
constexpr size_t WS_SSQ = WS_XB + (size_t)T * 1024 * 2;
constexpr size_t WS_IDX = WS_SSQ + (size_t)T * 32 * 4;
constexpr size_t WS_GATE = WS_IDX + (size_t)T * 128 * 4;
constexpr size_t WS_DT = WS_GATE + (size_t)T * 128 * 4;
constexpr size_t WS_DTR = WS_DT + (size_t)T * 32 * 4;
constexpr size_t WS_DEC = WS_DTR + (size_t)T * 32 * 4;
constexpr size_t WS_AB = WS_DEC + 16384;
constexpr size_t WS_BBR = WS_AB + 32768;
constexpr size_t WS_BBI = WS_BBR + 262144;
constexpr size_t WS_CT = WS_BBI + 262144;
constexpr size_t WS_E = WS_CT + 262144;
constexpr size_t WS_WINE = WS_E + 4194304;
constexpr size_t WS_WGLU = WS_WINE + (size_t)2 * 1280 * 1024 * 2;
constexpr size_t WS_WOUTE = WS_WGLU + (size_t)2 * 512 * 512 * 2;
constexpr size_t WS_WINO = WS_WOUTE + (size_t)2 * 1024 * 1024 * 2;
constexpr size_t WS_WOUTO = WS_WINO + (size_t)2 * 5248 * 1024 * 2;
constexpr size_t WS_WQ = WS_WOUTO + (size_t)2 * 1024 * 2048 * 2;
constexpr size_t WS_K1 = WS_WQ + (size_t)4 * 2048 * 1024 * 2;
constexpr size_t WS_K2 = WS_K1 + (size_t)4 * 8 * 128 * 128 * 2;
constexpr size_t WS_UB = WS_K2 + (size_t)4 * 8 * 128 * 128 * 2;
constexpr size_t WS_VB = WS_UB + (size_t)16384 * 1024 * 2;
constexpr size_t WS_ACT = WS_VB + (size_t)16384 * 1024 * 2;
constexpr size_t WS_Z = WS_ACT;
constexpr size_t WS_XBCR = WS_Z + (size_t)T * 2048 * 2;
constexpr size_t WS_R = WS_XBCR;
constexpr size_t WS_XS = WS_XBCR + (size_t)T * 3072 * 2;
constexpr size_t WS_BM = WS_XS + (size_t)T * 2048 * 2;
constexpr size_t WS_CM = WS_BM + (size_t)T * 512 * 2;
constexpr size_t WS_XST = WS_CM + (size_t)T * 512 * 2;
constexpr size_t WS_BMT = WS_XST + (size_t)TP * 2048 * 2;
constexpr size_t WS_ST = WS_BMT + (size_t)TP * 512 * 2;
constexpr size_t WS_YG = WS_ST + (size_t)8 * 16 * 32 * 64 * 128 * 4;
constexpr size_t WS_END = WS_YG + (size_t)T * 2048 * 2;
constexpr size_t WS_PE = WS_Z;
constexpr size_t WS_G = WS_XS;
constexpr size_t WS_CAT = WS_YG;

struct Params {
  const float* in[37];
  float* out;
  char* ws;
};

DI u16 f2bf(float f) { unsigned u = __float_as_uint(f); u += 0x7fffu + ((u >> 16) & 1u); return (u16)(u >> 16); }
DI float bf2f(u16 h) { return __uint_as_float(((unsigned)h) << 16); }
DI unsigned pack2(float a, float b) { return (unsigned)f2bf(a) | ((unsigned)f2bf(b) << 16); }
DI float lo2f(unsigned u) { return __uint_as_float(u << 16); }
DI float hi2f(unsigned u) { return __uint_as_float(u & 0xffff0000u); }
DI float gelu_tanh(float x) {
  float u = 0.7978845608028654f * (x + 0.044715f * x * x * x);
  float e = __expf(2.f * u);
  float th = 1.f - 2.f / (e + 1.f);
  return 0.5f * x * (1.f + th);
}
DI float sigmoidf_(float x) { return 1.f / (1.f + __expf(-x)); }
DI float siluf_(float x) { return x / (1.f + __expf(-x)); }
DI f32x4 mfma16(bf16x8 a, bf16x8 b, f32x4 c) { return __builtin_amdgcn_mfma_f32_16x16x32_bf16(a, b, c, 0, 0, 0); }
DI void wave_lds_sync() { __builtin_amdgcn_fence(__ATOMIC_ACQ_REL, "workgroup"); __builtin_amdgcn_wave_barrier(); }
DI void st_bf4(u16* dst, float a, float b, float c, float d) { uint2 v; v.x = pack2(a, b); v.y = pack2(c, d); *(uint2*)dst = v; }
DI bf16x8 mk8(uint4 v) { return __builtin_bit_cast(bf16x8, v); }

#define XB_TMO      128
#define XB_XCNT(j)  (256  + 64 * (j))
#define XB_XSUB(j)  (1280 + 64 * (j))
#define XB_XGEN(j)  (2304 + 64 * (j))
#define XB_TOP      3328
#define XB_TOPGEN   3392
#define XCD_BAR_WORDS 3456
#define XB_SPIN_CAP (1u << 22)
#define LAS __attribute__((address_space(3)))
DI unsigned xb_ld(unsigned* p) { return __hip_atomic_load(p, __ATOMIC_RELAXED, __HIP_MEMORY_SCOPE_AGENT); }
DI unsigned xb_add(unsigned* p, unsigned v) { return __hip_atomic_fetch_add(p, v, __ATOMIC_RELAXED, __HIP_MEMORY_SCOPE_AGENT); }
DI unsigned xb_xcc_id() { return (unsigned)__builtin_amdgcn_s_getreg((3 << 11) | 20) & 0xFu; }
#define XB_SPIN(cond, bar) do { unsigned _sp = 0; while (cond) { __builtin_amdgcn_s_sleep(1); \
    if ((++_sp & 255u) == 0u) { if (xb_ld(&(bar)[XB_TMO])) break; if (_sp > XB_SPIN_CAP) { atomicAdd(&(bar)[XB_TMO], 1u); break; } } } } while (0)
struct XcdBarrier { unsigned* bar; unsigned x; volatile LAS unsigned* st; };
DI XcdBarrier xcd_barrier_post(unsigned* bar, volatile LAS unsigned* st) {
  XcdBarrier b; b.bar = bar; b.x = xb_xcc_id(); b.st = st;
  if (threadIdx.x == 0) (void)xb_add(&bar[XB_XCNT(b.x)], 1u);
  return b;
}
DI void xcd_barrier_complete(unsigned* bar, unsigned x, unsigned& nloc, unsigned& nx) {
  const unsigned G = gridDim.x;
  unsigned sum, cnt, mine, sp = 0u;
  for (;;) {
    sum = 0u; cnt = 0u; mine = 0u;
#pragma unroll
    for (unsigned j = 0; j < 16; ++j) { const unsigned c = xb_ld(&bar[XB_XCNT(j)]); sum += c; cnt += (c > 0u) ? 1u : 0u; mine = (j == x) ? c : mine; }
    if (sum == G) break;
    __builtin_amdgcn_s_sleep(1);
    if ((++sp & 255u) == 0u) { if (xb_ld(&bar[XB_TMO])) break; if (sp > XB_SPIN_CAP) { atomicAdd(&bar[XB_TMO], 1u); break; } }
  }
  nloc = mine > 0u ? mine : 1u; nx = cnt > 0u ? cnt : 1u;
}
DI void xcd_barrier(const XcdBarrier& b) {
  asm volatile("s_waitcnt vmcnt(0)" ::: "memory");
  __syncthreads();
  if (threadIdx.x == 0) {
    unsigned* bar = b.bar;
    __builtin_amdgcn_s_waitcnt(0);
    unsigned nloc = b.st[0], nx = b.st[1];
    if (nloc == 0u) { xcd_barrier_complete(bar, b.x, nloc, nx); b.st[0] = nloc; b.st[1] = nx; }
    const unsigned old = xb_add(&bar[XB_XSUB(b.x)], 1u);
    const unsigned gen = old / nloc;
    if (old + 1u == (gen + 1u) * nloc) {
      __builtin_amdgcn_fence(__ATOMIC_RELEASE, "agent");
      asm volatile("s_waitcnt vmcnt(0)" ::: "memory");
      const unsigned og = xb_add(&bar[XB_TOP], 1u);
      const unsigned tg = og / nx;
      if (og + 1u == (tg + 1u) * nx) xb_add(&bar[XB_TOPGEN], 1u);
      else XB_SPIN(xb_ld(&bar[XB_TOPGEN]) == tg, bar);
      __builtin_amdgcn_fence(__ATOMIC_ACQUIRE, "agent");
      xb_add(&bar[XB_XGEN(b.x)], 1u);
      asm volatile("s_waitcnt vmcnt(0)" ::: "memory");
    } else {
      XB_SPIN(xb_ld(&bar[XB_XGEN(b.x)]) == gen, bar);
      __builtin_amdgcn_fence(__ATOMIC_ACQUIRE, "agent");
      asm volatile("s_waitcnt vmcnt(0)" ::: "memory");
    }
  }
  __syncthreads();
}

DI int otid() { int t = threadIdx.x; asm volatile("" : "+v"(t)); return t; }
DI int obid() { int t = blockIdx.x; asm volatile("" : "+s"(t)); return t; }

constexpr int LDSS = 72;
constexpr int GEMM_SMEM = 2 * 128 * LDSS * 2;
template <bool SYNC_EPI = false, class Epi>
DI void gemm_tile(const u16* __restrict__ A, int lda, const u16* __restrict__ Bt, int ldb, int K, int m0, int n0,
                  u16* sm, Epi&& epi) {
  u16* sA = sm; u16* sB = sm + 128 * LDSS;
  const int tid = otid(), lane = tid & 63, wid = tid >> 6, wr = wid >> 1, wc = wid & 1, fr = lane & 15, fq = lane >> 4;
  const int lr = tid >> 3, lc = (tid & 7) * 8;
  const u16* ga = A + (size_t)(m0 + lr) * lda + lc;
  const u16* gb = Bt + (size_t)(n0 + lr) * ldb + lc;
  u32x4 ra[4], rb[4];
#pragma unroll
  for (int i = 0; i < 4; ++i) { ra[i] = *(const u32x4*)(ga + (size_t)(32 * i) * lda); rb[i] = *(const u32x4*)(gb + (size_t)(32 * i) * ldb); }
  f32x4 acc[4][4];
#pragma unroll
  for (int m = 0; m < 4; ++m)
#pragma unroll
    for (int n = 0; n < 4; ++n) acc[m][n] = f32x4{0.f, 0.f, 0.f, 0.f};
  for (int k0 = 0; k0 < K; k0 += 64) {
    __syncthreads();
#pragma unroll
    for (int i = 0; i < 4; ++i) {
      *(u32x4*)(sA + (lr + 32 * i) * LDSS + lc) = ra[i];
      *(u32x4*)(sB + (lr + 32 * i) * LDSS + lc) = rb[i];
    }
    __syncthreads();
    if (k0 + 64 < K) {
#pragma unroll
      for (int i = 0; i < 4; ++i) {
        ra[i] = *(const u32x4*)(ga + (size_t)(32 * i) * lda + k0 + 64);
        rb[i] = *(const u32x4*)(gb + (size_t)(32 * i) * ldb + k0 + 64);
      }
    }
#pragma unroll
    for (int ks = 0; ks < 2; ++ks) {
      bf16x8 af[4], bfr[4];
#pragma unroll
      for (int m = 0; m < 4; ++m) af[m] = *(const bf16x8*)(sA + (wr * 64 + m * 16 + fr) * LDSS + ks * 32 + fq * 8);
#pragma unroll
      for (int n = 0; n < 4; ++n) bfr[n] = *(const bf16x8*)(sB + (wc * 64 + n * 16 + fr) * LDSS + ks * 32 + fq * 8);
#pragma unroll
      for (int m = 0; m < 4; ++m)
#pragma unroll
        for (int n = 0; n < 4; ++n) acc[m][n] = mfma16(bfr[n], af[m], acc[m][n]);
    }
  }
  if (SYNC_EPI) __syncthreads();
#pragma unroll
  for (int m = 0; m < 4; ++m)
#pragma unroll
    for (int n = 0; n < 4; ++n) epi(m0 + wr * 64 + m * 16 + fr, n0 + wc * 64 + n * 16 + fq * 4, acc[m][n], m, n);
}

struct WJob { const float* src; u16* dst; int K, N, Npad; const float* scale; };
DI WJob get_wjob(const Params& p, int j) {
  WJob w; w.scale = nullptr;
  if (j < 2) { w.src = p.in[8] + (size_t)j * 1024 * 1280; w.dst = (u16*)(p.ws + WS_WINE) + (size_t)j * 1280 * 1024; w.K = 1024; w.N = 1280; w.Npad = 1280; }
  else if (j < 4) { int i = j - 2; w.src = p.in[17] + (size_t)i * 512 * 512; w.dst = (u16*)(p.ws + WS_WGLU) + (size_t)i * 512 * 512; w.K = 512; w.N = 512; w.Npad = 512; }
  else if (j < 6) { int i = j - 4; w.src = p.in[19] + (size_t)i * 1024 * 1024; w.dst = (u16*)(p.ws + WS_WOUTE) + (size_t)i * 1024 * 1024; w.K = 1024; w.N = 1024; w.Npad = 1024; }
  else if (j < 8) { int i = j - 6; w.src = p.in[20] + (size_t)i * 1024 * 5152; w.dst = (u16*)(p.ws + WS_WINO) + (size_t)i * 5248 * 1024; w.K = 1024; w.N = 5152; w.Npad = 5248; }
  else if (j < 10) { int i = j - 8; w.src = p.in[27] + (size_t)i * 2048 * 1024; w.dst = (u16*)(p.ws + WS_WOUTO) + (size_t)i * 1024 * 2048; w.K = 2048; w.N = 1024; w.Npad = 1024; w.scale = p.in[26] + (size_t)i * 2048; }
  else { int i = j - 10; w.src = p.in[32] + (size_t)i * 1024 * 2048; w.dst = (u16*)(p.ws + WS_WQ) + (size_t)i * 2048 * 1024; w.K = 1024; w.N = 2048; w.Npad = 2048; }
  return w;
}

DI void phase_prep(const Params& p, char* smem) {
  const int tid = otid();
  const size_t gtid = (size_t)obid() * 256 + tid, gsz = (size_t)gridDim.x * 256;
  {
    float* X = (float*)(p.ws + WS_X); u16* Xb = (u16*)(p.ws + WS_XB);
    for (size_t i = gtid; i < (size_t)T * 256; i += gsz) {
      size_t e = i * 4;
      const float* src = e < (size_t)TP * 1024 ? p.in[0] + e : p.in[1] + (e - (size_t)TP * 1024);
      float4 v = *(const float4*)src;
      *(float4*)(X + e) = v;
      st_bf4(Xb + e, v.x, v.y, v.z, v.w);
    }
  }
  {
    float* tile = (float*)smem;
    for (int j = 0; j < 14; ++j) {
      WJob w = get_wjob(p, j);
      const int tk = w.K / 64, tn = w.Npad / 64;
      for (int t = obid(); t < tk * tn; t += gridDim.x) {
        const int k0 = (t % tk) * 64, n0 = (t / tk) * 64;
        const int c = tid & 63, r4 = tid >> 6;
        __syncthreads();
#pragma unroll
        for (int i = 0; i < 16; ++i) {
          int r = r4 + 4 * i;
          float v = 0.f;
          if (n0 + c < w.N) { v = w.src[(size_t)(k0 + r) * w.N + n0 + c]; if (w.scale) v *= w.scale[k0 + r]; }
          tile[r * 65 + c] = v;
        }
        __syncthreads();
#pragma unroll
        for (int i = 0; i < 16; ++i) {
          int nn = r4 + 4 * i;
          w.dst[(size_t)(n0 + nn) * w.K + k0 + c] = f2bf(tile[c * 65 + nn]);
        }
      }
    }
  }
  {
    u16* k1 = (u16*)(p.ws + WS_K1); u16* k2 = (u16*)(p.ws + WS_K2);
    for (size_t i = gtid; i < (size_t)131072; i += gsz) {
      float4 a = *(const float4*)(p.in[33] + i * 4), b = *(const float4*)(p.in[34] + i * 4);
      st_bf4(k1 + i * 4, a.x, a.y, a.z, a.w);
      st_bf4(k2 + i * 4, b.x, b.y, b.z, b.w);
    }
  }
  {
    float* AB = (float*)(p.ws + WS_AB); float* BBR = (float*)(p.ws + WS_BBR); float* BBI = (float*)(p.ws + WS_BBI);
    u16* CT = (u16*)(p.ws + WS_CT);
    for (size_t i = gtid; i < 4096; i += gsz) {
      int ig = (int)(i >> 6), pp = (int)(i & 63);
      float dt = expf(p.in[11][ig]);
      float lr = p.in[9][i], li = p.in[10][i];
      float mag = expf(lr * dt);
      float abr = mag * cosf(li * dt), abi = mag * sinf(li * dt);
      float den = lr * lr + li * li;
      float nr = abr - 1.f, ni = abi;
      float cr = (nr * lr + ni * li) / den, ci = (ni * lr - nr * li) / den;
      AB[i * 2] = abr; AB[i * 2 + 1] = abi;
      for (int c = 0; c < 16; ++c) {
        float br = p.in[12][i * 16 + c], bi = p.in[13][i * 16 + c];
        BBR[i * 16 + c] = cr * br - ci * bi;
        BBI[i * 16 + c] = cr * bi + ci * br;
        CT[((size_t)ig * 16 + c) * 128 + pp] = f2bf(p.in[14][((size_t)ig * 16 + c) * 64 + pp]);
        CT[((size_t)ig * 16 + c) * 128 + 64 + pp] = f2bf(-p.in[15][((size_t)ig * 16 + c) * 64 + pp]);
      }
    }
  }
  {
    for (size_t i = gtid; i < (size_t)2 * 128 * 127 * 32; i += gsz) {
      size_t q = i & 31, row = (i >> 5) % 127, is = (i >> 5) / 127;
      size_t so = (is * 128 + row + 1) * 128 + q * 4, dn = (is * 128 + row) * 128 + q * 4;
      *(float4*)(p.out + O_SSWAK + dn) = *(const float4*)(p.in[4] + so);
      *(float4*)(p.out + O_SSWAV + dn) = *(const float4*)(p.in[5] + so);
    }
    for (size_t i = gtid; i < (size_t)2 * 128 * 2 * 768; i += gsz) {
      size_t q = i % 768, row = (i / 768) & 1, is = i / 1536;
      *(float4*)(p.out + O_SCONV + (is * 3 + row) * 3072 + q * 4) = *(const float4*)(p.in[7] + (is * 3 + row + 1) * 3072 + q * 4);
    }
  }
}

DI void convert_tables(const Params& p, int layer) {
  const size_t gtid = (size_t)obid() * 256 + otid(), gsz = (size_t)gridDim.x * 256;
  const float* u = p.in[35] + (size_t)layer * 16384 * 1024;
  const float* v = p.in[36] + (size_t)layer * 16384 * 1024;
  u16* ub = (u16*)(p.ws + WS_UB); u16* vb = (u16*)(p.ws + WS_VB);
  for (size_t i = gtid; i < (size_t)16384 * 1024 / 8; i += gsz) {
    float4 a = *(const float4*)(u + i * 8), b = *(const float4*)(u + i * 8 + 4);
    uint4 o; o.x = pack2(a.x, a.y); o.y = pack2(a.z, a.w); o.z = pack2(b.x, b.y); o.w = pack2(b.z, b.w);
    *(uint4*)(ub + i * 8) = o;
    a = *(const float4*)(v + i * 8); b = *(const float4*)(v + i * 8 + 4);
    o.x = pack2(a.x, a.y); o.y = pack2(a.z, a.w); o.z = pack2(b.x, b.y); o.w = pack2(b.z, b.w);
    *(uint4*)(vb + i * 8) = o;
  }
}

DI void phase_e_inproj(const Params& p, int i, char* smem) {
  const u16* Xb = (const u16*)(p.ws + WS_XB);
  const u16* W = (const u16*)(p.ws + WS_WINE) + (size_t)i * 1280 * 1024;
  u16* PE = (u16*)(p.ws + WS_PE);
  float* out = p.out;
  for (int t = obid(); t < 129 * 10; t += gridDim.x) {
    const int mt = t / 10, nt = t % 10;
    gemm_tile(Xb, 1024, W, 1024, 1024, mt * 128, nt * 128, (u16*)smem, [&](int tok, int n, f32x4 v, int, int) {
      st_bf4(PE + (size_t)tok * 1280 + n, v[0], v[1], v[2], v[3]);
      if (n >= 1024) {
        const int isv = n >= 1152; const int col = n - (isv ? 1152 : 1024);
        if (tok >= TP) {
          size_t o = (isv ? O_SSWAV : O_SSWAK) + (((size_t)i * 128 + (tok - TP)) * 128 + 127) * 128 + col;
          *(float4*)(out + o) = float4{v[0], v[1], v[2], v[3]};
        } else {
          const int b = tok >> 11, l = tok & 2047;
          if (l >= 1920) {
            size_t o = (isv ? O_PSWAV : O_PSWAK) + (((size_t)i * 8 + b) * 128 + (l - 1920)) * 128 + col;
            *(float4*)(out + o) = float4{v[0], v[1], v[2], v[3]};
          }
        }
      }
    });
  }
}

DI void s5_pass1(const Params& p, int i, char* smem) {
  const int lane = otid() & 63, wid = otid() >> 6;
  float* Us = (float*)smem + wid * 1024;
  const u16* PE = (const u16*)(p.ws + WS_PE);
  const float* AB = (const float*)(p.ws + WS_AB); const float* BBR = (const float*)(p.ws + WS_BBR); const float* BBI = (const float*)(p.ws + WS_BBI);
  float2* E = (float2*)(p.ws + WS_E);
  for (int it = obid() * 4 + wid; it < 8192; it += gridDim.x * 4) {
    const int g = it & 31, chunk = (it >> 5) & 31, b = it >> 10;
    const size_t pi = ((size_t)i * 32 + g) * 64 + lane;
    float bbr[16], bbi[16];
#pragma unroll
    for (int c = 0; c < 4; ++c) {
      float4 a = *(const float4*)(BBR + pi * 16 + c * 4), bb = *(const float4*)(BBI + pi * 16 + c * 4);
      bbr[c * 4] = a.x; bbr[c * 4 + 1] = a.y; bbr[c * 4 + 2] = a.z; bbr[c * 4 + 3] = a.w;
      bbi[c * 4] = bb.x; bbi[c * 4 + 1] = bb.y; bbi[c * 4 + 2] = bb.z; bbi[c * 4 + 3] = bb.w;
    }
    const float abr = AB[pi * 2], abi = AB[pi * 2 + 1];
    const size_t t0 = (size_t)b * 2048 + chunk * 64;
    wave_lds_sync();
    {
      const u16* row = PE + (t0 + lane) * 1280 + g * 16;
      uint4 a = *(const uint4*)row, c = *(const uint4*)(row + 8);
      float* d = Us + lane * 16;
      *(float4*)(d) = float4{lo2f(a.x), hi2f(a.x), lo2f(a.y), hi2f(a.y)};
      *(float4*)(d + 4) = float4{lo2f(a.z), hi2f(a.z), lo2f(a.w), hi2f(a.w)};
      *(float4*)(d + 8) = float4{lo2f(c.x), hi2f(c.x), lo2f(c.y), hi2f(c.y)};
      *(float4*)(d + 12) = float4{lo2f(c.z), hi2f(c.z), lo2f(c.w), hi2f(c.w)};
    }
    wave_lds_sync();
    float hr = 0.f, hi = 0.f;
    for (int t = 0; t < 64; ++t) {
      float bur = 0.f, bui = 0.f;
#pragma unroll
      for (int c = 0; c < 4; ++c) {
        float4 u = *(const float4*)(Us + t * 16 + c * 4);
        bur += bbr[c * 4] * u.x + bbr[c * 4 + 1] * u.y + bbr[c * 4 + 2] * u.z + bbr[c * 4 + 3] * u.w;
        bui += bbi[c * 4] * u.x + bbi[c * 4 + 1] * u.y + bbi[c * 4 + 2] * u.z + bbi[c * 4 + 3] * u.w;
      }
      float nr = abr * hr - abi * hi + bur, ni = abr * hi + abi * hr + bui;
      hr = nr; hi = ni;
    }
    E[(size_t)it * 64 + lane] = float2{hr, hi};
  }
}

DI void s5_pass3(const Params& p, int i, char* smem) {
  const int lane = otid() & 63, wid = otid() >> 6, fr = lane & 15, fq = lane >> 4;
  float* Us = (float*)smem + wid * 1024;
  u16* Hs = (u16*)(smem + 16384) + wid * (16 * 136);
  const u16* PE = (const u16*)(p.ws + WS_PE);
  const float* AB = (const float*)(p.ws + WS_AB); const float* BBR = (const float*)(p.ws + WS_BBR); const float* BBI = (const float*)(p.ws + WS_BBI);
  const u16* CT = (const u16*)(p.ws + WS_CT);
  const float2* E = (const float2*)(p.ws + WS_E);
  u16* G = (u16*)(p.ws + WS_G);
  for (int it = obid() * 4 + wid; it < 8192 + 4096; it += gridDim.x * 4) {
    const bool smp = it >= 8192;
    int g, chunk, b, count; size_t t0;
    if (!smp) { g = it & 31; chunk = (it >> 5) & 31; b = it >> 10; count = 64; t0 = (size_t)b * 2048 + chunk * 64; }
    else { int r = it - 8192; g = r & 31; b = r >> 5; chunk = 0; count = 1; t0 = (size_t)TP + b; }
    const size_t pi = ((size_t)i * 32 + g) * 64 + lane;
    float bbr[16], bbi[16];
#pragma unroll
    for (int c = 0; c < 4; ++c) {
      float4 a = *(const float4*)(BBR + pi * 16 + c * 4), bb = *(const float4*)(BBI + pi * 16 + c * 4);
      bbr[c * 4] = a.x; bbr[c * 4 + 1] = a.y; bbr[c * 4 + 2] = a.z; bbr[c * 4 + 3] = a.w;
      bbi[c * 4] = bb.x; bbi[c * 4 + 1] = bb.y; bbi[c * 4 + 2] = bb.z; bbi[c * 4 + 3] = bb.w;
    }
    const float abr = AB[pi * 2], abi = AB[pi * 2 + 1];
    float hr = 0.f, hi = 0.f;
    if (!smp) {
      float qr = abr, qi = abi;
#pragma unroll
      for (int s = 0; s < 6; ++s) { float nr = qr * qr - qi * qi, ni = 2.f * qr * qi; qr = nr; qi = ni; }
      for (int j = 0; j < chunk; ++j) {
        float2 e = E[(((size_t)b * 32 + j) * 32 + g) * 64 + lane];
        float nr = qr * hr - qi * hi + e.x, ni = qr * hi + qi * hr + e.y;
        hr = nr; hi = ni;
      }
    } else {
      const size_t so = (((size_t)i * 128 + b) * 32 + g) * 64 + lane;
      float h0r = p.in[2][so], h0i = p.in[3][so];
      hr = h0r; hi = h0i;
    }
    bf16x8 ctf[4];
#pragma unroll
    for (int ks = 0; ks < 4; ++ks) ctf[ks] = *(const bf16x8*)(CT + (((size_t)i * 32 + g) * 16 + fr) * 128 + ks * 32 + fq * 8);
    const float4 d4 = *(const float4*)(p.in[16] + (size_t)i * 512 + g * 16 + fq * 4);
    wave_lds_sync();
    {
      float* d = Us + lane * 16;
      if (lane < count) {
        const u16* row = PE + (t0 + lane) * 1280 + g * 16;
        uint4 a = *(const uint4*)row, c = *(const uint4*)(row + 8);
        *(float4*)(d) = float4{lo2f(a.x), hi2f(a.x), lo2f(a.y), hi2f(a.y)};
        *(float4*)(d + 4) = float4{lo2f(a.z), hi2f(a.z), lo2f(a.w), hi2f(a.w)};
        *(float4*)(d + 8) = float4{lo2f(c.x), hi2f(c.x), lo2f(c.y), hi2f(c.y)};
        *(float4*)(d + 12) = float4{lo2f(c.z), hi2f(c.z), lo2f(c.w), hi2f(c.w)};
      } else {
        *(float4*)(d) = float4{0, 0, 0, 0}; *(float4*)(d + 4) = float4{0, 0, 0, 0};
        *(float4*)(d + 8) = float4{0, 0, 0, 0}; *(float4*)(d + 12) = float4{0, 0, 0, 0};
      }
    }
    wave_lds_sync();
    const int nsub = (count + 15) >> 4;
    for (int sub = 0; sub < nsub; ++sub) {
      for (int tt = 0; tt < 16; ++tt) {
        const int t = sub * 16 + tt;
        float wr_ = 0.f, wi_ = 0.f;
        if (t < count) {
          float bur = 0.f, bui = 0.f;
#pragma unroll
          for (int c = 0; c < 4; ++c) {
            float4 u = *(const float4*)(Us + t * 16 + c * 4);
            bur += bbr[c * 4] * u.x + bbr[c * 4 + 1] * u.y + bbr[c * 4 + 2] * u.z + bbr[c * 4 + 3] * u.w;
            bui += bbi[c * 4] * u.x + bbi[c * 4 + 1] * u.y + bbi[c * 4 + 2] * u.z + bbi[c * 4 + 3] * u.w;
          }
          float nr = abr * hr - abi * hi + bur, ni = abr * hi + abi * hr + bui;
          hr = nr; hi = ni; wr_ = hr; wi_ = hi;
        }
        Hs[tt * 136 + lane] = f2bf(wr_);
        Hs[tt * 136 + 64 + lane] = f2bf(wi_);
      }
      wave_lds_sync();
      f32x4 acc = f32x4{0.f, 0.f, 0.f, 0.f};
#pragma unroll
      for (int ks = 0; ks < 4; ++ks) {
        bf16x8 hf = *(const bf16x8*)(Hs + fr * 136 + ks * 32 + fq * 8);
        acc = mfma16(ctf[ks], hf, acc);
      }
      const int t = sub * 16 + fr;
      if (t < count) {
        float4 u4 = *(const float4*)(Us + t * 16 + fq * 4);
        float y0 = gelu_tanh(acc[0] + d4.x * u4.x), y1 = gelu_tanh(acc[1] + d4.y * u4.y);
        float y2 = gelu_tanh(acc[2] + d4.z * u4.z), y3 = gelu_tanh(acc[3] + d4.w * u4.w);
        st_bf4(G + (t0 + t) * 512 + g * 16 + fq * 4, y0, y1, y2, y3);
      }
      wave_lds_sync();
    }
    if (smp) {
      const size_t so = (((size_t)i * 128 + b) * 32 + g) * 64 + lane;
      p.out[O_SS5RE + so] = hr; p.out[O_SS5IM + so] = hi;
    } else if (chunk == 31) {
      const size_t so = (((size_t)i * 8 + b) * 32 + g) * 64 + lane;
      p.out[O_PS5RE + so] = hr; p.out[O_PS5IM + so] = hi;
    }
  }
}

constexpr int VTS = 264;
DI void swa_prompt(const Params& p, int i, char* smem) {
  const int tid = otid(), lane = tid & 63, w = tid >> 6, fr = lane & 15, fq = lane >> 4;
  u16* Vt = (u16*)smem;
  const u16* PE = (const u16*)(p.ws + WS_PE);
  u16* CAT = (u16*)(p.ws + WS_CAT);
  for (int it = obid(); it < 1024; it += gridDim.x) {
    const int qb = it & 15, h = (it >> 4) & 7, b = it >> 7, kvh = h >> 2;
    const float slope = exp2f(-(float)(h + 1));
    const float sink = p.in[18][i * 8 + h];
    __syncthreads();
    {
      const int l = qb * 128 - 128 + tid;
      u32x4 v[8];
      if (l >= 0) {
        const u16* row = PE + ((size_t)b * 2048 + l) * 1280 + 1152 + kvh * 64;
#pragma unroll
        for (int c = 0; c < 8; ++c) v[c] = *(const u32x4*)(row + c * 8);
      } else {
#pragma unroll
        for (int c = 0; c < 8; ++c) v[c] = u32x4{0, 0, 0, 0};
      }
#pragma unroll
      for (int c = 0; c < 8; ++c) {
#pragma unroll
        for (int q = 0; q < 4; ++q) {
          Vt[(c * 8 + 2 * q) * VTS + tid] = (u16)(v[c][q] & 0xffff);
          Vt[(c * 8 + 2 * q + 1) * VTS + tid] = (u16)(v[c][q] >> 16);
        }
      }
    }
    __syncthreads();
#pragma unroll 1
    for (int qt = 0; qt < 2; ++qt) {
      const int rq = 32 * w + 16 * qt, kt0 = 2 * w + qt;
      const size_t qtok = (size_t)b * 2048 + qb * 128 + rq + fr;
      bf16x8 qf[2];
#pragma unroll
      for (int ks = 0; ks < 2; ++ks) qf[ks] = *(const bf16x8*)(PE + qtok * 1280 + 512 + h * 64 + ks * 32 + fq * 8);
      f32x4 s[9];
#pragma unroll
      for (int c = 0; c < 9; ++c) {
        s[c] = f32x4{0.f, 0.f, 0.f, 0.f};
        const int l = qb * 128 - 128 + (kt0 + c) * 16 + fr;
#pragma unroll
        for (int ks = 0; ks < 2; ++ks) {
          bf16x8 kf = bf16x8{0, 0, 0, 0, 0, 0, 0, 0};
          if (l >= 0) kf = *(const bf16x8*)(PE + ((size_t)b * 2048 + l) * 1280 + 1024 + kvh * 64 + ks * 32 + fq * 8);
          s[c] = mfma16(kf, qf[ks], s[c]);
        }
      }
      const int r = rq + fr;
      float mx = -1e30f;
#pragma unroll
      for (int c = 0; c < 9; ++c)
#pragma unroll
        for (int j = 0; j < 4; ++j) {
          const int kl = (kt0 + c) * 16 + fq * 4 + j;
          const int dist = 128 + r - kl;
          const bool valid = dist >= 0 && dist < 128 && (qb * 128 - 128 + kl) >= 0;
          float sc = valid ? s[c][j] * 0.125f - slope * (float)dist : -1e30f;
          s[c][j] = sc; mx = fmaxf(mx, sc);
        }
      mx = fmaxf(mx, __shfl_xor(mx, 16)); mx = fmaxf(mx, __shfl_xor(mx, 32));
      const float m = fmaxf(mx, sink);
      float sum = 0.f;
#pragma unroll
      for (int c = 0; c < 9; ++c)
#pragma unroll
        for (int j = 0; j < 4; ++j) { float e = __expf(s[c][j] - m); s[c][j] = e; sum += e; }
      sum += __shfl_xor(sum, 16); sum += __shfl_xor(sum, 32);
      const float inv = 1.f / (sum + __expf(sink - m));
      f32x4 o[4];
#pragma unroll
      for (int d = 0; d < 4; ++d) o[d] = f32x4{0.f, 0.f, 0.f, 0.f};
#pragma unroll
      for (int pr = 0; pr < 5; ++pr) {
        const int ia = 2 * pr, ib = 2 * pr + 1;
        uint4 pk;
        pk.x = pack2(s[ia][0], s[ia][1]); pk.y = pack2(s[ia][2], s[ia][3]);
        if (ib < 9) { pk.z = pack2(s[ib < 9 ? ib : 8][0], s[ib < 9 ? ib : 8][1]); pk.w = pack2(s[ib < 9 ? ib : 8][2], s[ib < 9 ? ib : 8][3]); }
        else { pk.z = 0; pk.w = 0; }
        const bf16x8 pf = mk8(pk);
        int ta = kt0 + ia, tb = kt0 + ib; if (tb > 15) tb = 15;
#pragma unroll
        for (int d = 0; d < 4; ++d) {
          const u16* vr = Vt + (d * 16 + fr) * VTS;
          uint2 va = *(const uint2*)(vr + ta * 16 + fq * 4), vb = *(const uint2*)(vr + tb * 16 + fq * 4);
          o[d] = mfma16(mk8(uint4{va.x, va.y, vb.x, vb.y}), pf, o[d]);
        }
      }
#pragma unroll
      for (int d = 0; d < 4; ++d)
        st_bf4(CAT + qtok * 1024 + 512 + h * 64 + d * 16 + fq * 4, o[d][0] * inv, o[d][1] * inv, o[d][2] * inv, o[d][3] * inv);
    }
  }
}

DI void swa_sample(const Params& p, int i, char* smem) {
  const int lane = otid() & 63, wid = otid() >> 6;
  float* Ps = (float*)smem + wid * 128;
  const u16* PE = (const u16*)(p.ws + WS_PE);
  u16* CAT = (u16*)(p.ws + WS_CAT);
  for (int it = obid() * 4 + wid; it < 1024; it += gridDim.x * 4) {
    const int h = it & 7, s = it >> 3, kvh = h >> 2;
    const float slope = exp2f(-(float)(h + 1));
    const float sink = p.in[18][i * 8 + h];
    const size_t tok = (size_t)TP + s;
    const u16* qrow = PE + tok * 1280 + 512 + h * 64;
    const u16* knew = PE + tok * 1280 + 1024 + kvh * 64;
    const u16* vnew = PE + tok * 1280 + 1152 + kvh * 64;
    const float* kc = p.in[4] + (((size_t)i * 128 + s) * 128) * 128 + kvh * 64;
    const float* vc = p.in[5] + (((size_t)i * 128 + s) * 128) * 128 + kvh * 64;
    float sc[2];
#pragma unroll
    for (int hh = 0; hh < 2; ++hh) {
      const int id = lane + hh * 64;
      float dot = 0.f;
      if (id < 127) {
        const float* kr = kc + (size_t)(id + 1) * 128;
        for (int d = 0; d < 64; d += 4) {
          float4 kv = *(const float4*)(kr + d);
          uint2 qq = *(const uint2*)(qrow + d);
          dot += kv.x * lo2f(qq.x) + kv.y * hi2f(qq.x) + kv.z * lo2f(qq.y) + kv.w * hi2f(qq.y);
        }
      } else {
        for (int d = 0; d < 64; d += 4) {
          uint2 kk = *(const uint2*)(knew + d);
          uint2 qq = *(const uint2*)(qrow + d);
          dot += lo2f(kk.x) * lo2f(qq.x) + hi2f(kk.x) * hi2f(qq.x) + lo2f(kk.y) * lo2f(qq.y) + hi2f(kk.y) * hi2f(qq.y);
        }
      }
      sc[hh] = dot * 0.125f - slope * (float)(127 - id);
    }
    float mx = fmaxf(sc[0], sc[1]);
#pragma unroll
    for (int o = 32; o > 0; o >>= 1) mx = fmaxf(mx, __shfl_xor(mx, o));
    const float m = fmaxf(mx, sink);
    float e0 = __expf(sc[0] - m), e1 = __expf(sc[1] - m);
    float sum = e0 + e1;
#pragma unroll
    for (int o = 32; o > 0; o >>= 1) sum += __shfl_xor(sum, o);
    const float inv = 1.f / (sum + __expf(sink - m));
    wave_lds_sync();
    Ps[lane] = e0 * inv; Ps[lane + 64] = e1 * inv;
    wave_lds_sync();
    float o = 0.f;
    for (int id = 0; id < 127; ++id) o += Ps[id] * vc[(size_t)(id + 1) * 128 + lane];
    o += Ps[127] * bf2f(vnew[lane]);
    CAT[tok * 1024 + 512 + h * 64 + lane] = f2bf(o);
  }
}

DI void phase_e_glu(const Params& p, int i, char* smem) {
  const u16* G = (const u16*)(p.ws + WS_G);
  const u16* W = (const u16*)(p.ws + WS_WGLU) + (size_t)i * 512 * 512;
  u16* CAT = (u16*)(p.ws + WS_CAT);
  for (int t = obid(); t < 129 * 4; t += gridDim.x) {
    const int mt = t / 4, nt = t % 4;
    gemm_tile(G, 512, W, 512, 512, mt * 128, nt * 128, (u16*)smem, [&](int tok, int n, f32x4 v, int, int) {
      uint2 gg = *(const uint2*)(G + (size_t)tok * 512 + n);
      float g0 = lo2f(gg.x), g1 = hi2f(gg.x), g2 = lo2f(gg.y), g3 = hi2f(gg.y);
      st_bf4(CAT + (size_t)tok * 1024 + n, g0 * sigmoidf_(v[0]), g1 * sigmoidf_(v[1]), g2 * sigmoidf_(v[2]), g3 * sigmoidf_(v[3]));
    });
  }
}

DI void phase_outproj(const Params& p, const u16* A, int K, const u16* W, bool use_ssq, char* smem) {
  const float* X = (const float*)(p.ws + WS_X);
  float* R = (float*)(p.ws + WS_R);
  const float* SSQ = (const float*)(p.ws + WS_SSQ);
  for (int t = obid(); t < 129 * 8; t += gridDim.x) {
    const int mt = t / 8, nt = t % 8;
    gemm_tile(A, K, W, K, K, mt * 128, nt * 128, (u16*)smem, [&](int tok, int n, f32x4 v, int, int) {
      float sc = 1.f;
      if (use_ssq) {
        float ssum = 0.f;
#pragma unroll
        for (int q = 0; q < 8; ++q) { float4 s4 = *(const float4*)(SSQ + (size_t)tok * 32 + q * 4); ssum += (s4.x + s4.y) + (s4.z + s4.w); }
        sc = rsqrtf(ssum * (1.f / 2048.f) + 1e-5f);
      }
      float4 x = *(const float4*)(X + (size_t)tok * 1024 + n);
      *(float4*)(R + (size_t)tok * 1024 + n) = float4{ALPHA * x.x + sc * v[0], ALPHA * x.y + sc * v[1], ALPHA * x.z + sc * v[2], ALPHA * x.w + sc * v[3]};
    });
  }
}

DI void phase_ln1(const Params& p, int layer) {
  const int lane = otid() & 63, wid = otid() >> 6;
  const float* R = (const float*)(p.ws + WS_R);
  float* X = (float*)(p.ws + WS_X); u16* Xb = (u16*)(p.ws + WS_XB);
  const float* gam = p.in[28] + (size_t)layer * 1024; const float* bet = p.in[29] + (size_t)layer * 1024;
  for (int tok = obid() * 4 + wid; tok < T; tok += gridDim.x * 4) {
    float4 v[4];
    float s = 0.f;
#pragma unroll
    for (int c = 0; c < 4; ++c) { v[c] = *(const float4*)(R + (size_t)tok * 1024 + c * 256 + lane * 4); s += v[c].x + v[c].y + v[c].z + v[c].w; }
#pragma unroll
    for (int o = 32; o > 0; o >>= 1) s += __shfl_xor(s, o);
    const float mu = s * (1.f / 1024.f);
    float q = 0.f;
#pragma unroll
    for (int c = 0; c < 4; ++c) { float a = v[c].x - mu, b = v[c].y - mu, cc = v[c].z - mu, d = v[c].w - mu; q += a * a + b * b + cc * cc + d * d; }
#pragma unroll
    for (int o = 32; o > 0; o >>= 1) q += __shfl_xor(q, o);
    const float rstd = rsqrtf(q * (1.f / 1024.f) + 1e-5f);
#pragma unroll
    for (int c = 0; c < 4; ++c) {
      const int col = c * 256 + lane * 4;
      float4 g = *(const float4*)(gam + col), bb = *(const float4*)(bet + col);
      float4 o = float4{(v[c].x - mu) * rstd * g.x + bb.x, (v[c].y - mu) * rstd * g.y + bb.y, (v[c].z - mu) * rstd * g.z + bb.z, (v[c].w - mu) * rstd * g.w + bb.w};
      *(float4*)(X + (size_t)tok * 1024 + col) = o;
      st_bf4(Xb + (size_t)tok * 1024 + col, o.x, o.y, o.z, o.w);
    }
  }
}

DI unsigned sortkey(float f) { unsigned u = __float_as_uint(f); return u ^ ((u >> 31) ? 0xffffffffu : 0x80000000u); }
DI float unsortkey(unsigned k) { unsigned u = (k & 0x80000000u) ? (k ^ 0x80000000u) : ~k; return __uint_as_float(u); }

constexpr int QSS = 136;
constexpr int PEER_LST_OFF = GEMM_SMEM;
DI void phase_peer1(const Params& p, int layer, char* smem) {
  const int tid = otid(), lane = tid & 63, w = tid >> 6, fr = lane & 15, fq = lane >> 4;
  const u16* Xb = (const u16*)(p.ws + WS_XB);
  const u16* WQ = (const u16*)(p.ws + WS_WQ) + (size_t)layer * 2048 * 1024;
  u16* Qs = (u16*)smem;
  unsigned* Ls = (unsigned*)(smem + PEER_LST_OFF);
  int* IDX = (int*)(p.ws + WS_IDX); float* GATE = (float*)(p.ws + WS_GATE);
  for (int it = obid(); it < 129 * 8; it += gridDim.x) {
    const int mt = it >> 3, h = it & 7;
#pragma unroll 1
    for (int half = 0; half < 2; ++half) {
      const int m0 = mt * 128, n0 = h * 256 + half * 128;
      gemm_tile<true>(Xb, 1024, WQ, 1024, 1024, m0, n0, (u16*)smem, [&](int tok, int n, f32x4 v, int, int) {
        st_bf4(Qs + (tok - m0) * QSS + (n - n0), v[0], v[1], v[2], v[3]);
      });
      __syncthreads();
      const u16* KT = (const u16*)(p.ws + (half ? WS_K2 : WS_K1)) + ((size_t)layer * 8 + h) * 128 * 128;
#pragma unroll 1
      for (int tt = 0; tt < 2; ++tt) {
        bf16x8 qf[4];
#pragma unroll
        for (int ks = 0; ks < 4; ++ks) qf[ks] = *(const bf16x8*)(Qs + (32 * w + tt * 16 + fr) * QSS + ks * 32 + fq * 8);
        unsigned k[32];
#pragma unroll
        for (int kt = 0; kt < 8; ++kt) {
          f32x4 sc = f32x4{0.f, 0.f, 0.f, 0.f};
#pragma unroll
          for (int ks = 0; ks < 4; ++ks) {
            bf16x8 kf = *(const bf16x8*)(KT + (size_t)(kt * 16 + fr) * 128 + ks * 32 + fq * 8);
            sc = mfma16(kf, qf[ks], sc);
          }
#pragma unroll
          for (int j = 0; j < 4; ++j) k[kt * 4 + j] = (sortkey(sc[j]) & ~127u) | (unsigned)(kt * 16 + fq * 4 + j);
        }
        unsigned* lp = Ls + (32 * w + tt * 16 + fr) * 32 + half * 16;
#pragma unroll 1
        for (int r = 0; r < 16; ++r) {
          unsigned m = k[0];
#pragma unroll
          for (int q = 1; q < 32; ++q) m = m > k[q] ? m : k[q];
          unsigned o = __shfl_xor(m, 16); m = m > o ? m : o;
          o = __shfl_xor(m, 32); m = m > o ? m : o;
          if (fq == 0) lp[r] = m;
#pragma unroll
          for (int q = 0; q < 32; ++q) k[q] = (k[q] == m) ? 0u : k[q];
        }
      }
    }
    wave_lds_sync();
#pragma unroll 1
    for (int tt = 0; tt < 2; ++tt) {
      const unsigned* lp = Ls + (32 * w + tt * 16 + fr) * 32;
      float sum[21]; unsigned key[21]; int eidx[21];
      unsigned l2[16];
#pragma unroll
      for (int j = 0; j < 16; ++j) l2[j] = lp[16 + j];
#pragma unroll
      for (int m = 0; m < 4; ++m) {
        const unsigned a = lp[4 * m + fq];
        const float av = unsortkey(a & ~127u); const int ai = (int)(a & 127u);
        const int J = m == 0 ? 16 : m == 1 ? 3 : 1;
        const int base = m == 0 ? 0 : m == 1 ? 16 : m == 2 ? 19 : 20;
#pragma unroll
        for (int j = 0; j < J; ++j) {
          const unsigned b = l2[j];
          const float sj = av + unsortkey(b & ~127u);
          sum[base + j] = sj;
          key[base + j] = (sortkey(sj) & ~127u) | (unsigned)(fq << 5) | (unsigned)(base + j);
          eidx[base + j] = ai * 128 + (int)(b & 127u);
        }
      }
      const size_t tok = (size_t)mt * 128 + 32 * w + tt * 16 + fr;
      int* ip = IDX + tok * 128 + h * 16; float* gp = GATE + tok * 128 + h * 16;
      float mxs = 0.f;
#pragma unroll 1
      for (int r = 0; r < 16; ++r) {
        unsigned m = key[0];
#pragma unroll
        for (int c = 1; c < 21; ++c) m = m > key[c] ? m : key[c];
        unsigned o = __shfl_xor(m, 16); m = m > o ? m : o;
        o = __shfl_xor(m, 32); m = m > o ? m : o;
        float ws_ = -3.0e38f; int wi = 0;
#pragma unroll
        for (int c = 0; c < 21; ++c) { const bool hit = key[c] == m; ws_ = hit ? sum[c] : ws_; wi = hit ? eidx[c] : wi; key[c] = hit ? 0u : key[c]; }
        ws_ = fmaxf(ws_, __shfl_xor(ws_, 16)); ws_ = fmaxf(ws_, __shfl_xor(ws_, 32));
        int oi = __shfl_xor(wi, 16); wi = wi > oi ? wi : oi;
        oi = __shfl_xor(wi, 32); wi = wi > oi ? wi : oi;
        if (r == 0) mxs = ws_;
        if (fq == 0) { ip[r] = wi; gp[r] = __expf(ws_ - mxs); }
      }
    }
    wave_lds_sync();
  }
}

DI float dot2bf(unsigned a, unsigned b, float c) { return __builtin_amdgcn_fdot2_f32_bf16(__builtin_bit_cast(bf2, a), __builtin_bit_cast(bf2, b), c, false); }
DI void phase_peer3(const Params& p, int layer) {
  const int lane = otid() & 63, wid = otid() >> 6;
  const u16* UB = (const u16*)(p.ws + WS_UB); const u16* VB = (const u16*)(p.ws + WS_VB);
  const int* IDX = (const int*)(p.ws + WS_IDX); const float* GATE = (const float*)(p.ws + WS_GATE);
  float* X = (float*)(p.ws + WS_X); u16* Xb = (u16*)(p.ws + WS_XB);
  const float* gam = p.in[30] + (size_t)layer * 1024; const float* bet = p.in[31] + (size_t)layer * 1024;
  const bool last = layer == 3;
  for (int tok = obid() * 4 + wid; tok < T; tok += gridDim.x * 4) {
    float xa[16];
    {
      const float* xr = X + (size_t)tok * 1024;
      float4 a = *(const float4*)(xr + lane * 8), b = *(const float4*)(xr + lane * 8 + 4);
      float4 c = *(const float4*)(xr + 512 + lane * 8), d = *(const float4*)(xr + 512 + lane * 8 + 4);
      xa[0] = a.x; xa[1] = a.y; xa[2] = a.z; xa[3] = a.w; xa[4] = b.x; xa[5] = b.y; xa[6] = b.z; xa[7] = b.w;
      xa[8] = c.x; xa[9] = c.y; xa[10] = c.z; xa[11] = c.w; xa[12] = d.x; xa[13] = d.y; xa[14] = d.z; xa[15] = d.w;
    }
    unsigned xp[8];
#pragma unroll
    for (int q = 0; q < 8; ++q) xp[q] = pack2(xa[2 * q], xa[2 * q + 1]);
    const int id0 = IDX[(size_t)tok * 128 + lane], id1 = IDX[(size_t)tok * 128 + 64 + lane];
    float g0 = GATE[(size_t)tok * 128 + lane], g1 = GATE[(size_t)tok * 128 + 64 + lane];
    {
      float d0 = g0, d1 = g1;
#pragma unroll
      for (int o = 1; o < 16; o <<= 1) { d0 += __shfl_xor(d0, o); d1 += __shfl_xor(d1, o); }
      g0 /= d0; g1 /= d1;
    }
    float h0 = 0.f, h1 = 0.f;
#pragma unroll 4
    for (int e = 0; e < 64; ++e) {
      const int idx = __shfl(id0, e);
      const u16* row = UB + (size_t)idx * 1024;
      uint4 a = *(const uint4*)(row + lane * 8), b = *(const uint4*)(row + 512 + lane * 8);
      float s = dot2bf(a.x, xp[0], 0.f); s = dot2bf(a.y, xp[1], s); s = dot2bf(a.z, xp[2], s); s = dot2bf(a.w, xp[3], s);
      s = dot2bf(b.x, xp[4], s); s = dot2bf(b.y, xp[5], s); s = dot2bf(b.z, xp[6], s); s = dot2bf(b.w, xp[7], s);
#pragma unroll
      for (int o = 32; o > 0; o >>= 1) s += __shfl_xor(s, o);
      h0 = (lane == e) ? s : h0;
    }
#pragma unroll 4
    for (int e = 0; e < 64; ++e) {
      const int idx = __shfl(id1, e);
      const u16* row = UB + (size_t)idx * 1024;
      uint4 a = *(const uint4*)(row + lane * 8), b = *(const uint4*)(row + 512 + lane * 8);
      float s = dot2bf(a.x, xp[0], 0.f); s = dot2bf(a.y, xp[1], s); s = dot2bf(a.z, xp[2], s); s = dot2bf(a.w, xp[3], s);
      s = dot2bf(b.x, xp[4], s); s = dot2bf(b.y, xp[5], s); s = dot2bf(b.z, xp[6], s); s = dot2bf(b.w, xp[7], s);
#pragma unroll
      for (int o = 32; o > 0; o >>= 1) s += __shfl_xor(s, o);
      h1 = (lane == e) ? s : h1;
    }
    const float a0 = gelu_tanh(h0) * g0, a1 = gelu_tanh(h1) * g1;
    float y[16];
#pragma unroll
    for (int q = 0; q < 16; ++q) y[q] = 0.f;
#pragma unroll 4
    for (int e = 0; e < 128; ++e) {
      const int idx = e < 64 ? __shfl(id0, e) : __shfl(id1, e - 64);
      const float av = e < 64 ? __shfl(a0, e) : __shfl(a1, e - 64);
      const u16* row = VB + (size_t)idx * 1024;
      uint4 a = *(const uint4*)(row + lane * 8), b = *(const uint4*)(row + 512 + lane * 8);
      y[0] += av * lo2f(a.x); y[1] += av * hi2f(a.x); y[2] += av * lo2f(a.y); y[3] += av * hi2f(a.y);
      y[4] += av * lo2f(a.z); y[5] += av * hi2f(a.z); y[6] += av * lo2f(a.w); y[7] += av * hi2f(a.w);
      y[8] += av * lo2f(b.x); y[9] += av * hi2f(b.x); y[10] += av * lo2f(b.y); y[11] += av * hi2f(b.y);
      y[12] += av * lo2f(b.z); y[13] += av * hi2f(b.z); y[14] += av * lo2f(b.w); y[15] += av * hi2f(b.w);
    }
    float s = 0.f;
#pragma unroll
    for (int q = 0; q < 16; ++q) { y[q] = ALPHA * xa[q] + y[q]; s += y[q]; }
#pragma unroll
    for (int o = 32; o > 0; o >>= 1) s += __shfl_xor(s, o);
    const float mu = s * (1.f / 1024.f);
    float qv = 0.f;
#pragma unroll
    for (int q = 0; q < 16; ++q) { float d = y[q] - mu; qv += d * d; }
#pragma unroll
    for (int o = 32; o > 0; o >>= 1) qv += __shfl_xor(qv, o);
    const float rstd = rsqrtf(qv * (1.f / 1024.f) + 1e-5f);
#pragma unroll
    for (int hh = 0; hh < 2; ++hh) {
      const int col = hh * 512 + lane * 8;
      float4 ga = *(const float4*)(gam + col), gb = *(const float4*)(gam + col + 4);
      float4 ba = *(const float4*)(bet + col), bb = *(const float4*)(bet + col + 4);
      const float* yy = y + hh * 8;
      float4 oa = float4{(yy[0] - mu) * rstd * ga.x + ba.x, (yy[1] - mu) * rstd * ga.y + ba.y, (yy[2] - mu) * rstd * ga.z + ba.z, (yy[3] - mu) * rstd * ga.w + ba.w};
      float4 ob = float4{(yy[4] - mu) * rstd * gb.x + bb.x, (yy[5] - mu) * rstd * gb.y + bb.y, (yy[6] - mu) * rstd * gb.z + bb.z, (yy[7] - mu) * rstd * gb.w + bb.w};
      if (last) {
        *(float4*)(p.out + O_Y + (size_t)tok * 1024 + col) = oa; *(float4*)(p.out + O_Y + (size_t)tok * 1024 + col + 4) = ob;
      } else {
        *(float4*)(X + (size_t)tok * 1024 + col) = oa; *(float4*)(X + (size_t)tok * 1024 + col + 4) = ob;
        uint4 o; o.x = pack2(oa.x, oa.y); o.y = pack2(oa.z, oa.w); o.z = pack2(ob.x, ob.y); o.w = pack2(ob.z, ob.w);
        *(uint4*)(Xb + (size_t)tok * 1024 + col) = o;
      }
    }
  }
}

DI void phase_o_inproj(const Params& p, int i, char* smem) {
  const u16* Xb = (const u16*)(p.ws + WS_XB);
  const u16* W = (const u16*)(p.ws + WS_WINO) + (size_t)i * 5248 * 1024;
  u16* Z = (u16*)(p.ws + WS_Z); u16* XBCR = (u16*)(p.ws + WS_XBCR); float* DTR = (float*)(p.ws + WS_DTR);
  float* out = p.out;
  for (int t = obid(); t < 129 * 41; t += gridDim.x) {
    const int mt = t / 41, nt = t % 41;
    gemm_tile(Xb, 1024, W, 1024, 1024, mt * 128, nt * 128, (u16*)smem, [&](int tok, int n, f32x4 v, int, int) {
      if (n < 2048) st_bf4(Z + (size_t)tok * 2048 + n, v[0], v[1], v[2], v[3]);
      else if (n < 5120) {
        const int c = n - 2048;
        st_bf4(XBCR + (size_t)tok * 3072 + c, v[0], v[1], v[2], v[3]);
        if (tok >= TP) *(float4*)(out + O_SCONV + (((size_t)i * 128 + (tok - TP)) * 3 + 2) * 3072 + c) = float4{v[0], v[1], v[2], v[3]};
        else {
          const int b = tok >> 11, l = tok & 2047;
          if (l >= 2045) *(float4*)(out + O_PCONV + (((size_t)i * 8 + b) * 3 + (l - 2045)) * 3072 + c) = float4{v[0], v[1], v[2], v[3]};
        }
      } else if (n < 5152) *(float4*)(DTR + (size_t)tok * 32 + (n - 5120)) = float4{v[0], v[1], v[2], v[3]};
    });
  }
}

DI void phase_o_conv(const Params& p, int i, char* smem) {
  const int tid = otid();
  const size_t gtid = (size_t)obid() * 256 + tid, gsz = (size_t)gridDim.x * 256;
  const u16* XBCR = (const u16*)(p.ws + WS_XBCR);
  u16* XS = (u16*)(p.ws + WS_XS); u16* BM = (u16*)(p.ws + WS_BM); u16* CM = (u16*)(p.ws + WS_CM);
  u16* XST = (u16*)(p.ws + WS_XST); u16* BMT = (u16*)(p.ws + WS_BMT);
  const float* cw = p.in[21] + (size_t)i * 4 * 3072; const float* cb = p.in[22] + (size_t)i * 3072;
  float* raw = (float*)smem;
  u16* ys = (u16*)(smem + 67 * 64 * 4);
  for (int it = obid(); it < 256 * 48; it += gridDim.x) {
    const int ct = it % 48, tt = it / 48;
    const int t0 = tt * 64, l0 = t0 & 2047, c0 = ct * 64, b = t0 >> 11;
    const int c = tid & 63, r4 = tid >> 6;
    __syncthreads();
    for (int r = r4; r < 67; r += 4) {
      const int l = l0 - 3 + r;
      raw[r * 64 + c] = l >= 0 ? bf2f(XBCR[(size_t)(t0 - 3 + r) * 3072 + c0 + c]) : 0.f;
    }
    __syncthreads();
    const int ch = c0 + c;
    const float w0 = cw[ch], w1 = cw[3072 + ch], w2 = cw[2 * 3072 + ch], w3 = cw[3 * 3072 + ch], bs = cb[ch];
#pragma unroll
    for (int k = 0; k < 16; ++k) {
      const int r = r4 + 4 * k;
      float y = bs + w0 * raw[r * 64 + c] + w1 * raw[(r + 1) * 64 + c] + w2 * raw[(r + 2) * 64 + c] + w3 * raw[(r + 3) * 64 + c];
      const u16 yb = f2bf(siluf_(y));
      const size_t tok = (size_t)t0 + r;
      if (ch < 2048) XS[tok * 2048 + ch] = yb;
      else if (ch < 2560) BM[tok * 512 + ch - 2048] = yb;
      else CM[tok * 512 + ch - 2560] = yb;
      ys[r * 66 + c] = yb;
    }
    if (c0 < 2560) {
      __syncthreads();
      const int s = tid & 63, chunk = l0 >> 7, so = (l0 & 127) + s;
#pragma unroll
      for (int k = 0; k < 16; ++k) {
        const int cc = r4 + 4 * k;
        const u16 val = ys[s * 66 + cc];
        if (c0 < 2048) XST[(((size_t)b * 16 + chunk) * 2048 + c0 + cc) * 128 + so] = val;
        else BMT[(((size_t)b * 16 + chunk) * 512 + (c0 - 2048) + cc) * 128 + so] = val;
      }
    }
  }
  for (size_t e = gtid; e < (size_t)128 * 3072; e += gsz) {
    const int s = (int)(e / 3072), ch = (int)(e % 3072);
    const float* st = p.in[7] + ((size_t)i * 128 + s) * 3 * 3072 + ch;
    const size_t tok = (size_t)TP + s;
    float y = cb[ch] + cw[ch] * st[0] + cw[3072 + ch] * st[3072] + cw[2 * 3072 + ch] * st[2 * 3072] + cw[3 * 3072 + ch] * bf2f(XBCR[tok * 3072 + ch]);
    const u16 yb = f2bf(siluf_(y));
    if (ch < 2048) XS[tok * 2048 + ch] = yb;
    else if (ch < 2560) BM[tok * 512 + ch - 2048] = yb;
    else CM[tok * 512 + ch - 2560] = yb;
  }
  {
    const float* DTR = (const float*)(p.ws + WS_DTR); float* DT = (float*)(p.ws + WS_DT);
    const float* bias = p.in[23] + (size_t)i * 32;
    for (size_t e = gtid; e < (size_t)T * 32; e += gsz) {
      float x = DTR[e] + bias[e & 31];
      DT[e] = x > 20.f ? x : log1pf(expf(x));
    }
  }
}

DI void chunk_scan(const float* DT, size_t tok0, int h, float a, float* acs, float* dts, float* tot) {
  const int tid = otid(), lane = tid & 63;
  float d = 0.f, v = 0.f;
  __syncthreads();
  if (tid < 128) {
    d = DT[(tok0 + tid) * 32 + h];
    v = d * a;
#pragma unroll
    for (int o = 1; o < 64; o <<= 1) { float n = __shfl_up(v, o); if (lane >= o) v += n; }
    if (tid == 63) tot[0] = v;
  }
  __syncthreads();
  if (tid < 128) {
    if (tid >= 64) v += tot[0];
    acs[tid] = v; dts[tid] = d;
  }
  __syncthreads();
}

DI void phase_o_states(const Params& p, int i, char* smem) {
  const int tid = otid(), lane = tid & 63, w = tid >> 6, fr = lane & 15, fq = lane >> 4;
  float* acs = (float*)smem; float* dts = acs + 128; float* wgt = dts + 128; float* tot = wgt + 128;
  const float* DT = (const float*)(p.ws + WS_DT);
  const u16* XST = (const u16*)(p.ws + WS_XST); const u16* BMT = (const u16*)(p.ws + WS_BMT);
  float* ST = (float*)(p.ws + WS_ST); float* DEC = (float*)(p.ws + WS_DEC);
  for (int it = obid(); it < 4096; it += gridDim.x) {
    const int h = it & 31, chunk = (it >> 5) & 15, b = it >> 9, g = h >> 3;
    const float a = -expf(p.in[24][i * 32 + h]);
    const size_t tok0 = (size_t)b * 2048 + chunk * 128;
    chunk_scan(DT, tok0, h, a, acs, dts, tot);
    const float lastv = acs[127];
    if (tid < 128) wgt[tid] = __expf(lastv - acs[tid]) * dts[tid];
    if (tid == 0) DEC[((size_t)b * 16 + chunk) * 32 + h] = __expf(lastv);
    __syncthreads();
    const size_t bc = (size_t)b * 16 + chunk;
    f32x4 acc[4][2];
#pragma unroll
    for (int pt = 0; pt < 4; ++pt) { acc[pt][0] = f32x4{0.f, 0.f, 0.f, 0.f}; acc[pt][1] = f32x4{0.f, 0.f, 0.f, 0.f}; }
#pragma unroll
    for (int ks = 0; ks < 4; ++ks) {
      const int s0 = ks * 32 + fq * 8;
      const float4 wa = *(const float4*)(wgt + s0), wb = *(const float4*)(wgt + s0 + 4);
      bf16x8 bmf[2];
#pragma unroll
      for (int nt = 0; nt < 2; ++nt) bmf[nt] = *(const bf16x8*)(BMT + ((bc * 512 + g * 128 + 32 * w + nt * 16 + fr) * 128 + s0));
#pragma unroll
      for (int pt = 0; pt < 4; ++pt) {
        uint4 xr = *(const uint4*)(XST + ((bc * 2048 + h * 64 + pt * 16 + fr) * 128 + s0));
        uint4 xw;
        xw.x = pack2(lo2f(xr.x) * wa.x, hi2f(xr.x) * wa.y); xw.y = pack2(lo2f(xr.y) * wa.z, hi2f(xr.y) * wa.w);
        xw.z = pack2(lo2f(xr.z) * wb.x, hi2f(xr.z) * wb.y); xw.w = pack2(lo2f(xr.w) * wb.z, hi2f(xr.w) * wb.w);
        const bf16x8 xf = mk8(xw);
        acc[pt][0] = mfma16(bmf[0], xf, acc[pt][0]);
        acc[pt][1] = mfma16(bmf[1], xf, acc[pt][1]);
      }
    }
#pragma unroll
    for (int pt = 0; pt < 4; ++pt)
#pragma unroll
      for (int nt = 0; nt < 2; ++nt)
        *(float4*)(ST + (((bc * 32 + h) * 64 + pt * 16 + fr) * 128 + 32 * w + nt * 16 + fq * 4)) = float4{acc[pt][nt][0], acc[pt][nt][1], acc[pt][nt][2], acc[pt][nt][3]};
  }
}

DI void phase_o_scan(const Params& p, int i) {
  const size_t gtid = (size_t)obid() * 256 + otid(), gsz = (size_t)gridDim.x * 256;
  float* ST = (float*)(p.ws + WS_ST); const float* DEC = (const float*)(p.ws + WS_DEC);
  for (size_t e = gtid; e < (size_t)524288; e += gsz) {
    const int n4 = (int)(e & 31), pp = (int)((e >> 5) & 63), h = (int)((e >> 11) & 31), b = (int)(e >> 16);
    float4 carry = float4{0.f, 0.f, 0.f, 0.f};
    for (int c = 0; c < 16; ++c) {
      const size_t ad = ((((size_t)b * 16 + c) * 32 + h) * 64 + pp) * 128 + n4 * 4;
      const float dec = DEC[((size_t)b * 16 + c) * 32 + h];
      const float4 tmp = *(const float4*)(ST + ad);
      *(float4*)(ST + ad) = carry;
      carry = float4{dec * carry.x + tmp.x, dec * carry.y + tmp.y, dec * carry.z + tmp.z, dec * carry.w + tmp.w};
    }
    *(float4*)(p.out + O_PSSD + ((((size_t)i * 8 + b) * 32 + h) * 64 + pp) * 128 + n4 * 4) = carry;
  }
}

DI void phase_o_y(const Params& p, int i, char* smem) {
  const int tid = otid(), lane = tid & 63, w = tid >> 6, fr = lane & 15, fq = lane >> 4;
  float* acs = (float*)smem; float* dts = acs + 128; float* tot = dts + 128;
  const float* DT = (const float*)(p.ws + WS_DT);
  const u16* XST = (const u16*)(p.ws + WS_XST); const u16* XS = (const u16*)(p.ws + WS_XS);
  const u16* BM = (const u16*)(p.ws + WS_BM); const u16* CM = (const u16*)(p.ws + WS_CM); const u16* Z = (const u16*)(p.ws + WS_Z);
  const float* ST = (const float*)(p.ws + WS_ST);
  u16* YG = (u16*)(p.ws + WS_YG); float* SSQ = (float*)(p.ws + WS_SSQ);
  for (int it = obid(); it < 8192; it += gridDim.x) {
    if (it < 4096) {
      const int h = it & 31, chunk = (it >> 5) & 15, b = it >> 9, g = h >> 3;
      const float a = -expf(p.in[24][i * 32 + h]);
      const float Dh = p.in[25][i * 32 + h];
      const size_t tok0 = (size_t)b * 2048 + chunk * 128;
      const size_t bc = (size_t)b * 16 + chunk;
      chunk_scan(DT, tok0, h, a, acs, dts, tot);
      for (int q = 0; q < 2; ++q) {
        const int tt = q == 0 ? w : 7 - w;
        const int tl = tt * 16 + fr;
        bf16x8 cmf[4];
#pragma unroll
        for (int ks = 0; ks < 4; ++ks) cmf[ks] = *(const bf16x8*)(CM + (tok0 + tl) * 512 + g * 128 + ks * 32 + fq * 8);
        f32x4 acc[4];
#pragma unroll
        for (int pt = 0; pt < 4; ++pt) acc[pt] = f32x4{0.f, 0.f, 0.f, 0.f};
#pragma unroll
        for (int ks = 0; ks < 4; ++ks)
#pragma unroll
          for (int pt = 0; pt < 4; ++pt) {
            const float* sp = ST + (((bc * 32 + h) * 64 + pt * 16 + fr) * 128 + ks * 32 + fq * 8);
            float4 sa = *(const float4*)sp, sb = *(const float4*)(sp + 4);
            uint4 sv; sv.x = pack2(sa.x, sa.y); sv.y = pack2(sa.z, sa.w); sv.z = pack2(sb.x, sb.y); sv.w = pack2(sb.z, sb.w);
            acc[pt] = mfma16(mk8(sv), cmf[ks], acc[pt]);
          }
        const float at = acs[tl];
        const float ea = __expf(at);
#pragma unroll
        for (int pt = 0; pt < 4; ++pt) { acc[pt][0] *= ea; acc[pt][1] *= ea; acc[pt][2] *= ea; acc[pt][3] *= ea; }
        for (int sp = 0; sp * 2 <= tt; ++sp) {
          uint4 mk;
#pragma unroll
          for (int half = 0; half < 2; ++half) {
            const int st = 2 * sp + half;
            f32x4 cb = f32x4{0.f, 0.f, 0.f, 0.f};
            if (st <= tt) {
#pragma unroll
              for (int ks = 0; ks < 4; ++ks) {
                bf16x8 bmf = *(const bf16x8*)(BM + (tok0 + st * 16 + fr) * 512 + g * 128 + ks * 32 + fq * 8);
                cb = mfma16(bmf, cmf[ks], cb);
              }
            }
            float mv[4];
#pragma unroll
            for (int j = 0; j < 4; ++j) {
              const int sl = st * 16 + fq * 4 + j;
              float m = 0.f;
              if (st <= tt && sl <= tl) m = cb[j] * __expf(at - acs[sl]) * dts[sl];
              mv[j] = m;
            }
            if (half == 0) { mk.x = pack2(mv[0], mv[1]); mk.y = pack2(mv[2], mv[3]); }
            else { mk.z = pack2(mv[0], mv[1]); mk.w = pack2(mv[2], mv[3]); }
          }
          const bf16x8 mf = mk8(mk);
#pragma unroll
          for (int pt = 0; pt < 4; ++pt) {
            const u16* xr = XST + ((bc * 2048 + h * 64 + pt * 16 + fr) * 128);
            uint2 xa = *(const uint2*)(xr + (2 * sp) * 16 + fq * 4), xb = *(const uint2*)(xr + (2 * sp + 1) * 16 + fq * 4);
            acc[pt] = mfma16(mk8(uint4{xa.x, xa.y, xb.x, xb.y}), mf, acc[pt]);
          }
        }
        const size_t tok = tok0 + tl;
        float ss = 0.f;
#pragma unroll
        for (int pt = 0; pt < 4; ++pt) {
          const int col = h * 64 + pt * 16 + fq * 4;
          uint2 xv = *(const uint2*)(XS + tok * 2048 + col), zv = *(const uint2*)(Z + tok * 2048 + col);
          float y0 = (acc[pt][0] + Dh * lo2f(xv.x)) * siluf_(lo2f(zv.x));
          float y1 = (acc[pt][1] + Dh * hi2f(xv.x)) * siluf_(hi2f(zv.x));
          float y2 = (acc[pt][2] + Dh * lo2f(xv.y)) * siluf_(lo2f(zv.y));
          float y3 = (acc[pt][3] + Dh * hi2f(xv.y)) * siluf_(hi2f(zv.y));
          st_bf4(YG + tok * 2048 + col, y0, y1, y2, y3);
          ss += y0 * y0 + y1 * y1 + y2 * y2 + y3 * y3;
        }
        ss += __shfl_xor(ss, 16); ss += __shfl_xor(ss, 32);
        if (fq == 0) SSQ[tok * 32 + h] = ss;
      }
    } else {
      const int r = it - 4096, h = r & 31, s = r >> 5, g = h >> 3;
      const float a = -expf(p.in[24][i * 32 + h]);
      const float Dh = p.in[25][i * 32 + h];
      const size_t tok = (size_t)TP + s;
      const int pp = tid >> 2, nq = tid & 3;
      const float dtv = DT[tok * 32 + h];
      const float dA = __expf(dtv * a);
      const float xv = bf2f(XS[tok * 2048 + h * 64 + pp]);
      const size_t ad = ((((size_t)i * 128 + s) * 32 + h) * 64 + pp) * 128 + nq * 32;
      const float dx = dtv * xv;
      float yp = 0.f;
#pragma unroll
      for (int k = 0; k < 8; ++k) {
        float4 s0 = *(const float4*)(p.in[6] + ad + 4 * k);
        uint2 bv = *(const uint2*)(BM + tok * 512 + g * 128 + nq * 32 + 4 * k), cv = *(const uint2*)(CM + tok * 512 + g * 128 + nq * 32 + 4 * k);
        float4 nw = float4{dA * s0.x + dx * lo2f(bv.x), dA * s0.y + dx * hi2f(bv.x), dA * s0.z + dx * lo2f(bv.y), dA * s0.w + dx * hi2f(bv.y)};
        *(float4*)(p.out + O_SSSD + ad + 4 * k) = nw;
        yp += nw.x * lo2f(cv.x) + nw.y * hi2f(cv.x) + nw.z * lo2f(cv.y) + nw.w * hi2f(cv.y);
      }
      yp += __shfl_xor(yp, 1); yp += __shfl_xor(yp, 2);
      const float yg = (yp + Dh * xv) * siluf_(bf2f(Z[tok * 2048 + h * 64 + pp]));
      float ss = 0.f;
      if (nq == 0) { YG[tok * 2048 + h * 64 + pp] = f2bf(yg); ss = yg * yg; }
#pragma unroll
      for (int o = 32; o > 0; o >>= 1) ss += __shfl_xor(ss, o);
      __syncthreads();
      if (lane == 0) tot[w] = ss;
      __syncthreads();
      if (tid == 0) SSQ[tok * 32 + h] = (tot[0] + tot[1]) + (tot[2] + tot[3]);
    }
  }
}

constexpr int SMEM_BYTES = GEMM_SMEM + 128 * 32 * 4;
__global__ void __launch_bounds__(256, 2) mega_kernel(Params p) {
  __shared__ __attribute__((aligned(16))) char smem[SMEM_BYTES];
  __shared__ uint4 xb_words;
  if (threadIdx.x == 0) xb_words = make_uint4(0u, 0u, 0u, 0u);
  __syncthreads();
  XcdBarrier bar = xcd_barrier_post((unsigned*)(p.ws + WS_BAR), (volatile LAS unsigned*)&xb_words);
  phase_prep(p, smem);
  cg::this_grid().sync();
  for (int layer = 0; layer < 4; ++layer) {
    const int i = layer >> 1;
    convert_tables(p, layer);
    if ((layer & 1) == 0) {
      phase_e_inproj(p, i, smem);
      xcd_barrier(bar);
      s5_pass1(p, i, smem);
      __syncthreads();
      swa_prompt(p, i, smem);
      __syncthreads();
      swa_sample(p, i, smem);
      xcd_barrier(bar);
      s5_pass3(p, i, smem);
      xcd_barrier(bar);
      phase_e_glu(p, i, smem);
      xcd_barrier(bar);
      phase_outproj(p, (const u16*)(p.ws + WS_CAT), 1024, (const u16*)(p.ws + WS_WOUTE) + (size_t)i * 1024 * 1024, false, smem);
      xcd_barrier(bar);
    } else {
      phase_o_inproj(p, i, smem);
      xcd_barrier(bar);
      phase_o_conv(p, i, smem);
      xcd_barrier(bar);
      phase_o_states(p, i, smem);
      xcd_barrier(bar);
      phase_o_scan(p, i);
      xcd_barrier(bar);
      phase_o_y(p, i, smem);
      xcd_barrier(bar);
      phase_outproj(p, (const u16*)(p.ws + WS_YG), 2048, (const u16*)(p.ws + WS_WOUTO) + (size_t)i * 1024 * 2048, true, smem);
      xcd_barrier(bar);
    }
    phase_ln1(p, layer);
    xcd_barrier(bar);
    phase_peer1(p, layer, smem);
    xcd_barrier(bar);
    phase_peer3(p, layer);
    xcd_barrier(bar);
  }
}

extern "C" void kernel_launch(void* const* d_in, const int* in_sizes, int n_in, void* d_out, int out_size, void* d_ws,
                              size_t ws_size, hipStream_t stream) {
  static int grid_blocks = 0;
  if (!grid_blocks) {
    int dev = 0, cus = 0, per_cu = 0;
    hipGetDevice(&dev);
    hipDeviceGetAttribute(&cus, hipDeviceAttributeMultiprocessorCount, dev);
    hipOccupancyMaxActiveBlocksPerMultiprocessor(&per_cu, mega_kernel, 256, 0);
    if (per_cu > 2) per_cu = 2;
    if (per_cu < 1) per_cu = 1;
    grid_blocks = cus * per_cu;
  }
  if (ws_size < WS_END) { fprintf(stderr, "workspace too small: %zu < %zu\n", ws_size, (size_t)WS_END); return; }
  Params p{};
  for (int k = 0; k < 37; ++k) p.in[k] = (const float*)d_in[k];
  p.out = (float*)d_out;
  p.ws = (char*)d_ws;
  hipMemsetAsync((char*)d_ws + WS_BAR, 0, 16384, stream);
  void* args[] = {&p};
  hipError_t e = hipLaunchCooperativeKernel((void*)mega_kernel, dim3(grid_blocks), dim3(256), args, 0, stream);
  if (e != hipSuccess) fprintf(stderr, "cooperative launch failed: %s (grid %d)\n", hipGetErrorString(e), grid_blocks);
}
```

```cpp
#include <hip/hip_runtime.h>
#include <hip/hip_cooperative_groups.h>
#include <cstdio>
#include <cstdint>
namespace cg = cooperative_groups;

typedef unsigned short u16;
typedef __attribute__((ext_vector_type(8))) short bf16x8;
typedef __attribute__((ext_vector_type(4))) short bf16x4;
typedef __attribute__((ext_vector_type(4))) float f32x4;
typedef __attribute__((ext_vector_type(2))) __bf16 bf2;
typedef __attribute__((ext_vector_type(4))) unsigned u32x4;

#define DI __device__ __forceinline__

constexpr int T = 16512, TP = 16384, NSMP = 128;
constexpr float ALPHA = 1.681792830507429f;

constexpr size_t O_Y = 0;
constexpr size_t O_PS5RE = (size_t)T * 1024;
constexpr size_t O_PS5IM = O_PS5RE + 32768;
constexpr size_t O_PSWAK = O_PS5IM + 32768;
constexpr size_t O_PSWAV = O_PSWAK + 262144;
constexpr size_t O_PSSD = O_PSWAV + 262144;
constexpr size_t O_PCONV = O_PSSD + 4194304;
constexpr size_t O_SS5RE = O_PCONV + 147456;
constexpr size_t O_SS5IM = O_SS5RE + 524288;
constexpr size_t O_SSWAK = O_SS5IM + 524288;
constexpr size_t O_SSWAV = O_SSWAK + 4194304;
constexpr size_t O_SSSD = O_SSWAV + 4194304;
constexpr size_t O_SCONV = O_SSSD + 67108864;

constexpr size_t WS_BAR = 0;
constexpr size_t WS_X = 16384;
constexpr size_t WS_XB = WS_X + (size_t)T * 1024 * 4;
constexpr size_t WS_SSQ = WS_XB + (size_t)T * 1024 * 2;
constexpr size_t WS_IDX = WS_SSQ + (size_t)T * 32 * 4;
constexpr size_t WS_GATE = WS_IDX + (size_t)T * 128 * 4;
constexpr size_t WS_DT = WS_GATE + (size_t)T * 128 * 4;
constexpr size_t WS_DTR = WS_DT + (size_t)T * 32 * 4;
constexpr size_t WS_DEC = WS_DTR + (size_t)T * 32 * 4;
constexpr size_t WS_AB = WS_DEC + 16384;
constexpr size_t WS_BBR = WS_AB + 32768;
constexpr size_t WS_BBI = WS_BBR + 262144;
constexpr size_t WS_CT = WS_BBI + 262144;
constexpr size_t WS_E = WS_CT + 262144;
constexpr size_t WS_WINE = WS_E + 4194304;
constexpr size_t WS_WGLU = WS_WINE + (size_t)2 * 1280 * 1024 * 2;
constexpr size_t WS_WOUTE = WS_WGLU + (size_t)2 * 512 * 512 * 2;
constexpr size_t WS_WINO = WS_WOUTE + (size_t)2 * 1024 * 1024 * 2;
constexpr size_t WS_WOUTO = WS_WINO + (size_t)2 * 5248 * 1024 * 2;
constexpr size_t WS_WQ = WS_WOUTO + (size_t)2 * 1024 * 2048 * 2;
constexpr size_t WS_K1 = WS_WQ + (size_t)4 * 2048 * 1024 * 2;
constexpr size_t WS_K2 = WS_K1 + (size_t)4 * 8 * 128 * 128 * 2;
constexpr size_t WS_UB = WS_K2 + (size_t)4 * 8 * 128 * 128 * 2;
constexpr size_t WS_VB = WS_UB + (size_t)16384 * 1024 * 2;
constexpr size_t WS_ACT = WS_VB + (size_t)16384 * 1024 * 2;
constexpr size_t WS_Z = WS_ACT;
constexpr size_t WS_XBCR = WS_Z + (size_t)T * 2048 * 2;
constexpr size_t WS_R = WS_XBCR;
constexpr size_t WS_XS = WS_XBCR + (size_t)T * 3072 * 2;
constexpr size_t WS_BM = WS_XS + (size_t)T * 2048 * 2;
constexpr size_t WS_CM = WS_BM + (size_t)T * 512 * 2;
constexpr size_t WS_XST = WS_CM + (size_t)T * 512 * 2;
constexpr size_t WS_BMT = WS_XST + (size_t)TP * 2048 * 2;
constexpr size_t WS_ST = WS_BMT + (size_t)TP * 512 * 2;
constexpr size_t WS_YG = WS_ST + (size_t)8 * 16 * 32 * 64 * 128 * 4;
constexpr size_t WS_END = WS_YG + (size_t)T * 2048 * 2;
constexpr size_t WS_PE = WS_Z;
constexpr size_t WS_G = WS_XS;
constexpr size_t WS_CAT = WS_YG;

struct Params {
  const float* in[37];
  float* out;
  char* ws;
};

DI u16 f2bf(float f) { unsigned u = __float_as_uint(f); u += 0x7fffu + ((u >> 16) & 1u); return (u16)(u >> 16); }
DI float bf2f(u16 h) { return __uint_as_float(((unsigned)h) << 16); }
DI unsigned pack2(float a, float b) { return (unsigned)f2bf(a) | ((unsigned)f2bf(b) << 16); }
DI float lo2f(unsigned u) { return __uint_as_float(u << 16); }
DI float hi2f(unsigned u) { return __uint_as_float(u & 0xffff0000u); }
DI float gelu_tanh(float x) {
  float u = 0.7978845608028654f * (x + 0.044715f * x * x * x);
  float e = __expf(2.f * u);
  float th = 1.f - 2.f / (e + 1.f);
  return 0.5f * x * (1.f + th);
}
DI float sigmoidf_(float x) { return 1.f / (1.f + __expf(-x)); }
DI float siluf_(float x) { return x / (1.f + __expf(-x)); }
DI f32x4 mfma16(bf16x8 a, bf16x8 b, f32x4 c) { return __builtin_amdgcn_mfma_f32_16x16x32_bf16(a, b, c, 0, 0, 0); }
DI void wave_lds_sync() { __builtin_amdgcn_fence(__ATOMIC_ACQ_REL, "workgroup"); __builtin_amdgcn_wave_barrier(); }
DI void st_bf4(u16* dst, float a, float b, float c, float d) { uint2 v; v.x = pack2(a, b); v.y = pack2(c, d); *(uint2*)dst = v; }
DI bf16x8 mk8(uint4 v) { return __builtin_bit_cast(bf16x8, v); }

#define XB_TMO      128
#define XB_XCNT(j)  (256  + 64 * (j))
#define XB_XSUB(j)  (1280 + 64 * (j))
#define XB_XGEN(j)  (2304 + 64 * (j))
#define XB_TOP      3328
#define XB_TOPGEN   3392
#define XCD_BAR_WORDS 3456
#define XB_SPIN_CAP (1u << 22)
#define LAS __attribute__((address_space(3)))
DI unsigned xb_ld(unsigned* p) { return __hip_atomic_load(p, __ATOMIC_RELAXED, __HIP_MEMORY_SCOPE_AGENT); }
DI unsigned xb_add(unsigned* p, unsigned v) { return __hip_atomic_fetch_add(p, v, __ATOMIC_RELAXED, __HIP_MEMORY_SCOPE_AGENT); }
DI unsigned xb_xcc_id() { return (unsigned)__builtin_amdgcn_s_getreg((3 << 11) | 20) & 0xFu; }
#define XB_SPIN(cond, bar) do { unsigned _sp = 0; while (cond) { __builtin_amdgcn_s_sleep(1); \
    if ((++_sp & 255u) == 0u) { if (xb_ld(&(bar)[XB_TMO])) break; if (_sp > XB_SPIN_CAP) { atomicAdd(&(bar)[XB_TMO], 1u); break; } } } } while (0)
struct XcdBarrier { unsigned* bar; unsigned x; volatile LAS unsigned* st; };
DI XcdBarrier xcd_barrier_post(unsigned* bar, volatile LAS unsigned* st) {
  XcdBarrier b; b.bar = bar; b.x = xb_xcc_id(); b.st = st;
  if (threadIdx.x == 0) (void)xb_add(&bar[XB_XCNT(b.x)], 1u);
  return b;
}
DI void xcd_barrier_complete(unsigned* bar, unsigned x, unsigned& nloc, unsigned& nx) {
  const unsigned G = gridDim.x;
  unsigned sum, cnt, mine, sp = 0u;
  for (;;) {
    sum = 0u; cnt = 0u; mine = 0u;
#pragma unroll
    for (unsigned j = 0; j < 16; ++j) { const unsigned c = xb_ld(&bar[XB_XCNT(j)]); sum += c; cnt += (c > 0u) ? 1u : 0u; mine = (j == x) ? c : mine; }
    if (sum == G) break;
    __builtin_amdgcn_s_sleep(1);
    if ((++sp & 255u) == 0u) { if (xb_ld(&bar[XB_TMO])) break; if (sp > XB_SPIN_CAP) { atomicAdd(&bar[XB_TMO], 1u); break; } }
  }
  nloc = mine > 0u ? mine : 1u; nx = cnt > 0u ? cnt : 1u;
}
DI void xcd_barrier(const XcdBarrier& b) {
  asm volatile("s_waitcnt vmcnt(0)" ::: "memory");
  __syncthreads();
  if (threadIdx.x == 0) {
    unsigned* bar = b.bar;
    __builtin_amdgcn_s_waitcnt(0);
    unsigned nloc = b.st[0], nx = b.st[1];
    if (nloc == 0u) { xcd_barrier_complete(bar, b.x, nloc, nx); b.st[0] = nloc; b.st[1] = nx; }
    const unsigned old = xb_add(&bar[XB_XSUB(b.x)], 1u);
    const unsigned gen = old / nloc;
    if (old + 1u == (gen + 1u) * nloc) {
      __builtin_amdgcn_fence(__ATOMIC_RELEASE, "agent");
      asm volatile("s_waitcnt vmcnt(0)" ::: "memory");
      const unsigned og = xb_add(&bar[XB_TOP], 1u);
      const unsigned tg = og / nx;
      if (og + 1u == (tg + 1u) * nx) xb_add(&bar[XB_TOPGEN], 1u);
      else XB_SPIN(xb_ld(&bar[XB_TOPGEN]) == tg, bar);
      __builtin_amdgcn_fence(__ATOMIC_ACQUIRE, "agent");
      xb_add(&bar[XB_XGEN(b.x)], 1u);
      asm volatile("s_waitcnt vmcnt(0)" ::: "memory");
    } else {
      XB_SPIN(xb_ld(&bar[XB_XGEN(b.x)]) == gen, bar);
      __builtin_amdgcn_fence(__ATOMIC_ACQUIRE, "agent");
      asm volatile("s_waitcnt vmcnt(0)" ::: "memory");
    }
  }
  __syncthreads();
}

DI int otid() { int t = threadIdx.x; asm volatile("" : "+v"(t)); return t; }
DI int obid() { int t = blockIdx.x; asm volatile("" : "+s"(t)); return t; }

constexpr int LDSS = 72;
constexpr int GEMM_SMEM = 2 * 128 * LDSS * 2;
template <bool SYNC_EPI = false, class Epi>
DI void gemm_tile(const u16* __restrict__ A, int lda, const u16* __restrict__ Bt, int ldb, int K, int m0, int n0,
                  u16* sm, Epi&& epi) {
  u16* sA = sm; u16* sB = sm + 128 * LDSS;
  const int tid = otid(), lane = tid & 63, wid = tid >> 6, wr = wid >> 1, wc = wid & 1, fr = lane & 15, fq = lane >> 4;
  const int lr = tid >> 3, lc = (tid & 7) * 8;
  const u16* ga = A + (size_t)(m0 + lr) * lda + lc;
  const u16* gb = Bt + (size_t)(n0 + lr) * ldb + lc;
  u32x4 ra[4], rb[4];
#pragma unroll
  for (int i = 0; i < 4; ++i) { ra[i] = *(const u32x4*)(ga + (size_t)(32 * i) * lda); rb[i] = *(const u32x4*)(gb + (size_t)(32 * i) * ldb); }
  f32x4 acc[4][4];
#pragma unroll
  for (int m = 0; m < 4; ++m)
#pragma unroll
    for (int n = 0; n < 4; ++n) acc[m][n] = f32x4{0.f, 0.f, 0.f, 0.f};
  for (int k0 = 0; k0 < K; k0 += 64) {
    __syncthreads();
#pragma unroll
    for (int i = 0; i < 4; ++i) {
      *(u32x4*)(sA + (lr + 32 * i) * LDSS + lc) = ra[i];
      *(u32x4*)(sB + (lr + 32 * i) * LDSS + lc) = rb[i];
    }
    __syncthreads();
    if (k0 + 64 < K) {
#pragma unroll
      for (int i = 0; i < 4; ++i) {
        ra[i] = *(const u32x4*)(ga + (size_t)(32 * i) * lda + k0 + 64);
        rb[i] = *(const u32x4*)(gb + (size_t)(32 * i) * ldb + k0 + 64);
      }
    }
#pragma unroll
    for (int ks = 0; ks < 2; ++ks) {
      bf16x8 af[4], bfr[4];
#pragma unroll
      for (int m = 0; m < 4; ++m) af[m] = *(const bf16x8*)(sA + (wr * 64 + m * 16 + fr) * LDSS + ks * 32 + fq * 8);
#pragma unroll
      for (int n = 0; n < 4; ++n) bfr[n] = *(const bf16x8*)(sB + (wc * 64 + n * 16 + fr) * LDSS + ks * 32 + fq * 8);
#pragma unroll
      for (int m = 0; m < 4; ++m)
#pragma unroll
        for (int n = 0; n < 4; ++n) acc[m][n] = mfma16(bfr[n], af[m], acc[m][n]);
    }
  }
  if (SYNC_EPI) __syncthreads();
#pragma unroll
  for (int m = 0; m < 4; ++m)
#pragma unroll
    for (int n = 0; n < 4; ++n) epi(m0 + wr * 64 + m * 16 + fr, n0 + wc * 64 + n * 16 + fq * 4, acc[m][n], m, n);
}

struct WJob { const float* src; u16* dst; int K, N, Npad; const float* scale; };
DI WJob get_wjob(const Params& p, int j) {
  WJob w; w.scale = nullptr;
  if (j < 2) { w.src = p.in[8] + (size_t)j * 1024 * 1280; w.dst = (u16*)(p.ws + WS_WINE) + (size_t)j * 1280 * 1024; w.K = 1024; w.N = 1280; w.Npad = 1280; }
  else if (j < 4) { int i = j - 2; w.src = p.in[17] + (size_t)i * 512 * 512; w.dst = (u16*)(p.ws + WS_WGLU) + (size_t)i * 512 * 512; w.K = 512; w.N = 512; w.Npad = 512; }
  else if (j < 6) { int i = j - 4; w.src = p.in[19] + (size_t)i * 1024 * 1024; w.dst = (u16*)(p.ws + WS_WOUTE) + (size_t)i * 1024 * 1024; w.K = 1024; w.N = 1024; w.Npad = 1024; }
  else if (j < 8) { int i = j - 6; w.src = p.in[20] + (size_t)i * 1024 * 5152; w.dst = (u16*)(p.ws + WS_WINO) + (size_t)i * 5248 * 1024; w.K = 1024; w.N = 5152; w.Npad = 5248; }
  else if (j < 10) { int i = j - 8; w.src = p.in[27] + (size_t)i * 2048 * 1024; w.dst = (u16*)(p.ws + WS_WOUTO) + (size_t)i * 1024 * 2048; w.K = 2048; w.N = 1024; w.Npad = 1024; w.scale = p.in[26] + (size_t)i * 2048; }
  else { int i = j - 10; w.src = p.in[32] + (size_t)i * 1024 * 2048; w.dst = (u16*)(p.ws + WS_WQ) + (size_t)i * 2048 * 1024; w.K = 1024; w.N = 2048; w.Npad = 2048; }
  return w;
}

DI void phase_prep(const Params& p, char* smem) {
  const int tid = otid();
  const size_t gtid = (size_t)obid() * 256 + tid, gsz = (size_t)gridDim.x * 256;
  {
    float* X = (float*)(p.ws + WS_X); u16* Xb = (u16*)(p.ws + WS_XB);
    for (size_t i = gtid; i < (size_t)T * 256; i += gsz) {
      size_t e = i * 4;
      const float* src = e < (size_t)TP * 1024 ? p.in[0] + e : p.in[1] + (e - (size_t)TP * 1024);
      float4 v = *(const float4*)src;
      *(float4*)(X + e) = v;
      st_bf4(Xb + e, v.x, v.y, v.z, v.w);
    }
  }
  {
    float* tile = (float*)smem;
    for (int j = 0; j < 14; ++j) {
      WJob w = get_wjob(p, j);
      const int tk = w.K / 64, tn = w.Npad / 64;
      for (int t = obid(); t < tk * tn; t += gridDim.x) {
        const int k0 = (t % tk) * 64, n0 = (t / tk) * 64;
        const int c = tid & 63, r4 = tid >> 6;
        __syncthreads();
#pragma unroll
        for (int i = 0; i < 16; ++i) {
          int r = r4 + 4 * i;
          float v = 0.f;
          if (n0 + c < w.N) { v = w.src[(size_t)(k0 + r) * w.N + n0 + c]; if (w.scale) v *= w.scale[k0 + r]; }
          tile[r * 65 + c] = v;
        }
        __syncthreads();
#pragma unroll
        for (int i = 0; i < 16; ++i) {
          int nn = r4 + 4 * i;
          w.dst[(size_t)(n0 + nn) * w.K + k0 + c] = f2bf(tile[c * 65 + nn]);
        }
      }
    }
  }
  {
    u16* k1 = (u16*)(p.ws + WS_K1); u16* k2 = (u16*)(p.ws + WS_K2);
    for (size_t i = gtid; i < (size_t)131072; i += gsz) {
      float4 a = *(const float4*)(p.in[33] + i * 4), b = *(const float4*)(p.in[34] + i * 4);
      st_bf4(k1 + i * 4, a.x, a.y, a.z, a.w);
      st_bf4(k2 + i * 4, b.x, b.y, b.z, b.w);
    }
  }
  {
    float* AB = (float*)(p.ws + WS_AB); float* BBR = (float*)(p.ws + WS_BBR); float* BBI = (float*)(p.ws + WS_BBI);
    u16* CT = (u16*)(p.ws + WS_CT);
    for (size_t i = gtid; i < 4096; i += gsz) {
      int ig = (int)(i >> 6), pp = (int)(i & 63);
      float dt = expf(p.in[11][ig]);
      float lr = p.in[9][i], li = p.in[10][i];
      float mag = expf(lr * dt);
      float abr = mag * cosf(li * dt), abi = mag * sinf(li * dt);
      float den = lr * lr + li * li;
      float nr = abr - 1.f, ni = abi;
      float cr = (nr * lr + ni * li) / den, ci = (ni * lr - nr * li) / den;
      AB[i * 2] = abr; AB[i * 2 + 1] = abi;
      for (int c = 0; c < 16; ++c) {
        float br = p.in[12][i * 16 + c], bi = p.in[13][i * 16 + c];
        BBR[i * 16 + c] = cr * br - ci * bi;
        BBI[i * 16 + c] = cr * bi + ci * br;
        CT[((size_t)ig * 16 + c) * 128 + pp] = f2bf(p.in[14][((size_t)ig * 16 + c) * 64 + pp]);
        CT[((size_t)ig * 16 + c) * 128 + 64 + pp] = f2bf(-p.in[15][((size_t)ig * 16 + c) * 64 + pp]);
      }
    }
  }
  {
    for (size_t i = gtid; i < (size_t)2 * 128 * 127 * 32; i += gsz) {
      size_t q = i & 31, row = (i >> 5) % 127, is = (i >> 5) / 127;
      size_t so = (is * 128 + row + 1) * 128 + q * 4, dn = (is * 128 + row) * 128 + q * 4;
      *(float4*)(p.out + O_SSWAK + dn) = *(const float4*)(p.in[4] + so);
      *(float4*)(p.out + O_SSWAV + dn) = *(const float4*)(p.in[5] + so);
    }
    for (size_t i = gtid; i < (size_t)2 * 128 * 2 * 768; i += gsz) {
      size_t q = i % 768, row = (i / 768) & 1, is = i / 1536;
      *(float4*)(p.out + O_SCONV + (is * 3 + row) * 3072 + q * 4) = *(const float4*)(p.in[7] + (is * 3 + row + 1) * 3072 + q * 4);
    }
  }
}

constexpr float U8_SCALE = 256.f, V8_SCALE = 64.f;
DI unsigned enc4(float4 a, float sc) {
  int pk = __builtin_amdgcn_cvt_pk_fp8_f32(a.x * sc, a.y * sc, 0, false);
  pk = __builtin_amdgcn_cvt_pk_fp8_f32(a.z * sc, a.w * sc, pk, true);
  return (unsigned)pk;
}
DI void convert_tables(const Params& p, int layer) {
  const size_t gtid = (size_t)obid() * 256 + otid(), gsz = (size_t)gridDim.x * 256;
  const float* u = p.in[35] + (size_t)layer * 16384 * 1024;
  const float* v = p.in[36] + (size_t)layer * 16384 * 1024;
  unsigned char* ub = (unsigned char*)(p.ws + WS_UB); unsigned char* vb = (unsigned char*)(p.ws + WS_VB);
  for (size_t i = gtid; i < (size_t)16384 * 1024 / 16; i += gsz) {
    u32x4 o;
#pragma unroll
    for (int q = 0; q < 4; ++q) o[q] = enc4(*(const float4*)(u + i * 16 + q * 4), U8_SCALE);
    *(u32x4*)(ub + i * 16) = o;
#pragma unroll
    for (int q = 0; q < 4; ++q) o[q] = enc4(*(const float4*)(v + i * 16 + q * 4), V8_SCALE);
    *(u32x4*)(vb + i * 16) = o;
  }
}

DI void phase_e_inproj(const Params& p, int i, char* smem) {
  const u16* Xb = (const u16*)(p.ws + WS_XB);
  const u16* W = (const u16*)(p.ws + WS_WINE) + (size_t)i * 1280 * 1024;
  u16* PE = (u16*)(p.ws + WS_PE);
  float* out = p.out;
  for (int t = obid(); t < 129 * 10; t += gridDim.x) {
    const int mt = t / 10, nt = t % 10;
    gemm_tile(Xb, 1024, W, 1024, 1024, mt * 128, nt * 128, (u16*)smem, [&](int tok, int n, f32x4 v, int, int) {
      st_bf4(PE + (size_t)tok * 1280 + n, v[0], v[1], v[2], v[3]);
      if (n >= 1024) {
        const int isv = n >= 1152; const int col = n - (isv ? 1152 : 1024);
        if (tok >= TP) {
          size_t o = (isv ? O_SSWAV : O_SSWAK) + (((size_t)i * 128 + (tok - TP)) * 128 + 127) * 128 + col;
          *(float4*)(out + o) = float4{v[0], v[1], v[2], v[3]};
        } else {
          const int b = tok >> 11, l = tok & 2047;
          if (l >= 1920) {
            size_t o = (isv ? O_PSWAV : O_PSWAK) + (((size_t)i * 8 + b) * 128 + (l - 1920)) * 128 + col;
            *(float4*)(out + o) = float4{v[0], v[1], v[2], v[3]};
          }
        }
      }
    });
  }
}

DI void s5_pass1(const Params& p, int i, char* smem) {
  const int lane = otid() & 63, wid = otid() >> 6;
  float* Us = (float*)smem + wid * 1024;
  const u16* PE = (const u16*)(p.ws + WS_PE);
  const float* AB = (const float*)(p.ws + WS_AB); const float* BBR = (const float*)(p.ws + WS_BBR); const float* BBI = (const float*)(p.ws + WS_BBI);
  float2* E = (float2*)(p.ws + WS_E);
  for (int it = obid() * 4 + wid; it < 8192; it += gridDim.x * 4) {
    const int g = it & 31, chunk = (it >> 5) & 31, b = it >> 10;
    const size_t pi = ((size_t)i * 32 + g) * 64 + lane;
    float bbr[16], bbi[16];
#pragma unroll
    for (int c = 0; c < 4; ++c) {
      float4 a = *(const float4*)(BBR + pi * 16 + c * 4), bb = *(const float4*)(BBI + pi * 16 + c * 4);
      bbr[c * 4] = a.x; bbr[c * 4 + 1] = a.y; bbr[c * 4 + 2] = a.z; bbr[c * 4 + 3] = a.w;
      bbi[c * 4] = bb.x; bbi[c * 4 + 1] = bb.y; bbi[c * 4 + 2] = bb.z; bbi[c * 4 + 3] = bb.w;
    }
    const float abr = AB[pi * 2], abi = AB[pi * 2 + 1];
    const size_t t0 = (size_t)b * 2048 + chunk * 64;
    wave_lds_sync();
    {
      const u16* row = PE + (t0 + lane) * 1280 + g * 16;
      uint4 a = *(const uint4*)row, c = *(const uint4*)(row + 8);
      float* d = Us + lane * 16;
      *(float4*)(d) = float4{lo2f(a.x), hi2f(a.x), lo2f(a.y), hi2f(a.y)};
      *(float4*)(d + 4) = float4{lo2f(a.z), hi2f(a.z), lo2f(a.w), hi2f(a.w)};
      *(float4*)(d + 8) = float4{lo2f(c.x), hi2f(c.x), lo2f(c.y), hi2f(c.y)};
      *(float4*)(d + 12) = float4{lo2f(c.z), hi2f(c.z), lo2f(c.w), hi2f(c.w)};
    }
    wave_lds_sync();
    float hr = 0.f, hi = 0.f;
    for (int t = 0; t < 64; ++t) {
      float bur = 0.f, bui = 0.f;
#pragma unroll
      for (int c = 0; c < 4; ++c) {
        float4 u = *(const float4*)(Us + t * 16 + c * 4);
        bur += bbr[c * 4] * u.x + bbr[c * 4 + 1] * u.y + bbr[c * 4 + 2] * u.z + bbr[c * 4 + 3] * u.w;
        bui += bbi[c * 4] * u.x + bbi[c * 4 + 1] * u.y + bbi[c * 4 + 2] * u.z + bbi[c * 4 + 3] * u.w;
      }
      float nr = abr * hr - abi * hi + bur, ni = abr * hi + abi * hr + bui;
      hr = nr; hi = ni;
    }
    E[(size_t)it * 64 + lane] = float2{hr, hi};
  }
}

DI void s5_pass3(const Params& p, int i, char* smem) {
  const int lane = otid() & 63, wid = otid() >> 6, fr = lane & 15, fq = lane >> 4;
  float* Us = (float*)smem + wid * 1024;
  u16* Hs = (u16*)(smem + 16384) + wid * (16 * 136);
  const u16* PE = (const u16*)(p.ws + WS_PE);
  const float* AB = (const float*)(p.ws + WS_AB); const float* BBR = (const float*)(p.ws + WS_BBR); const float* BBI = (const float*)(p.ws + WS_BBI);
  const u16* CT = (const u16*)(p.ws + WS_CT);
  const float2* E = (const float2*)(p.ws + WS_E);
  u16* G = (u16*)(p.ws + WS_G);
  for (int it = obid() * 4 + wid; it < 8192 + 4096; it += gridDim.x * 4) {
    const bool smp = it >= 8192;
    int g, chunk, b, count; size_t t0;
    if (!smp) { g = it & 31; chunk = (it >> 5) & 31; b = it >> 10; count = 64; t0 = (size_t)b * 2048 + chunk * 64; }
    else { int r = it - 8192; g = r & 31; b = r >> 5; chunk = 0; count = 1; t0 = (size_t)TP + b; }
    const size_t pi = ((size_t)i * 32 + g) * 64 + lane;
    float bbr[16], bbi[16];
#pragma unroll
    for (int c = 0; c < 4; ++c) {
      float4 a = *(const float4*)(BBR + pi * 16 + c * 4), bb = *(const float4*)(BBI + pi * 16 + c * 4);
      bbr[c * 4] = a.x; bbr[c * 4 + 1] = a.y; bbr[c * 4 + 2] = a.z; bbr[c * 4 + 3] = a.w;
      bbi[c * 4] = bb.x; bbi[c * 4 + 1] = bb.y; bbi[c * 4 + 2] = bb.z; bbi[c * 4 + 3] = bb.w;
    }
    const float abr = AB[pi * 2], abi = AB[pi * 2 + 1];
    float hr = 0.f, hi = 0.f;
    if (!smp) {
      float qr = abr, qi = abi;
#pragma unroll
      for (int s = 0; s < 6; ++s) { float nr = qr * qr - qi * qi, ni = 2.f * qr * qi; qr = nr; qi = ni; }
      for (int j = 0; j < chunk; ++j) {
        float2 e = E[(((size_t)b * 32 + j) * 32 + g) * 64 + lane];
        float nr = qr * hr - qi * hi + e.x, ni = qr * hi + qi * hr + e.y;
        hr = nr; hi = ni;
      }
    } else {
      const size_t so = (((size_t)i * 128 + b) * 32 + g) * 64 + lane;
      float h0r = p.in[2][so], h0i = p.in[3][so];
      hr = h0r; hi = h0i;
    }
    bf16x8 ctf[4];
#pragma unroll
    for (int ks = 0; ks < 4; ++ks) ctf[ks] = *(const bf16x8*)(CT + (((size_t)i * 32 + g) * 16 + fr) * 128 + ks * 32 + fq * 8);
    const float4 d4 = *(const float4*)(p.in[16] + (size_t)i * 512 + g * 16 + fq * 4);
    wave_lds_sync();
    {
      float* d = Us + lane * 16;
      if (lane < count) {
        const u16* row = PE + (t0 + lane) * 1280 + g * 16;
        uint4 a = *(const uint4*)row, c = *(const uint4*)(row + 8);
        *(float4*)(d) = float4{lo2f(a.x), hi2f(a.x), lo2f(a.y), hi2f(a.y)};
        *(float4*)(d + 4) = float4{lo2f(a.z), hi2f(a.z), lo2f(a.w), hi2f(a.w)};
        *(float4*)(d + 8) = float4{lo2f(c.x), hi2f(c.x), lo2f(c.y), hi2f(c.y)};
        *(float4*)(d + 12) = float4{lo2f(c.z), hi2f(c.z), lo2f(c.w), hi2f(c.w)};
      } else {
        *(float4*)(d) = float4{0, 0, 0, 0}; *(float4*)(d + 4) = float4{0, 0, 0, 0};
        *(float4*)(d + 8) = float4{0, 0, 0, 0}; *(float4*)(d + 12) = float4{0, 0, 0, 0};
      }
    }
    wave_lds_sync();
    const int nsub = (count + 15) >> 4;
    for (int sub = 0; sub < nsub; ++sub) {
      for (int tt = 0; tt < 16; ++tt) {
        const int t = sub * 16 + tt;
        float wr_ = 0.f, wi_ = 0.f;
        if (t < count) {
          float bur = 0.f, bui = 0.f;
#pragma unroll
          for (int c = 0; c < 4; ++c) {
            float4 u = *(const float4*)(Us + t * 16 + c * 4);
            bur += bbr[c * 4] * u.x + bbr[c * 4 + 1] * u.y + bbr[c * 4 + 2] * u.z + bbr[c * 4 + 3] * u.w;
            bui += bbi[c * 4] * u.x + bbi[c * 4 + 1] * u.y + bbi[c * 4 + 2] * u.z + bbi[c * 4 + 3] * u.w;
          }
          float nr = abr * hr - abi * hi + bur, ni = abr * hi + abi * hr + bui;
          hr = nr; hi = ni; wr_ = hr; wi_ = hi;
        }
        Hs[tt * 136 + lane] = f2bf(wr_);
        Hs[tt * 136 + 64 + lane] = f2bf(wi_);
      }
      wave_lds_sync();
      f32x4 acc = f32x4{0.f, 0.f, 0.f, 0.f};
#pragma unroll
      for (int ks = 0; ks < 4; ++ks) {
        bf16x8 hf = *(const bf16x8*)(Hs + fr * 136 + ks * 32 + fq * 8);
        acc = mfma16(ctf[ks], hf, acc);
      }
      const int t = sub * 16 + fr;
      if (t < count) {
        float4 u4 = *(const float4*)(Us + t * 16 + fq * 4);
        float y0 = gelu_tanh(acc[0] + d4.x * u4.x), y1 = gelu_tanh(acc[1] + d4.y * u4.y);
        float y2 = gelu_tanh(acc[2] + d4.z * u4.z), y3 = gelu_tanh(acc[3] + d4.w * u4.w);
        st_bf4(G + (t0 + t) * 512 + g * 16 + fq * 4, y0, y1, y2, y3);
      }
      wave_lds_sync();
    }
    if (smp) {
      const size_t so = (((size_t)i * 128 + b) * 32 + g) * 64 + lane;
      p.out[O_SS5RE + so] = hr; p.out[O_SS5IM + so] = hi;
    } else if (chunk == 31) {
      const size_t so = (((size_t)i * 8 + b) * 32 + g) * 64 + lane;
      p.out[O_PS5RE + so] = hr; p.out[O_PS5IM + so] = hi;
    }
  }
}

constexpr int VTS = 264;
DI void swa_prompt(const Params& p, int i, char* smem) {
  const int tid = otid(), lane = tid & 63, w = tid >> 6, fr = lane & 15, fq = lane >> 4;
  u16* Vt = (u16*)smem;
  const u16* PE = (const u16*)(p.ws + WS_PE);
  u16* CAT = (u16*)(p.ws + WS_CAT);
  for (int it = obid(); it < 1024; it += gridDim.x) {
    const int qb = it & 15, h = (it >> 4) & 7, b = it >> 7, kvh = h >> 2;
    const float slope = exp2f(-(float)(h + 1));
    const float sink = p.in[18][i * 8 + h];
    __syncthreads();
    {
      const int l = qb * 128 - 128 + tid;
      u32x4 v[8];
      if (l >= 0) {
        const u16* row = PE + ((size_t)b * 2048 + l) * 1280 + 1152 + kvh * 64;
#pragma unroll
        for (int c = 0; c < 8; ++c) v[c] = *(const u32x4*)(row + c * 8);
      } else {
#pragma unroll
        for (int c = 0; c < 8; ++c) v[c] = u32x4{0, 0, 0, 0};
      }
#pragma unroll
      for (int c = 0; c < 8; ++c) {
#pragma unroll
        for (int q = 0; q < 4; ++q) {
          Vt[(c * 8 + 2 * q) * VTS + tid] = (u16)(v[c][q] & 0xffff);
          Vt[(c * 8 + 2 * q + 1) * VTS + tid] = (u16)(v[c][q] >> 16);
        }
      }
    }
    __syncthreads();
#pragma unroll 1
    for (int qt = 0; qt < 2; ++qt) {
      const int rq = 32 * w + 16 * qt, kt0 = 2 * w + qt;
      const size_t qtok = (size_t)b * 2048 + qb * 128 + rq + fr;
      bf16x8 qf[2];
#pragma unroll
      for (int ks = 0; ks < 2; ++ks) qf[ks] = *(const bf16x8*)(PE + qtok * 1280 + 512 + h * 64 + ks * 32 + fq * 8);
      f32x4 s[9];
#pragma unroll
      for (int c = 0; c < 9; ++c) {
        s[c] = f32x4{0.f, 0.f, 0.f, 0.f};
        const int l = qb * 128 - 128 + (kt0 + c) * 16 + fr;
#pragma unroll
        for (int ks = 0; ks < 2; ++ks) {
          bf16x8 kf = bf16x8{0, 0, 0, 0, 0, 0, 0, 0};
          if (l >= 0) kf = *(const bf16x8*)(PE + ((size_t)b * 2048 + l) * 1280 + 1024 + kvh * 64 + ks * 32 + fq * 8);
          s[c] = mfma16(kf, qf[ks], s[c]);
        }
      }
      const int r = rq + fr;
      float mx = -1e30f;
#pragma unroll
      for (int c = 0; c < 9; ++c)
#pragma unroll
        for (int j = 0; j < 4; ++j) {
          const int kl = (kt0 + c) * 16 + fq * 4 + j;
          const int dist = 128 + r - kl;
          const bool valid = dist >= 0 && dist < 128 && (qb * 128 - 128 + kl) >= 0;
          float sc = valid ? s[c][j] * 0.125f - slope * (float)dist : -1e30f;
          s[c][j] = sc; mx = fmaxf(mx, sc);
        }
      mx = fmaxf(mx, __shfl_xor(mx, 16)); mx = fmaxf(mx, __shfl_xor(mx, 32));
      const float m = fmaxf(mx, sink);
      float sum = 0.f;
#pragma unroll
      for (int c = 0; c < 9; ++c)
#pragma unroll
        for (int j = 0; j < 4; ++j) { float e = __expf(s[c][j] - m); s[c][j] = e; sum += e; }
      sum += __shfl_xor(sum, 16); sum += __shfl_xor(sum, 32);
      const float inv = 1.f / (sum + __expf(sink - m));
      f32x4 o[4];
#pragma unroll
      for (int d = 0; d < 4; ++d) o[d] = f32x4{0.f, 0.f, 0.f, 0.f};
#pragma unroll
      for (int pr = 0; pr < 5; ++pr) {
        const int ia = 2 * pr, ib = 2 * pr + 1;
        uint4 pk;
        pk.x = pack2(s[ia][0], s[ia][1]); pk.y = pack2(s[ia][2], s[ia][3]);
        if (ib < 9) { pk.z = pack2(s[ib < 9 ? ib : 8][0], s[ib < 9 ? ib : 8][1]); pk.w = pack2(s[ib < 9 ? ib : 8][2], s[ib < 9 ? ib : 8][3]); }
        else { pk.z = 0; pk.w = 0; }
        const bf16x8 pf = mk8(pk);
        int ta = kt0 + ia, tb = kt0 + ib; if (tb > 15) tb = 15;
#pragma unroll
        for (int d = 0; d < 4; ++d) {
          const u16* vr = Vt + (d * 16 + fr) * VTS;
          uint2 va = *(const uint2*)(vr + ta * 16 + fq * 4), vb = *(const uint2*)(vr + tb * 16 + fq * 4);
          o[d] = mfma16(mk8(uint4{va.x, va.y, vb.x, vb.y}), pf, o[d]);
        }
      }
#pragma unroll
      for (int d = 0; d < 4; ++d)
        st_bf4(CAT + qtok * 1024 + 512 + h * 64 + d * 16 + fq * 4, o[d][0] * inv, o[d][1] * inv, o[d][2] * inv, o[d][3] * inv);
    }
  }
}

DI void swa_sample(const Params& p, int i, char* smem) {
  const int lane = otid() & 63, wid = otid() >> 6;
  float* Ps = (float*)smem + wid * 128;
  const u16* PE = (const u16*)(p.ws + WS_PE);
  u16* CAT = (u16*)(p.ws + WS_CAT);
  for (int it = obid() * 4 + wid; it < 1024; it += gridDim.x * 4) {
    const int h = it & 7, s = it >> 3, kvh = h >> 2;
    const float slope = exp2f(-(float)(h + 1));
    const float sink = p.in[18][i * 8 + h];
    const size_t tok = (size_t)TP + s;
    const u16* qrow = PE + tok * 1280 + 512 + h * 64;
    const u16* knew = PE + tok * 1280 + 1024 + kvh * 64;
    const u16* vnew = PE + tok * 1280 + 1152 + kvh * 64;
    const float* kc = p.in[4] + (((size_t)i * 128 + s) * 128) * 128 + kvh * 64;
    const float* vc = p.in[5] + (((size_t)i * 128 + s) * 128) * 128 + kvh * 64;
    float sc[2];
#pragma unroll
    for (int hh = 0; hh < 2; ++hh) {
      const int id = lane + hh * 64;
      float dot = 0.f;
      if (id < 127) {
        const float* kr = kc + (size_t)(id + 1) * 128;
        for (int d = 0; d < 64; d += 4) {
          float4 kv = *(const float4*)(kr + d);
          uint2 qq = *(const uint2*)(qrow + d);
          dot += kv.x * lo2f(qq.x) + kv.y * hi2f(qq.x) + kv.z * lo2f(qq.y) + kv.w * hi2f(qq.y);
        }
      } else {
        for (int d = 0; d < 64; d += 4) {
          uint2 kk = *(const uint2*)(knew + d);
          uint2 qq = *(const uint2*)(qrow + d);
          dot += lo2f(kk.x) * lo2f(qq.x) + hi2f(kk.x) * hi2f(qq.x) + lo2f(kk.y) * lo2f(qq.y) + hi2f(kk.y) * hi2f(qq.y);
        }
      }
      sc[hh] = dot * 0.125f - slope * (float)(127 - id);
    }
    float mx = fmaxf(sc[0], sc[1]);
#pragma unroll
    for (int o = 32; o > 0; o >>= 1) mx = fmaxf(mx, __shfl_xor(mx, o));
    const float m = fmaxf(mx, sink);
    float e0 = __expf(sc[0] - m), e1 = __expf(sc[1] - m);
    float sum = e0 + e1;
#pragma unroll
    for (int o = 32; o > 0; o >>= 1) sum += __shfl_xor(sum, o);
    const float inv = 1.f / (sum + __expf(sink - m));
    wave_lds_sync();
    Ps[lane] = e0 * inv; Ps[lane + 64] = e1 * inv;
    wave_lds_sync();
    float o = 0.f;
    for (int id = 0; id < 127; ++id) o += Ps[id] * vc[(size_t)(id + 1) * 128 + lane];
    o += Ps[127] * bf2f(vnew[lane]);
    CAT[tok * 1024 + 512 + h * 64 + lane] = f2bf(o);
  }
}

DI void phase_e_glu(const Params& p, int i, char* smem) {
  const u16* G = (const u16*)(p.ws + WS_G);
  const u16* W = (const u16*)(p.ws + WS_WGLU) + (size_t)i * 512 * 512;
  u16* CAT = (u16*)(p.ws + WS_CAT);
  for (int t = obid(); t < 129 * 4; t += gridDim.x) {
    const int mt = t / 4, nt = t % 4;
    gemm_tile(G, 512, W, 512, 512, mt * 128, nt * 128, (u16*)smem, [&](int tok, int n, f32x4 v, int, int) {
      uint2 gg = *(const uint2*)(G + (size_t)tok * 512 + n);
      float g0 = lo2f(gg.x), g1 = hi2f(gg.x), g2 = lo2f(gg.y), g3 = hi2f(gg.y);
      st_bf4(CAT + (size_t)tok * 1024 + n, g0 * sigmoidf_(v[0]), g1 * sigmoidf_(v[1]), g2 * sigmoidf_(v[2]), g3 * sigmoidf_(v[3]));
    });
  }
}

DI void phase_outproj(const Params& p, const u16* A, int K, const u16* W, bool use_ssq, char* smem) {
  const float* X = (const float*)(p.ws + WS_X);
  float* R = (float*)(p.ws + WS_R);
  const float* SSQ = (const float*)(p.ws + WS_SSQ);
  for (int t = obid(); t < 129 * 8; t += gridDim.x) {
    const int mt = t / 8, nt = t % 8;
    gemm_tile(A, K, W, K, K, mt * 128, nt * 128, (u16*)smem, [&](int tok, int n, f32x4 v, int, int) {
      float sc = 1.f;
      if (use_ssq) {
        float ssum = 0.f;
#pragma unroll
        for (int q = 0; q < 8; ++q) { float4 s4 = *(const float4*)(SSQ + (size_t)tok * 32 + q * 4); ssum += (s4.x + s4.y) + (s4.z + s4.w); }
        sc = rsqrtf(ssum * (1.f / 2048.f) + 1e-5f);
      }
      float4 x = *(const float4*)(X + (size_t)tok * 1024 + n);
      *(float4*)(R + (size_t)tok * 1024 + n) = float4{ALPHA * x.x + sc * v[0], ALPHA * x.y + sc * v[1], ALPHA * x.z + sc * v[2], ALPHA * x.w + sc * v[3]};
    });
  }
}

DI void phase_ln1(const Params& p, int layer) {
  const int lane = otid() & 63, wid = otid() >> 6;
  const float* R = (const float*)(p.ws + WS_R);
  float* X = (float*)(p.ws + WS_X); u16* Xb = (u16*)(p.ws + WS_XB);
  const float* gam = p.in[28] + (size_t)layer * 1024; const float* bet = p.in[29] + (size_t)layer * 1024;
  for (int tok = obid() * 4 + wid; tok < T; tok += gridDim.x * 4) {
    float4 v[4];
    float s = 0.f;
#pragma unroll
    for (int c = 0; c < 4; ++c) { v[c] = *(const float4*)(R + (size_t)tok * 1024 + c * 256 + lane * 4); s += v[c].x + v[c].y + v[c].z + v[c].w; }
#pragma unroll
    for (int o = 32; o > 0; o >>= 1) s += __shfl_xor(s, o);
    const float mu = s * (1.f / 1024.f);
    float q = 0.f;
#pragma unroll
    for (int c = 0; c < 4; ++c) { float a = v[c].x - mu, b = v[c].y - mu, cc = v[c].z - mu, d = v[c].w - mu; q += a * a + b * b + cc * cc + d * d; }
#pragma unroll
    for (int o = 32; o > 0; o >>= 1) q += __shfl_xor(q, o);
    const float rstd = rsqrtf(q * (1.f / 1024.f) + 1e-5f);
#pragma unroll
    for (int c = 0; c < 4; ++c) {
      const int col = c * 256 + lane * 4;
      float4 g = *(const float4*)(gam + col), bb = *(const float4*)(bet + col);
      float4 o = float4{(v[c].x - mu) * rstd * g.x + bb.x, (v[c].y - mu) * rstd * g.y + bb.y, (v[c].z - mu) * rstd * g.z + bb.z, (v[c].w - mu) * rstd * g.w + bb.w};
      *(float4*)(X + (size_t)tok * 1024 + col) = o;
      st_bf4(Xb + (size_t)tok * 1024 + col, o.x, o.y, o.z, o.w);
    }
  }
}

DI unsigned sortkey(float f) { unsigned u = __float_as_uint(f); return u ^ ((u >> 31) ? 0xffffffffu : 0x80000000u); }
DI float unsortkey(unsigned k) { unsigned u = (k & 0x80000000u) ? (k ^ 0x80000000u) : ~k; return __uint_as_float(u); }

constexpr int QSS = 136;
constexpr int PEER_LST_OFF = GEMM_SMEM;
DI void phase_peer1(const Params& p, int layer, char* smem) {
  const int tid = otid(), lane = tid & 63, w = tid >> 6, fr = lane & 15, fq = lane >> 4;
  const u16* Xb = (const u16*)(p.ws + WS_XB);
  const u16* WQ = (const u16*)(p.ws + WS_WQ) + (size_t)layer * 2048 * 1024;
  u16* Qs = (u16*)smem;
  unsigned* Ls = (unsigned*)(smem + PEER_LST_OFF);
  int* IDX = (int*)(p.ws + WS_IDX); float* GATE = (float*)(p.ws + WS_GATE);
  for (int it = obid(); it < 129 * 8; it += gridDim.x) {
    const int mt = it >> 3, h = it & 7;
#pragma unroll 1
    for (int half = 0; half < 2; ++half) {
      const int m0 = mt * 128, n0 = h * 256 + half * 128;
      gemm_tile<true>(Xb, 1024, WQ, 1024, 1024, m0, n0, (u16*)smem, [&](int tok, int n, f32x4 v, int, int) {
        st_bf4(Qs + (tok - m0) * QSS + (n - n0), v[0], v[1], v[2], v[3]);
      });
      __syncthreads();
      const u16* KT = (const u16*)(p.ws + (half ? WS_K2 : WS_K1)) + ((size_t)layer * 8 + h) * 128 * 128;
#pragma unroll 1
      for (int tt = 0; tt < 2; ++tt) {
        bf16x8 qf[4];
#pragma unroll
        for (int ks = 0; ks < 4; ++ks) qf[ks] = *(const bf16x8*)(Qs + (32 * w + tt * 16 + fr) * QSS + ks * 32 + fq * 8);
        unsigned k[32];
#pragma unroll
        for (int kt = 0; kt < 8; ++kt) {
          f32x4 sc = f32x4{0.f, 0.f, 0.f, 0.f};
#pragma unroll
          for (int ks = 0; ks < 4; ++ks) {
            bf16x8 kf = *(const bf16x8*)(KT + (size_t)(kt * 16 + fr) * 128 + ks * 32 + fq * 8);
            sc = mfma16(kf, qf[ks], sc);
          }
#pragma unroll
          for (int j = 0; j < 4; ++j) k[kt * 4 + j] = (sortkey(sc[j]) & ~127u) | (unsigned)(kt * 16 + fq * 4 + j);
          if (kt & 1) __builtin_amdgcn_sched_barrier(0);
        }
        unsigned* lp = Ls + (32 * w + tt * 16 + fr) * 32 + half * 16;
#pragma unroll 1
        for (int r = 0; r < 16; ++r) {
          unsigned m = k[0];
#pragma unroll
          for (int q = 1; q < 32; ++q) m = m > k[q] ? m : k[q];
          unsigned o = __shfl_xor(m, 16); m = m > o ? m : o;
          o = __shfl_xor(m, 32); m = m > o ? m : o;
          if (fq == 0) lp[r] = m;
#pragma unroll
          for (int q = 0; q < 32; ++q) k[q] = (k[q] == m) ? 0u : k[q];
        }
      }
    }
    wave_lds_sync();
#pragma unroll 1
    for (int tt = 0; tt < 2; ++tt) {
      const unsigned* lp = Ls + (32 * w + tt * 16 + fr) * 32;
      float sum[21]; unsigned key[21]; int eidx[21];
      unsigned l2[16];
#pragma unroll
      for (int j = 0; j < 16; ++j) l2[j] = lp[16 + j];
#pragma unroll
      for (int m = 0; m < 4; ++m) {
        const unsigned a = lp[4 * m + fq];
        const float av = unsortkey(a & ~127u); const int ai = (int)(a & 127u);
        const int J = m == 0 ? 16 : m == 1 ? 3 : 1;
        const int base = m == 0 ? 0 : m == 1 ? 16 : m == 2 ? 19 : 20;
#pragma unroll
        for (int j = 0; j < J; ++j) {
          const unsigned b = l2[j];
          const float sj = av + unsortkey(b & ~127u);
          sum[base + j] = sj;
          key[base + j] = (sortkey(sj) & ~127u) | (unsigned)(fq << 5) | (unsigned)(base + j);
          eidx[base + j] = ai * 128 + (int)(b & 127u);
        }
      }
      const size_t tok = (size_t)mt * 128 + 32 * w + tt * 16 + fr;
      int* ip = IDX + tok * 128 + h * 16; float* gp = GATE + tok * 128 + h * 16;
      float mxs = 0.f;
#pragma unroll 1
      for (int r = 0; r < 16; ++r) {
        unsigned m = key[0];
#pragma unroll
        for (int c = 1; c < 21; ++c) m = m > key[c] ? m : key[c];
        unsigned o = __shfl_xor(m, 16); m = m > o ? m : o;
        o = __shfl_xor(m, 32); m = m > o ? m : o;
        float ws_ = -3.0e38f; int wi = 0;
#pragma unroll
        for (int c = 0; c < 21; ++c) { const bool hit = key[c] == m; ws_ = hit ? sum[c] : ws_; wi = hit ? eidx[c] : wi; key[c] = hit ? 0u : key[c]; }
        ws_ = fmaxf(ws_, __shfl_xor(ws_, 16)); ws_ = fmaxf(ws_, __shfl_xor(ws_, 32));
        int oi = __shfl_xor(wi, 16); wi = wi > oi ? wi : oi;
        oi = __shfl_xor(wi, 32); wi = wi > oi ? wi : oi;
        if (r == 0) mxs = ws_;
        if (fq == 0) { ip[r] = wi; gp[r] = __expf(ws_ - mxs); }
      }
    }
    wave_lds_sync();
  }
}

typedef __attribute__((ext_vector_type(2))) float f32x2;
DI void dec16(u32x4 r, f32x2 (&o)[8]) {
#pragma unroll
  for (int q = 0; q < 4; ++q) { o[2 * q] = __builtin_amdgcn_cvt_pk_f32_fp8((int)r[q], false); o[2 * q + 1] = __builtin_amdgcn_cvt_pk_f32_fp8((int)r[q], true); }
}
DI float dpp_f(float v, const int ctrl_sel) {
  const int x = __builtin_bit_cast(int, v);
  int r;
  if (ctrl_sel == 0) r = __builtin_amdgcn_update_dpp(0, x, 0xB1, 0xF, 0xF, true);
  else if (ctrl_sel == 1) r = __builtin_amdgcn_update_dpp(0, x, 0x4E, 0xF, 0xF, true);
  else if (ctrl_sel == 2) r = __builtin_amdgcn_update_dpp(0, x, 0x141, 0xF, 0xF, true);
  else r = __builtin_amdgcn_update_dpp(0, x, 0x140, 0xF, 0xF, true);
  return __builtin_bit_cast(float, r);
}
DI float wave_sum_uniform(float v) {
  v += dpp_f(v, 0); v += dpp_f(v, 1); v += dpp_f(v, 2); v += dpp_f(v, 3);
  const int x = __builtin_bit_cast(int, v);
  const float r0 = __builtin_bit_cast(float, __builtin_amdgcn_readlane(x, 0)), r1 = __builtin_bit_cast(float, __builtin_amdgcn_readlane(x, 16));
  const float r2 = __builtin_bit_cast(float, __builtin_amdgcn_readlane(x, 32)), r3 = __builtin_bit_cast(float, __builtin_amdgcn_readlane(x, 48));
  return (r0 + r1) + (r2 + r3);
}
DI void phase_peer3(const Params& p, int layer) {
  const int lane = otid() & 63, wid = otid() >> 6;
  const unsigned char* UB = (const unsigned char*)(p.ws + WS_UB); const unsigned char* VB = (const unsigned char*)(p.ws + WS_VB);
  const int* IDX = (const int*)(p.ws + WS_IDX); const float* GATE = (const float*)(p.ws + WS_GATE);
  float* X = (float*)(p.ws + WS_X); u16* Xb = (u16*)(p.ws + WS_XB);
  const float* gam = p.in[30] + (size_t)layer * 1024; const float* bet = p.in[31] + (size_t)layer * 1024;
  const bool last = layer == 3;
  for (int tok = obid() * 4 + wid; tok < T; tok += gridDim.x * 4) {
    f32x2 x2[8];
    {
      const float* xr = X + (size_t)tok * 1024 + lane * 16;
#pragma unroll
      for (int q = 0; q < 4; ++q) { float4 a = *(const float4*)(xr + q * 4); x2[2 * q] = f32x2{a.x, a.y}; x2[2 * q + 1] = f32x2{a.z, a.w}; }
    }
    const int id0 = IDX[(size_t)tok * 128 + lane], id1 = IDX[(size_t)tok * 128 + 64 + lane];
    float g0 = GATE[(size_t)tok * 128 + lane], g1 = GATE[(size_t)tok * 128 + 64 + lane];
    {
      float d0 = g0, d1 = g1;
#pragma unroll
      for (int o = 1; o < 16; o <<= 1) { d0 += __shfl_xor(d0, o); d1 += __shfl_xor(d1, o); }
      g0 /= d0; g1 /= d1;
    }
    float h0 = 0.f, h1 = 0.f;
#pragma unroll 4
    for (int e = 0; e < 64; ++e) {
      const int idx = __builtin_amdgcn_readlane(id0, e);
      const u32x4 r = *(const u32x4*)(UB + (size_t)idx * 1024 + lane * 16);
      f32x2 d[8]; dec16(r, d);
      f32x2 a2 = d[0] * x2[0];
#pragma unroll
      for (int q = 1; q < 8; ++q) a2 += d[q] * x2[q];
      const float sm = wave_sum_uniform(a2.x + a2.y);
      h0 = (lane == e) ? sm : h0;
    }
#pragma unroll 4
    for (int e = 0; e < 64; ++e) {
      const int idx = __builtin_amdgcn_readlane(id1, e);
      const u32x4 r = *(const u32x4*)(UB + (size_t)idx * 1024 + lane * 16);
      f32x2 d[8]; dec16(r, d);
      f32x2 a2 = d[0] * x2[0];
#pragma unroll
      for (int q = 1; q < 8; ++q) a2 += d[q] * x2[q];
      const float sm = wave_sum_uniform(a2.x + a2.y);
      h1 = (lane == e) ? sm : h1;
    }
    const float a0 = gelu_tanh(h0 * (1.f / U8_SCALE)) * g0 * (1.f / V8_SCALE), a1 = gelu_tanh(h1 * (1.f / U8_SCALE)) * g1 * (1.f / V8_SCALE);
    f32x2 y2[8];
#pragma unroll
    for (int q = 0; q < 8; ++q) y2[q] = f32x2{0.f, 0.f};
#pragma unroll 8
    for (int e = 0; e < 128; ++e) {
      const int idx = e < 64 ? __builtin_amdgcn_readlane(id0, e) : __builtin_amdgcn_readlane(id1, e - 64);
      const float av = __builtin_bit_cast(float, e < 64 ? __builtin_amdgcn_readlane(__builtin_bit_cast(int, a0), e) : __builtin_amdgcn_readlane(__builtin_bit_cast(int, a1), e - 64));
      const u32x4 r = *(const u32x4*)(VB + (size_t)idx * 1024 + lane * 16);
      f32x2 d[8]; dec16(r, d);
      const f32x2 av2 = f32x2{av, av};
#pragma unroll
      for (int q = 0; q < 8; ++q) y2[q] += d[q] * av2;
    }
    float y[16];
    float s = 0.f;
#pragma unroll
    for (int q = 0; q < 8; ++q) { y[2 * q] = ALPHA * x2[q].x + y2[q].x; y[2 * q + 1] = ALPHA * x2[q].y + y2[q].y; s += y[2 * q] + y[2 * q + 1]; }
#pragma unroll
    for (int o = 32; o > 0; o >>= 1) s += __shfl_xor(s, o);
    const float mu = s * (1.f / 1024.f);
    float qv = 0.f;
#pragma unroll
    for (int q = 0; q < 16; ++q) { float dd = y[q] - mu; qv += dd * dd; }
#pragma unroll
    for (int o = 32; o > 0; o >>= 1) qv += __shfl_xor(qv, o);
    const float rstd = rsqrtf(qv * (1.f / 1024.f) + 1e-5f);
    const int col = lane * 16;
    float o16[16];
#pragma unroll
    for (int q = 0; q < 4; ++q) {
      float4 ga = *(const float4*)(gam + col + q * 4), ba = *(const float4*)(bet + col + q * 4);
      o16[q * 4] = (y[q * 4] - mu) * rstd * ga.x + ba.x; o16[q * 4 + 1] = (y[q * 4 + 1] - mu) * rstd * ga.y + ba.y;
      o16[q * 4 + 2] = (y[q * 4 + 2] - mu) * rstd * ga.z + ba.z; o16[q * 4 + 3] = (y[q * 4 + 3] - mu) * rstd * ga.w + ba.w;
    }
    float* dst = last ? (p.out + O_Y + (size_t)tok * 1024 + col) : (X + (size_t)tok * 1024 + col);
#pragma unroll
    for (int q = 0; q < 4; ++q) *(float4*)(dst + q * 4) = float4{o16[q * 4], o16[q * 4 + 1], o16[q * 4 + 2], o16[q * 4 + 3]};
    if (!last) {
      u32x4 o; o[0] = pack2(o16[0], o16[1]); o[1] = pack2(o16[2], o16[3]); o[2] = pack2(o16[4], o16[5]); o[3] = pack2(o16[6], o16[7]);
      *(u32x4*)(Xb + (size_t)tok * 1024 + col) = o;
      o[0] = pack2(o16[8], o16[9]); o[1] = pack2(o16[10], o16[11]); o[2] = pack2(o16[12], o16[13]); o[3] = pack2(o16[14], o16[15]);
      *(u32x4*)(Xb + (size_t)tok * 1024 + col + 8) = o;
    }
  }
}

DI void phase_o_inproj(const Params& p, int i, char* smem) {
  const u16* Xb = (const u16*)(p.ws + WS_XB);
  const u16* W = (const u16*)(p.ws + WS_WINO) + (size_t)i * 5248 * 1024;
  u16* Z = (u16*)(p.ws + WS_Z); u16* XBCR = (u16*)(p.ws + WS_XBCR); float* DTR = (float*)(p.ws + WS_DTR);
  float* out = p.out;
  for (int t = obid(); t < 129 * 41; t += gridDim.x) {
    const int mt = t / 41, nt = t % 41;
    gemm_tile(Xb, 1024, W, 1024, 1024, mt * 128, nt * 128, (u16*)smem, [&](int tok, int n, f32x4 v, int, int) {
      if (n < 2048) st_bf4(Z + (size_t)tok * 2048 + n, v[0], v[1], v[2], v[3]);
      else if (n < 5120) {
        const int c = n - 2048;
        st_bf4(XBCR + (size_t)tok * 3072 + c, v[0], v[1], v[2], v[3]);
        if (tok >= TP) *(float4*)(out + O_SCONV + (((size_t)i * 128 + (tok - TP)) * 3 + 2) * 3072 + c) = float4{v[0], v[1], v[2], v[3]};
        else {
          const int b = tok >> 11, l = tok & 2047;
          if (l >= 2045) *(float4*)(out + O_PCONV + (((size_t)i * 8 + b) * 3 + (l - 2045)) * 3072 + c) = float4{v[0], v[1], v[2], v[3]};
        }
      } else if (n < 5152) *(float4*)(DTR + (size_t)tok * 32 + (n - 5120)) = float4{v[0], v[1], v[2], v[3]};
    });
  }
}

DI void phase_o_conv(const Params& p, int i, char* smem) {
  const int tid = otid();
  const size_t gtid = (size_t)obid() * 256 + tid, gsz = (size_t)gridDim.x * 256;
  const u16* XBCR = (const u16*)(p.ws + WS_XBCR);
  u16* XS = (u16*)(p.ws + WS_XS); u16* BM = (u16*)(p.ws + WS_BM); u16* CM = (u16*)(p.ws + WS_CM);
  u16* XST = (u16*)(p.ws + WS_XST); u16* BMT = (u16*)(p.ws + WS_BMT);
  const float* cw = p.in[21] + (size_t)i * 4 * 3072; const float* cb = p.in[22] + (size_t)i * 3072;
  float* raw = (float*)smem;
  u16* ys = (u16*)(smem + 67 * 64 * 4);
  for (int it = obid(); it < 256 * 48; it += gridDim.x) {
    const int ct = it % 48, tt = it / 48;
    const int t0 = tt * 64, l0 = t0 & 2047, c0 = ct * 64, b = t0 >> 11;
    const int c = tid & 63, r4 = tid >> 6;
    __syncthreads();
    for (int r = r4; r < 67; r += 4) {
      const int l = l0 - 3 + r;
      raw[r * 64 + c] = l >= 0 ? bf2f(XBCR[(size_t)(t0 - 3 + r) * 3072 + c0 + c]) : 0.f;
    }
    __syncthreads();
    const int ch = c0 + c;
    const float w0 = cw[ch], w1 = cw[3072 + ch], w2 = cw[2 * 3072 + ch], w3 = cw[3 * 3072 + ch], bs = cb[ch];
#pragma unroll
    for (int k = 0; k < 16; ++k) {
      const int r = r4 + 4 * k;
      float y = bs + w0 * raw[r * 64 + c] + w1 * raw[(r + 1) * 64 + c] + w2 * raw[(r + 2) * 64 + c] + w3 * raw[(r + 3) * 64 + c];
      const u16 yb = f2bf(siluf_(y));
      const size_t tok = (size_t)t0 + r;
      if (ch < 2048) XS[tok * 2048 + ch] = yb;
      else if (ch < 2560) BM[tok * 512 + ch - 2048] = yb;
      else CM[tok * 512 + ch - 2560] = yb;
      ys[r * 66 + c] = yb;
    }
    if (c0 < 2560) {
      __syncthreads();
      const int s = tid & 63, chunk = l0 >> 7, so = (l0 & 127) + s;
#pragma unroll
      for (int k = 0; k < 16; ++k) {
        const int cc = r4 + 4 * k;
        const u16 val = ys[s * 66 + cc];
        if (c0 < 2048) XST[(((size_t)b * 16 + chunk) * 2048 + c0 + cc) * 128 + so] = val;
        else BMT[(((size_t)b * 16 + chunk) * 512 + (c0 - 2048) + cc) * 128 + so] = val;
      }
    }
  }
  for (size_t e = gtid; e < (size_t)128 * 3072; e += gsz) {
    const int s = (int)(e / 3072), ch = (int)(e % 3072);
    const float* st = p.in[7] + ((size_t)i * 128 + s) * 3 * 3072 + ch;
    const size_t tok = (size_t)TP + s;
    float y = cb[ch] + cw[ch] * st[0] + cw[3072 + ch] * st[3072] + cw[2 * 3072 + ch] * st[2 * 3072] + cw[3 * 3072 + ch] * bf2f(XBCR[tok * 3072 + ch]);
    const u16 yb = f2bf(siluf_(y));
    if (ch < 2048) XS[tok * 2048 + ch] = yb;
    else if (ch < 2560) BM[tok * 512 + ch - 2048] = yb;
    else CM[tok * 512 + ch - 2560] = yb;
  }
  {
    const float* DTR = (const float*)(p.ws + WS_DTR); float* DT = (float*)(p.ws + WS_DT);
    const float* bias = p.in[23] + (size_t)i * 32;
    for (size_t e = gtid; e < (size_t)T * 32; e += gsz) {
      float x = DTR[e] + bias[e & 31];
      DT[e] = x > 20.f ? x : log1pf(expf(x));
    }
  }
}

DI void chunk_scan(const float* DT, size_t tok0, int h, float a, float* acs, float* dts, float* tot) {
  const int tid = otid(), lane = tid & 63;
  float d = 0.f, v = 0.f;
  __syncthreads();
  if (tid < 128) {
    d = DT[(tok0 + tid) * 32 + h];
    v = d * a;
#pragma unroll
    for (int o = 1; o < 64; o <<= 1) { float n = __shfl_up(v, o); if (lane >= o) v += n; }
    if (tid == 63) tot[0] = v;
  }
  __syncthreads();
  if (tid < 128) {
    if (tid >= 64) v += tot[0];
    acs[tid] = v; dts[tid] = d;
  }
  __syncthreads();
}

DI void phase_o_states(const Params& p, int i, char* smem) {
  const int tid = otid(), lane = tid & 63, w = tid >> 6, fr = lane & 15, fq = lane >> 4;
  float* acs = (float*)smem; float* dts = acs + 128; float* wgt = dts + 128; float* tot = wgt + 128;
  const float* DT = (const float*)(p.ws + WS_DT);
  const u16* XST = (const u16*)(p.ws + WS_XST); const u16* BMT = (const u16*)(p.ws + WS_BMT);
  float* ST = (float*)(p.ws + WS_ST); float* DEC = (float*)(p.ws + WS_DEC);
  for (int it = obid(); it < 4096; it += gridDim.x) {
    const int h = it & 31, chunk = (it >> 5) & 15, b = it >> 9, g = h >> 3;
    const float a = -expf(p.in[24][i * 32 + h]);
    const size_t tok0 = (size_t)b * 2048 + chunk * 128;
    chunk_scan(DT, tok0, h, a, acs, dts, tot);
    const float lastv = acs[127];
    if (tid < 128) wgt[tid] = __expf(lastv - acs[tid]) * dts[tid];
    if (tid == 0) DEC[((size_t)b * 16 + chunk) * 32 + h] = __expf(lastv);
    __syncthreads();
    const size_t bc = (size_t)b * 16 + chunk;
    f32x4 acc[4][2];
#pragma unroll
    for (int pt = 0; pt < 4; ++pt) { acc[pt][0] = f32x4{0.f, 0.f, 0.f, 0.f}; acc[pt][1] = f32x4{0.f, 0.f, 0.f, 0.f}; }
#pragma unroll
    for (int ks = 0; ks < 4; ++ks) {
      const int s0 = ks * 32 + fq * 8;
      const float4 wa = *(const float4*)(wgt + s0), wb = *(const float4*)(wgt + s0 + 4);
      bf16x8 bmf[2];
#pragma unroll
      for (int nt = 0; nt < 2; ++nt) bmf[nt] = *(const bf16x8*)(BMT + ((bc * 512 + g * 128 + 32 * w + nt * 16 + fr) * 128 + s0));
#pragma unroll
      for (int pt = 0; pt < 4; ++pt) {
        uint4 xr = *(const uint4*)(XST + ((bc * 2048 + h * 64 + pt * 16 + fr) * 128 + s0));
        uint4 xw;
        xw.x = pack2(lo2f(xr.x) * wa.x, hi2f(xr.x) * wa.y); xw.y = pack2(lo2f(xr.y) * wa.z, hi2f(xr.y) * wa.w);
        xw.z = pack2(lo2f(xr.z) * wb.x, hi2f(xr.z) * wb.y); xw.w = pack2(lo2f(xr.w) * wb.z, hi2f(xr.w) * wb.w);
        const bf16x8 xf = mk8(xw);
        acc[pt][0] = mfma16(bmf[0], xf, acc[pt][0]);
        acc[pt][1] = mfma16(bmf[1], xf, acc[pt][1]);
      }
    }
#pragma unroll
    for (int pt = 0; pt < 4; ++pt)
#pragma unroll
      for (int nt = 0; nt < 2; ++nt)
        *(float4*)(ST + (((bc * 32 + h) * 64 + pt * 16 + fr) * 128 + 32 * w + nt * 16 + fq * 4)) = float4{acc[pt][nt][0], acc[pt][nt][1], acc[pt][nt][2], acc[pt][nt][3]};
  }
}

DI void phase_o_scan(const Params& p, int i) {
  const size_t gtid = (size_t)obid() * 256 + otid(), gsz = (size_t)gridDim.x * 256;
  float* ST = (float*)(p.ws + WS_ST); const float* DEC = (const float*)(p.ws + WS_DEC);
  for (size_t e = gtid; e < (size_t)524288; e += gsz) {
    const int n4 = (int)(e & 31), pp = (int)((e >> 5) & 63), h = (int)((e >> 11) & 31), b = (int)(e >> 16);
    float4 carry = float4{0.f, 0.f, 0.f, 0.f};
    for (int c = 0; c < 16; ++c) {
      const size_t ad = ((((size_t)b * 16 + c) * 32 + h) * 64 + pp) * 128 + n4 * 4;
      const float dec = DEC[((size_t)b * 16 + c) * 32 + h];
      const float4 tmp = *(const float4*)(ST + ad);
      *(float4*)(ST + ad) = carry;
      carry = float4{dec * carry.x + tmp.x, dec * carry.y + tmp.y, dec * carry.z + tmp.z, dec * carry.w + tmp.w};
    }
    *(float4*)(p.out + O_PSSD + ((((size_t)i * 8 + b) * 32 + h) * 64 + pp) * 128 + n4 * 4) = carry;
  }
}

DI void phase_o_y(const Params& p, int i, char* smem) {
  const int tid = otid(), lane = tid & 63, w = tid >> 6, fr = lane & 15, fq = lane >> 4;
  float* acs = (float*)smem; float* dts = acs + 128; float* tot = dts + 128;
  const float* DT = (const float*)(p.ws + WS_DT);
  const u16* XST = (const u16*)(p.ws + WS_XST); const u16* XS = (const u16*)(p.ws + WS_XS);
  const u16* BM = (const u16*)(p.ws + WS_BM); const u16* CM = (const u16*)(p.ws + WS_CM); const u16* Z = (const u16*)(p.ws + WS_Z);
  const float* ST = (const float*)(p.ws + WS_ST);
  u16* YG = (u16*)(p.ws + WS_YG); float* SSQ = (float*)(p.ws + WS_SSQ);
  for (int it = obid(); it < 8192; it += gridDim.x) {
    if (it < 4096) {
      const int h = it & 31, chunk = (it >> 5) & 15, b = it >> 9, g = h >> 3;
      const float a = -expf(p.in[24][i * 32 + h]);
      const float Dh = p.in[25][i * 32 + h];
      const size_t tok0 = (size_t)b * 2048 + chunk * 128;
      const size_t bc = (size_t)b * 16 + chunk;
      chunk_scan(DT, tok0, h, a, acs, dts, tot);
      for (int q = 0; q < 2; ++q) {
        const int tt = q == 0 ? w : 7 - w;
        const int tl = tt * 16 + fr;
        bf16x8 cmf[4];
#pragma unroll
        for (int ks = 0; ks < 4; ++ks) cmf[ks] = *(const bf16x8*)(CM + (tok0 + tl) * 512 + g * 128 + ks * 32 + fq * 8);
        f32x4 acc[4];
#pragma unroll
        for (int pt = 0; pt < 4; ++pt) acc[pt] = f32x4{0.f, 0.f, 0.f, 0.f};
#pragma unroll
        for (int ks = 0; ks < 4; ++ks)
#pragma unroll
          for (int pt = 0; pt < 4; ++pt) {
            const float* sp = ST + (((bc * 32 + h) * 64 + pt * 16 + fr) * 128 + ks * 32 + fq * 8);
            float4 sa = *(const float4*)sp, sb = *(const float4*)(sp + 4);
            uint4 sv; sv.x = pack2(sa.x, sa.y); sv.y = pack2(sa.z, sa.w); sv.z = pack2(sb.x, sb.y); sv.w = pack2(sb.z, sb.w);
            acc[pt] = mfma16(mk8(sv), cmf[ks], acc[pt]);
          }
        const float at = acs[tl];
        const float ea = __expf(at);
#pragma unroll
        for (int pt = 0; pt < 4; ++pt) { acc[pt][0] *= ea; acc[pt][1] *= ea; acc[pt][2] *= ea; acc[pt][3] *= ea; }
        for (int sp = 0; sp * 2 <= tt; ++sp) {
          uint4 mk;
#pragma unroll
          for (int half = 0; half < 2; ++half) {
            const int st = 2 * sp + half;
            f32x4 cb = f32x4{0.f, 0.f, 0.f, 0.f};
            if (st <= tt) {
#pragma unroll
              for (int ks = 0; ks < 4; ++ks) {
                bf16x8 bmf = *(const bf16x8*)(BM + (tok0 + st * 16 + fr) * 512 + g * 128 + ks * 32 + fq * 8);
                cb = mfma16(bmf, cmf[ks], cb);
              }
            }
            float mv[4];
#pragma unroll
            for (int j = 0; j < 4; ++j) {
              const int sl = st * 16 + fq * 4 + j;
              float m = 0.f;
              if (st <= tt && sl <= tl) m = cb[j] * __expf(at - acs[sl]) * dts[sl];
              mv[j] = m;
            }
            if (half == 0) { mk.x = pack2(mv[0], mv[1]); mk.y = pack2(mv[2], mv[3]); }
            else { mk.z = pack2(mv[0], mv[1]); mk.w = pack2(mv[2], mv[3]); }
          }
          const bf16x8 mf = mk8(mk);
#pragma unroll
          for (int pt = 0; pt < 4; ++pt) {
            const u16* xr = XST + ((bc * 2048 + h * 64 + pt * 16 + fr) * 128);
            uint2 xa = *(const uint2*)(xr + (2 * sp) * 16 + fq * 4), xb = *(const uint2*)(xr + (2 * sp + 1) * 16 + fq * 4);
            acc[pt] = mfma16(mk8(uint4{xa.x, xa.y, xb.x, xb.y}), mf, acc[pt]);
          }
        }
        const size_t tok = tok0 + tl;
        float ss = 0.f;
#pragma unroll
        for (int pt = 0; pt < 4; ++pt) {
          const int col = h * 64 + pt * 16 + fq * 4;
          uint2 xv = *(const uint2*)(XS + tok * 2048 + col), zv = *(const uint2*)(Z + tok * 2048 + col);
          float y0 = (acc[pt][0] + Dh * lo2f(xv.x)) * siluf_(lo2f(zv.x));
          float y1 = (acc[pt][1] + Dh * hi2f(xv.x)) * siluf_(hi2f(zv.x));
          float y2 = (acc[pt][2] + Dh * lo2f(xv.y)) * siluf_(lo2f(zv.y));
          float y3 = (acc[pt][3] + Dh * hi2f(xv.y)) * siluf_(hi2f(zv.y));
          st_bf4(YG + tok * 2048 + col, y0, y1, y2, y3);
          ss += y0 * y0 + y1 * y1 + y2 * y2 + y3 * y3;
        }
        ss += __shfl_xor(ss, 16); ss += __shfl_xor(ss, 32);
        if (fq == 0) SSQ[tok * 32 + h] = ss;
      }
    } else {
      const int r = it - 4096, h = r & 31, s = r >> 5, g = h >> 3;
      const float a = -expf(p.in[24][i * 32 + h]);
      const float Dh = p.in[25][i * 32 + h];
      const size_t tok = (size_t)TP + s;
      const int pp = tid >> 2, nq = tid & 3;
      const float dtv = DT[tok * 32 + h];
      const float dA = __expf(dtv * a);
      const float xv = bf2f(XS[tok * 2048 + h * 64 + pp]);
      const size_t ad = ((((size_t)i * 128 + s) * 32 + h) * 64 + pp) * 128 + nq * 32;
      const float dx = dtv * xv;
      float yp = 0.f;
#pragma unroll
      for (int k = 0; k < 8; ++k) {
        float4 s0 = *(const float4*)(p.in[6] + ad + 4 * k);
        uint2 bv = *(const uint2*)(BM + tok * 512 + g * 128 + nq * 32 + 4 * k), cv = *(const uint2*)(CM + tok * 512 + g * 128 + nq * 32 + 4 * k);
        float4 nw = float4{dA * s0.x + dx * lo2f(bv.x), dA * s0.y + dx * hi2f(bv.x), dA * s0.z + dx * lo2f(bv.y), dA * s0.w + dx * hi2f(bv.y)};
        *(float4*)(p.out + O_SSSD + ad + 4 * k) = nw;
        yp += nw.x * lo2f(cv.x) + nw.y * hi2f(cv.x) + nw.z * lo2f(cv.y) + nw.w * hi2f(cv.y);
      }
      yp += __shfl_xor(yp, 1); yp += __shfl_xor(yp, 2);
      const float yg = (yp + Dh * xv) * siluf_(bf2f(Z[tok * 2048 + h * 64 + pp]));
      float ss = 0.f;
      if (nq == 0) { YG[tok * 2048 + h * 64 + pp] = f2bf(yg); ss = yg * yg; }
#pragma unroll
      for (int o = 32; o > 0; o >>= 1) ss += __shfl_xor(ss, o);
      __syncthreads();
      if (lane == 0) tot[w] = ss;
      __syncthreads();
      if (tid == 0) SSQ[tok * 32 + h] = (tot[0] + tot[1]) + (tot[2] + tot[3]);
    }
  }
}

constexpr int SMEM_BYTES = GEMM_SMEM + 128 * 32 * 4;
#ifndef PROBE_ID
#define PROBE_ID 0
#endif
#define TIMED(id, ...) { long long t0_ = 0; if (PROBE_ID == (id)) t0_ = wall_clock64(); __VA_ARGS__; if (PROBE_ID == (id)) tacc += wall_clock64() - t0_; }
__global__ void __launch_bounds__(256, 2) mega_kernel(Params p) {
  __shared__ __attribute__((aligned(16))) char smem[SMEM_BYTES];
  __shared__ uint4 xb_words;
  if (threadIdx.x == 0) xb_words = make_uint4(0u, 0u, 0u, 0u);
  __syncthreads();
  XcdBarrier bar = xcd_barrier_post((unsigned*)(p.ws + WS_BAR), (volatile LAS unsigned*)&xb_words);
  long long tacc = 0;
  TIMED(1, phase_prep(p, smem); cg::this_grid().sync();)
  for (int layer = 0; layer < 4; ++layer) {
    const int i = layer >> 1;
    if ((layer & 1) == 0) {
      TIMED(2, convert_tables(p, layer); phase_e_inproj(p, i, smem); xcd_barrier(bar);)
      TIMED(3,
        s5_pass1(p, i, smem);
        __syncthreads();
        swa_prompt(p, i, smem);
        __syncthreads();
        swa_sample(p, i, smem);
        xcd_barrier(bar);
        s5_pass3(p, i, smem);
        xcd_barrier(bar);
        phase_e_glu(p, i, smem);
        xcd_barrier(bar);)
      TIMED(4, phase_outproj(p, (const u16*)(p.ws + WS_CAT), 1024, (const u16*)(p.ws + WS_WOUTE) + (size_t)i * 1024 * 1024, false, smem);
        xcd_barrier(bar);)
    } else {
      TIMED(2, convert_tables(p, layer); phase_o_inproj(p, i, smem); xcd_barrier(bar);)
      TIMED(5,
        phase_o_conv(p, i, smem);
        xcd_barrier(bar);
        phase_o_states(p, i, smem);
        xcd_barrier(bar);
        phase_o_scan(p, i);
        xcd_barrier(bar);
        phase_o_y(p, i, smem);
        xcd_barrier(bar);)
      TIMED(4, phase_outproj(p, (const u16*)(p.ws + WS_YG), 2048, (const u16*)(p.ws + WS_WOUTO) + (size_t)i * 1024 * 2048, true, smem);
        xcd_barrier(bar);)
    }
    TIMED(4, phase_ln1(p, layer); xcd_barrier(bar);)
    TIMED(6, phase_peer1(p, layer, smem); xcd_barrier(bar);)
    TIMED(7, phase_peer3(p, layer); xcd_barrier(bar);)
  }
  if (PROBE_ID != 0 && blockIdx.x == 0 && threadIdx.x == 0) {
    const long long t0 = wall_clock64();
    while (wall_clock64() - t0 < tacc) __builtin_amdgcn_s_sleep(8);
  }
}

extern "C" void kernel_launch(void* const* d_in, const int* in_sizes, int n_in, void* d_out, int out_size, void* d_ws,
                              size_t ws_size, hipStream_t stream) {
  static int grid_blocks = 0;
  if (!grid_blocks) {
    int dev = 0, cus = 0, per_cu = 0;
    hipGetDevice(&dev);
    hipDeviceGetAttribute(&cus, hipDeviceAttributeMultiprocessorCount, dev);
    hipOccupancyMaxActiveBlocksPerMultiprocessor(&per_cu, mega_kernel, 256, 0);
    if (per_cu > 2) per_cu = 2;
    if (per_cu < 1) per_cu = 1;
    grid_blocks = cus * per_cu;
  }
  if (ws_size < WS_END) { fprintf(stderr, "workspace too small: %zu < %zu\n", ws_size, (size_t)WS_END); return; }
  Params p{};
  for (int k = 0; k < 37; ++k) p.in[k] = (const float*)d_in[k];
  p.out = (float*)d_out;
  p.ws = (char*)d_ws;
  hipMemsetAsync((char*)d_ws + WS_BAR, 0, 16384, stream);
  void* args[] = {&p};
  hipError_t e = hipLaunchCooperativeKernel((void*)mega_kernel, dim3(grid_blocks), dim3(256), args, 0, stream);
  if (e != hipSuccess) fprintf(stderr, "cooperative launch failed: %s (grid %d)\n", hipGetErrorString(e), grid_blocks);
}
```

```cpp
#include <hip/hip_runtime.h>
#include <hip/hip_cooperative_groups.h>
#include <cstdio>
#include <cstdint>
namespace cg = cooperative_groups;

typedef unsigned short u16;
typedef __attribute__((ext_vector_type(8))) short bf16x8;
typedef __attribute__((ext_vector_type(4))) short bf16x4;
typedef __attribute__((ext_vector_type(4))) float f32x4;
typedef __attribute__((ext_vector_type(2))) __bf16 bf2;
typedef __attribute__((ext_vector_type(4))) unsigned u32x4;

#define DI __device__ __forceinline__

constexpr int T = 16512, TP = 16384, NSMP = 128;
constexpr float ALPHA = 1.681792830507429f;

constexpr size_t O_Y = 0;
constexpr size_t O_PS5RE = (size_t)T * 1024;
constexpr size_t O_PS5IM = O_PS5RE + 32768;
constexpr size_t O_PSWAK = O_PS5IM + 32768;
constexpr size_t O_PSWAV = O_PSWAK + 262144;
constexpr size_t O_PSSD = O_PSWAV + 262144;
constexpr size_t O_PCONV = O_PSSD + 4194304;
constexpr size_t O_SS5RE = O_PCONV + 147456;
constexpr size_t O_SS5IM = O_SS5RE + 524288;
constexpr size_t O_SSWAK = O_SS5IM + 524288;
constexpr size_t O_SSWAV = O_SSWAK + 4194304;
constexpr size_t O_SSSD = O_SSWAV + 4194304;
constexpr size_t O_SCONV = O_SSSD + 67108864;

constexpr size_t WS_BAR = 0;
constexpr size_t WS_X = 16384;
constexpr size_t WS_XB = WS_X + (size_t)T * 1024 * 4;
constexpr size_t WS_SSQ = WS_XB + (size_t)T * 1024 * 2;
constexpr size_t WS_IDX = WS_SSQ + (size_t)T * 32 * 4;
constexpr size_t WS_GATE = WS_IDX + (size_t)T * 128 * 4;
constexpr size_t WS_DT = WS_GATE + (size_t)T * 128 * 4;
constexpr size_t WS_DTR = WS_DT + (size_t)T * 32 * 4;
constexpr size_t WS_DEC = WS_DTR + (size_t)T * 32 * 4;
constexpr size_t WS_AB = WS_DEC + 16384;
constexpr size_t WS_BBR = WS_AB + 32768;
constexpr size_t WS_BBI = WS_BBR + 262144;
constexpr size_t WS_CT = WS_BBI + 262144;
constexpr size_t WS_E = WS_CT + 262144;
constexpr size_t WS_WINE = WS_E + 4194304;
constexpr size_t WS_WGLU = WS_WINE + (size_t)2 * 1280 * 1024 * 2;
constexpr size_t WS_WOUTE = WS_WGLU + (size_t)2 * 512 * 512 * 2;
constexpr size_t WS_WINO = WS_WOUTE + (size_t)2 * 1024 * 1024 * 2;
constexpr size_t WS_WOUTO = WS_WINO + (size_t)2 * 5248 * 1024 * 2;
constexpr size_t WS_WQ = WS_WOUTO + (size_t)2 * 1024 * 2048 * 2;
constexpr size_t WS_K1 = WS_WQ + (size_t)4 * 2048 * 1024 * 2;
constexpr size_t WS_K2 = WS_K1 + (size_t)4 * 8 * 128 * 128 * 2;
constexpr size_t WS_UB = WS_K2 + (size_t)4 * 8 * 128 * 128 * 2;
constexpr size_t WS_VB = WS_UB + (size_t)16384 * 1024 * 2;
constexpr size_t WS_ACT = WS_VB + (size_t)16384 * 1024 * 2;
constexpr size_t WS_Z = WS_ACT;
constexpr size_t WS_XBCR = WS_Z + (size_t)T * 2048 * 2;
constexpr size_t WS_R = WS_XBCR;
constexpr size_t WS_XS = WS_XBCR + (size_t)T * 3072 * 2;
constexpr size_t WS_BM = WS_XS + (size_t)T * 2048 * 2;
constexpr size_t WS_CM = WS_BM + (size_t)T * 512 * 2;
constexpr size_t WS_XST = WS_CM + (size_t)T * 512 * 2;
constexpr size_t WS_BMT = WS_XST + (size_t)TP * 2048 * 2;
constexpr size_t WS_ST = WS_BMT + (size_t)TP * 512 * 2;
constexpr size_t WS_YG = WS_ST + (size_t)8 * 16 * 32 * 64 * 128 * 4;
constexpr size_t WS_ACTP = WS_YG + (size_t)T * 2048 * 2;
constexpr size_t WS_IDXP = WS_ACTP + (size_t)T * 128 * 4;
constexpr size_t WS_END = WS_IDXP + (size_t)T * 128 * 4;
constexpr size_t WS_PE = WS_Z;
constexpr size_t WS_G = WS_XS;
constexpr size_t WS_CAT = WS_YG;

struct Params {
  const float* in[37];
  float* out;
  char* ws;
};

DI u16 f2bf(float f) { unsigned u = __float_as_uint(f); u += 0x7fffu + ((u >> 16) & 1u); return (u16)(u >> 16); }
DI float bf2f(u16 h) { return __uint_as_float(((unsigned)h) << 16); }
DI unsigned pack2(float a, float b) { return (unsigned)f2bf(a) | ((unsigned)f2bf(b) << 16); }
DI float lo2f(unsigned u) { return __uint_as_float(u << 16); }
DI float hi2f(unsigned u) { return __uint_as_float(u & 0xffff0000u); }
DI float gelu_tanh(float x) {
  float u = 0.7978845608028654f * (x + 0.044715f * x * x * x);
  float e = __expf(2.f * u);
  float th = 1.f - 2.f / (e + 1.f);
  return 0.5f * x * (1.f + th);
}
DI float sigmoidf_(float x) { return 1.f / (1.f + __expf(-x)); }
DI float siluf_(float x) { return x / (1.f + __expf(-x)); }
DI f32x4 mfma16(bf16x8 a, bf16x8 b, f32x4 c) { return __builtin_amdgcn_mfma_f32_16x16x32_bf16(a, b, c, 0, 0, 0); }
DI void wave_lds_sync() { __builtin_amdgcn_fence(__ATOMIC_ACQ_REL, "workgroup"); __builtin_amdgcn_wave_barrier(); }
DI void st_bf4(u16* dst, float a, float b, float c, float d) { uint2 v; v.x = pack2(a, b); v.y = pack2(c, d); *(uint2*)dst = v; }
DI bf16x8 mk8(uint4 v) { return __builtin_bit_cast(bf16x8, v); }

#define XB_TMO      128
#define XB_XCNT(j)  (256  + 64 * (j))
#define XB_XSUB(j)  (1280 + 64 * (j))
#define XB_XGEN(j)  (2304 + 64 * (j))
#define XB_TOP      3328
#define XB_TOPGEN   3392
#define XCD_BAR_WORDS 3456
#define XB_SPIN_CAP (1u << 22)
#define LAS __attribute__((address_space(3)))
DI unsigned xb_ld(unsigned* p) { return __hip_atomic_load(p, __ATOMIC_RELAXED, __HIP_MEMORY_SCOPE_AGENT); }
DI unsigned xb_add(unsigned* p, unsigned v) { return __hip_atomic_fetch_add(p, v, __ATOMIC_RELAXED, __HIP_MEMORY_SCOPE_AGENT); }
DI unsigned xb_xcc_id() { return (unsigned)__builtin_amdgcn_s_getreg((3 << 11) | 20) & 0xFu; }
#define XB_SPIN(cond, bar) do { unsigned _sp = 0; while (cond) { __builtin_amdgcn_s_sleep(1); \
    if ((++_sp & 255u) == 0u) { if (xb_ld(&(bar)[XB_TMO])) break; if (_sp > XB_SPIN_CAP) { atomicAdd(&(bar)[XB_TMO], 1u); break; } } } } while (0)
struct XcdBarrier { unsigned* bar; unsigned x; volatile LAS unsigned* st; };
DI XcdBarrier xcd_barrier_post(unsigned* bar, volatile LAS unsigned* st) {
  XcdBarrier b; b.bar = bar; b.x = xb_xcc_id(); b.st = st;
  if (threadIdx.x == 0) (void)xb_add(&bar[XB_XCNT(b.x)], 1u);
  return b;
}
DI void xcd_barrier_complete(unsigned* bar, unsigned x, unsigned& nloc, unsigned& nx) {
  const unsigned G = gridDim.x;
  unsigned sum, cnt, mine, sp = 0u;
  for (;;) {
    sum = 0u; cnt = 0u; mine = 0u;
#pragma unroll
    for (unsigned j = 0; j < 16; ++j) { const unsigned c = xb_ld(&bar[XB_XCNT(j)]); sum += c; cnt += (c > 0u) ? 1u : 0u; mine = (j == x) ? c : mine; }
    if (sum == G) break;
    __builtin_amdgcn_s_sleep(1);
    if ((++sp & 255u) == 0u) { if (xb_ld(&bar[XB_TMO])) break; if (sp > XB_SPIN_CAP) { atomicAdd(&bar[XB_TMO], 1u); break; } }
  }
  nloc = mine > 0u ? mine : 1u; nx = cnt > 0u ? cnt : 1u;
}
DI void xcd_barrier(const XcdBarrier& b) {
  asm volatile("s_waitcnt vmcnt(0)" ::: "memory");
  __syncthreads();
  if (threadIdx.x == 0) {
    unsigned* bar = b.bar;
    __builtin_amdgcn_s_waitcnt(0);
    unsigned nloc = b.st[0], nx = b.st[1];
    if (nloc == 0u) { xcd_barrier_complete(bar, b.x, nloc, nx); b.st[0] = nloc; b.st[1] = nx; }
    const unsigned old = xb_add(&bar[XB_XSUB(b.x)], 1u);
    const unsigned gen = old / nloc;
    if (old + 1u == (gen + 1u) * nloc) {
      __builtin_amdgcn_fence(__ATOMIC_RELEASE, "agent");
      asm volatile("s_waitcnt vmcnt(0)" ::: "memory");
      const unsigned og = xb_add(&bar[XB_TOP], 1u);
      const unsigned tg = og / nx;
      if (og + 1u == (tg + 1u) * nx) xb_add(&bar[XB_TOPGEN], 1u);
      else XB_SPIN(xb_ld(&bar[XB_TOPGEN]) == tg, bar);
      __builtin_amdgcn_fence(__ATOMIC_ACQUIRE, "agent");
      xb_add(&bar[XB_XGEN(b.x)], 1u);
      asm volatile("s_waitcnt vmcnt(0)" ::: "memory");
    } else {
      XB_SPIN(xb_ld(&bar[XB_XGEN(b.x)]) == gen, bar);
      __builtin_amdgcn_fence(__ATOMIC_ACQUIRE, "agent");
      asm volatile("s_waitcnt vmcnt(0)" ::: "memory");
    }
  }
  __syncthreads();
}

DI int otid() { int t = threadIdx.x; asm volatile("" : "+v"(t)); return t; }
DI int obid() { int t = blockIdx.x; asm volatile("" : "+s"(t)); return t; }

constexpr int LDSS = 72;
constexpr int GEMM_SMEM = 2 * 128 * LDSS * 2;
template <bool SYNC_EPI = false, class Epi>
DI void gemm_tile(const u16* __restrict__ A, int lda, const u16* __restrict__ Bt, int ldb, int K, int m0, int n0,
                  u16* sm, Epi&& epi) {
  u16* sA = sm; u16* sB = sm + 128 * LDSS;
  const int tid = otid(), lane = tid & 63, wid = tid >> 6, wr = wid >> 1, wc = wid & 1, fr = lane & 15, fq = lane >> 4;
  const int lr = tid >> 3, lc = (tid & 7) * 8;
  const u16* ga = A + (size_t)(m0 + lr) * lda + lc;
  const u16* gb = Bt + (size_t)(n0 + lr) * ldb + lc;
  u32x4 ra[4], rb[4];
#pragma unroll
  for (int i = 0; i < 4; ++i) { ra[i] = *(const u32x4*)(ga + (size_t)(32 * i) * lda); rb[i] = *(const u32x4*)(gb + (size_t)(32 * i) * ldb); }
  f32x4 acc[4][4];
#pragma unroll
  for (int m = 0; m < 4; ++m)
#pragma unroll
    for (int n = 0; n < 4; ++n) acc[m][n] = f32x4{0.f, 0.f, 0.f, 0.f};
  for (int k0 = 0; k0 < K; k0 += 64) {
    __syncthreads();
#pragma unroll
    for (int i = 0; i < 4; ++i) {
      *(u32x4*)(sA + (lr + 32 * i) * LDSS + lc) = ra[i];
      *(u32x4*)(sB + (lr + 32 * i) * LDSS + lc) = rb[i];
    }
    __syncthreads();
    if (k0 + 64 < K) {
#pragma unroll
      for (int i = 0; i < 4; ++i) {
        ra[i] = *(const u32x4*)(ga + (size_t)(32 * i) * lda + k0 + 64);
        rb[i] = *(const u32x4*)(gb + (size_t)(32 * i) * ldb + k0 + 64);
      }
    }
#pragma unroll
    for (int ks = 0; ks < 2; ++ks) {
      bf16x8 af[4], bfr[4];
#pragma unroll
      for (int m = 0; m < 4; ++m) af[m] = *(const bf16x8*)(sA + (wr * 64 + m * 16 + fr) * LDSS + ks * 32 + fq * 8);
#pragma unroll
      for (int n = 0; n < 4; ++n) bfr[n] = *(const bf16x8*)(sB + (wc * 64 + n * 16 + fr) * LDSS + ks * 32 + fq * 8);
#pragma unroll
      for (int m = 0; m < 4; ++m)
#pragma unroll
        for (int n = 0; n < 4; ++n) acc[m][n] = mfma16(bfr[n], af[m], acc[m][n]);
    }
  }
  if (SYNC_EPI) __syncthreads();
#pragma unroll
  for (int m = 0; m < 4; ++m)
#pragma unroll
    for (int n = 0; n < 4; ++n) epi(m0 + wr * 64 + m * 16 + fr, n0 + wc * 64 + n * 16 + fq * 4, acc[m][n], m, n);
}

struct WJob { const float* src; u16* dst; int K, N, Npad; const float* scale; };
DI WJob get_wjob(const Params& p, int j) {
  WJob w; w.scale = nullptr;
  if (j < 2) { w.src = p.in[8] + (size_t)j * 1024 * 1280; w.dst = (u16*)(p.ws + WS_WINE) + (size_t)j * 1280 * 1024; w.K = 1024; w.N = 1280; w.Npad = 1280; }
  else if (j < 4) { int i = j - 2; w.src = p.in[17] + (size_t)i * 512 * 512; w.dst = (u16*)(p.ws + WS_WGLU) + (size_t)i * 512 * 512; w.K = 512; w.N = 512; w.Npad = 512; }
  else if (j < 6) { int i = j - 4; w.src = p.in[19] + (size_t)i * 1024 * 1024; w.dst = (u16*)(p.ws + WS_WOUTE) + (size_t)i * 1024 * 1024; w.K = 1024; w.N = 1024; w.Npad = 1024; }
  else if (j < 8) { int i = j - 6; w.src = p.in[20] + (size_t)i * 1024 * 5152; w.dst = (u16*)(p.ws + WS_WINO) + (size_t)i * 5248 * 1024; w.K = 1024; w.N = 5152; w.Npad = 5248; }
  else if (j < 10) { int i = j - 8; w.src = p.in[27] + (size_t)i * 2048 * 1024; w.dst = (u16*)(p.ws + WS_WOUTO) + (size_t)i * 1024 * 2048; w.K = 2048; w.N = 1024; w.Npad = 1024; w.scale = p.in[26] + (size_t)i * 2048; }
  else { int i = j - 10; w.src = p.in[32] + (size_t)i * 1024 * 2048; w.dst = (u16*)(p.ws + WS_WQ) + (size_t)i * 2048 * 1024; w.K = 1024; w.N = 2048; w.Npad = 2048; }
  return w;
}

DI void phase_prep(const Params& p, char* smem) {
  const int tid = otid();
  const size_t gtid = (size_t)obid() * 256 + tid, gsz = (size_t)gridDim.x * 256;
  {
    float* X = (float*)(p.ws + WS_X); u16* Xb = (u16*)(p.ws + WS_XB);
    for (size_t i = gtid; i < (size_t)T * 256; i += gsz) {
      size_t e = i * 4;
      const float* src = e < (size_t)TP * 1024 ? p.in[0] + e : p.in[1] + (e - (size_t)TP * 1024);
      float4 v = *(const float4*)src;
      *(float4*)(X + e) = v;
      st_bf4(Xb + e, v.x, v.y, v.z, v.w);
    }
  }
  {
    float* tile = (float*)smem;
    for (int j = 0; j < 14; ++j) {
      WJob w = get_wjob(p, j);
      const int tk = w.K / 64, tn = w.Npad / 64;
      for (int t = obid(); t < tk * tn; t += gridDim.x) {
        const int k0 = (t % tk) * 64, n0 = (t / tk) * 64;
        const int c = tid & 63, r4 = tid >> 6;
        __syncthreads();
#pragma unroll
        for (int i = 0; i < 16; ++i) {
          int r = r4 + 4 * i;
          float v = 0.f;
          if (n0 + c < w.N) { v = w.src[(size_t)(k0 + r) * w.N + n0 + c]; if (w.scale) v *= w.scale[k0 + r]; }
          tile[r * 65 + c] = v;
        }
        __syncthreads();
#pragma unroll
        for (int i = 0; i < 16; ++i) {
          int nn = r4 + 4 * i;
          w.dst[(size_t)(n0 + nn) * w.K + k0 + c] = f2bf(tile[c * 65 + nn]);
        }
      }
    }
  }
  {
    u16* k1 = (u16*)(p.ws + WS_K1); u16* k2 = (u16*)(p.ws + WS_K2);
    for (size_t i = gtid; i < (size_t)131072; i += gsz) {
      float4 a = *(const float4*)(p.in[33] + i * 4), b = *(const float4*)(p.in[34] + i * 4);
      st_bf4(k1 + i * 4, a.x, a.y, a.z, a.w);
      st_bf4(k2 + i * 4, b.x, b.y, b.z, b.w);
    }
  }
  {
    float* AB = (float*)(p.ws + WS_AB); float* BBR = (float*)(p.ws + WS_BBR); float* BBI = (float*)(p.ws + WS_BBI);
    u16* CT = (u16*)(p.ws + WS_CT);
    for (size_t i = gtid; i < 4096; i += gsz) {
      int ig = (int)(i >> 6), pp = (int)(i & 63);
      float dt = expf(p.in[11][ig]);
      float lr = p.in[9][i], li = p.in[10][i];
      float mag = expf(lr * dt);
      float abr = mag * cosf(li * dt), abi = mag * sinf(li * dt);
      float den = lr * lr + li * li;
      float nr = abr - 1.f, ni = abi;
      float cr = (nr * lr + ni * li) / den, ci = (ni * lr - nr * li) / den;
      AB[i * 2] = abr; AB[i * 2 + 1] = abi;
      for (int c = 0; c < 16; ++c) {
        float br = p.in[12][i * 16 + c], bi = p.in[13][i * 16 + c];
        BBR[i * 16 + c] = cr * br - ci * bi;
        BBI[i * 16 + c] = cr * bi + ci * br;
        CT[((size_t)ig * 16 + c) * 128 + pp] = f2bf(p.in[14][((size_t)ig * 16 + c) * 64 + pp]);
        CT[((size_t)ig * 16 + c) * 128 + 64 + pp] = f2bf(-p.in[15][((size_t)ig * 16 + c) * 64 + pp]);
      }
    }
  }
  {
    for (size_t i = gtid; i < (size_t)2 * 128 * 127 * 32; i += gsz) {
      size_t q = i & 31, row = (i >> 5) % 127, is = (i >> 5) / 127;
      size_t so = (is * 128 + row + 1) * 128 + q * 4, dn = (is * 128 + row) * 128 + q * 4;
      *(float4*)(p.out + O_SSWAK + dn) = *(const float4*)(p.in[4] + so);
      *(float4*)(p.out + O_SSWAV + dn) = *(const float4*)(p.in[5] + so);
    }
    for (size_t i = gtid; i < (size_t)2 * 128 * 2 * 768; i += gsz) {
      size_t q = i % 768, row = (i / 768) & 1, is = i / 1536;
      *(float4*)(p.out + O_SCONV + (is * 3 + row) * 3072 + q * 4) = *(const float4*)(p.in[7] + (is * 3 + row + 1) * 3072 + q * 4);
    }
  }
}

constexpr float U8_SCALE = 256.f, V8_SCALE = 64.f;
DI unsigned enc4(float4 a, float sc) {
  int pk = __builtin_amdgcn_cvt_pk_fp8_f32(a.x * sc, a.y * sc, 0, false);
  pk = __builtin_amdgcn_cvt_pk_fp8_f32(a.z * sc, a.w * sc, pk, true);
  return (unsigned)pk;
}
DI void convert_tables(const Params& p, int layer) {
  const size_t gtid = (size_t)obid() * 256 + otid(), gsz = (size_t)gridDim.x * 256;
  const float* u = p.in[35] + (size_t)layer * 16384 * 1024;
  const float* v = p.in[36] + (size_t)layer * 16384 * 1024;
  unsigned char* ub = (unsigned char*)(p.ws + WS_UB); unsigned char* vb = (unsigned char*)(p.ws + WS_VB);
  for (size_t i = gtid; i < (size_t)16384 * 1024 / 16; i += gsz) {
    u32x4 o;
#pragma unroll
    for (int q = 0; q < 4; ++q) o[q] = enc4(*(const float4*)(u + i * 16 + q * 4), U8_SCALE);
    {
      const size_t e0 = i * 16, row = e0 >> 10, col = e0 & 1023;
      *(u32x4*)(ub + (col >> 7) * (size_t)2097152 + row * 128 + (col & 127)) = o;
    }
#pragma unroll
    for (int q = 0; q < 4; ++q) o[q] = enc4(*(const float4*)(v + i * 16 + q * 4), V8_SCALE);
    {
      const size_t e0 = i * 16, row = e0 >> 10, col = e0 & 1023;
      *(u32x4*)(vb + (col >> 7) * (size_t)2097152 + row * 128 + (col & 127)) = o;
    }
  }
}

DI void phase_e_inproj(const Params& p, int i, char* smem) {
  const u16* Xb = (const u16*)(p.ws + WS_XB);
  const u16* W = (const u16*)(p.ws + WS_WINE) + (size_t)i * 1280 * 1024;
  u16* PE = (u16*)(p.ws + WS_PE);
  float* out = p.out;
  for (int t = obid(); t < 129 * 10; t += gridDim.x) {
    const int mt = t / 10, nt = t % 10;
    gemm_tile(Xb, 1024, W, 1024, 1024, mt * 128, nt * 128, (u16*)smem, [&](int tok, int n, f32x4 v, int, int) {
      st_bf4(PE + (size_t)tok * 1280 + n, v[0], v[1], v[2], v[3]);
      if (n >= 1024) {
        const int isv = n >= 1152; const int col = n - (isv ? 1152 : 1024);
        if (tok >= TP) {
          size_t o = (isv ? O_SSWAV : O_SSWAK) + (((size_t)i * 128 + (tok - TP)) * 128 + 127) * 128 + col;
          *(float4*)(out + o) = float4{v[0], v[1], v[2], v[3]};
        } else {
          const int b = tok >> 11, l = tok & 2047;
          if (l >= 1920) {
            size_t o = (isv ? O_PSWAV : O_PSWAK) + (((size_t)i * 8 + b) * 128 + (l - 1920)) * 128 + col;
            *(float4*)(out + o) = float4{v[0], v[1], v[2], v[3]};
          }
        }
      }
    });
  }
}

DI void s5_pass1(const Params& p, int i, char* smem) {
  const int lane = otid() & 63, wid = otid() >> 6;
  float* Us = (float*)smem + wid * 1024;
  const u16* PE = (const u16*)(p.ws + WS_PE);
  const float* AB = (const float*)(p.ws + WS_AB); const float* BBR = (const float*)(p.ws + WS_BBR); const float* BBI = (const float*)(p.ws + WS_BBI);
  float2* E = (float2*)(p.ws + WS_E);
  for (int it = obid() * 4 + wid; it < 8192; it += gridDim.x * 4) {
    const int g = it & 31, chunk = (it >> 5) & 31, b = it >> 10;
    const size_t pi = ((size_t)i * 32 + g) * 64 + lane;
    float bbr[16], bbi[16];
#pragma unroll
    for (int c = 0; c < 4; ++c) {
      float4 a = *(const float4*)(BBR + pi * 16 + c * 4), bb = *(const float4*)(BBI + pi * 16 + c * 4);
      bbr[c * 4] = a.x; bbr[c * 4 + 1] = a.y; bbr[c * 4 + 2] = a.z; bbr[c * 4 + 3] = a.w;
      bbi[c * 4] = bb.x; bbi[c * 4 + 1] = bb.y; bbi[c * 4 + 2] = bb.z; bbi[c * 4 + 3] = bb.w;
    }
    const float abr = AB[pi * 2], abi = AB[pi * 2 + 1];
    const size_t t0 = (size_t)b * 2048 + chunk * 64;
    wave_lds_sync();
    {
      const u16* row = PE + (t0 + lane) * 1280 + g * 16;
      uint4 a = *(const uint4*)row, c = *(const uint4*)(row + 8);
      float* d = Us + lane * 16;
      *(float4*)(d) = float4{lo2f(a.x), hi2f(a.x), lo2f(a.y), hi2f(a.y)};
      *(float4*)(d + 4) = float4{lo2f(a.z), hi2f(a.z), lo2f(a.w), hi2f(a.w)};
      *(float4*)(d + 8) = float4{lo2f(c.x), hi2f(c.x), lo2f(c.y), hi2f(c.y)};
      *(float4*)(d + 12) = float4{lo2f(c.z), hi2f(c.z), lo2f(c.w), hi2f(c.w)};
    }
    wave_lds_sync();
    float hr = 0.f, hi = 0.f;
    for (int t = 0; t < 64; ++t) {
      float bur = 0.f, bui = 0.f;
#pragma unroll
      for (int c = 0; c < 4; ++c) {
        float4 u = *(const float4*)(Us + t * 16 + c * 4);
        bur += bbr[c * 4] * u.x + bbr[c * 4 + 1] * u.y + bbr[c * 4 + 2] * u.z + bbr[c * 4 + 3] * u.w;
        bui += bbi[c * 4] * u.x + bbi[c * 4 + 1] * u.y + bbi[c * 4 + 2] * u.z + bbi[c * 4 + 3] * u.w;
      }
      float nr = abr * hr - abi * hi + bur, ni = abr * hi + abi * hr + bui;
      hr = nr; hi = ni;
    }
    E[(size_t)it * 64 + lane] = float2{hr, hi};
  }
}

DI void s5_pass3(const Params& p, int i, char* smem) {
  const int lane = otid() & 63, wid = otid() >> 6, fr = lane & 15, fq = lane >> 4;
  float* Us = (float*)smem + wid * 1024;
  u16* Hs = (u16*)(smem + 16384) + wid * (16 * 136);
  const u16* PE = (const u16*)(p.ws + WS_PE);
  const float* AB = (const float*)(p.ws + WS_AB); const float* BBR = (const float*)(p.ws + WS_BBR); const float* BBI = (const float*)(p.ws + WS_BBI);
  const u16* CT = (const u16*)(p.ws + WS_CT);
  const float2* E = (const float2*)(p.ws + WS_E);
  u16* G = (u16*)(p.ws + WS_G);
  for (int it = obid() * 4 + wid; it < 8192 + 4096; it += gridDim.x * 4) {
    const bool smp = it >= 8192;
    int g, chunk, b, count; size_t t0;
    if (!smp) { g = it & 31; chunk = (it >> 5) & 31; b = it >> 10; count = 64; t0 = (size_t)b * 2048 + chunk * 64; }
    else { int r = it - 8192; g = r & 31; b = r >> 5; chunk = 0; count = 1; t0 = (size_t)TP + b; }
    const size_t pi = ((size_t)i * 32 + g) * 64 + lane;
    float bbr[16], bbi[16];
#pragma unroll
    for (int c = 0; c < 4; ++c) {
      float4 a = *(const float4*)(BBR + pi * 16 + c * 4), bb = *(const float4*)(BBI + pi * 16 + c * 4);
      bbr[c * 4] = a.x; bbr[c * 4 + 1] = a.y; bbr[c * 4 + 2] = a.z; bbr[c * 4 + 3] = a.w;
      bbi[c * 4] = bb.x; bbi[c * 4 + 1] = bb.y; bbi[c * 4 + 2] = bb.z; bbi[c * 4 + 3] = bb.w;
    }
    const float abr = AB[pi * 2], abi = AB[pi * 2 + 1];
    float hr = 0.f, hi = 0.f;
    if (!smp) {
      float qr = abr, qi = abi;
#pragma unroll
      for (int s = 0; s < 6; ++s) { float nr = qr * qr - qi * qi, ni = 2.f * qr * qi; qr = nr; qi = ni; }
      for (int j = 0; j < chunk; ++j) {
        float2 e = E[(((size_t)b * 32 + j) * 32 + g) * 64 + lane];
        float nr = qr * hr - qi * hi + e.x, ni = qr * hi + qi * hr + e.y;
        hr = nr; hi = ni;
      }
    } else {
      const size_t so = (((size_t)i * 128 + b) * 32 + g) * 64 + lane;
      float h0r = p.in[2][so], h0i = p.in[3][so];
      hr = h0r; hi = h0i;
    }
    bf16x8 ctf[4];
#pragma unroll
    for (int ks = 0; ks < 4; ++ks) ctf[ks] = *(const bf16x8*)(CT + (((size_t)i * 32 + g) * 16 + fr) * 128 + ks * 32 + fq * 8);
    const float4 d4 = *(const float4*)(p.in[16] + (size_t)i * 512 + g * 16 + fq * 4);
    wave_lds_sync();
    {
      float* d = Us + lane * 16;
      if (lane < count) {
        const u16* row = PE + (t0 + lane) * 1280 + g * 16;
        uint4 a = *(const uint4*)row, c = *(const uint4*)(row + 8);
        *(float4*)(d) = float4{lo2f(a.x), hi2f(a.x), lo2f(a.y), hi2f(a.y)};
        *(float4*)(d + 4) = float4{lo2f(a.z), hi2f(a.z), lo2f(a.w), hi2f(a.w)};
        *(float4*)(d + 8) = float4{lo2f(c.x), hi2f(c.x), lo2f(c.y), hi2f(c.y)};
        *(float4*)(d + 12) = float4{lo2f(c.z), hi2f(c.z), lo2f(c.w), hi2f(c.w)};
      } else {
        *(float4*)(d) = float4{0, 0, 0, 0}; *(float4*)(d + 4) = float4{0, 0, 0, 0};
        *(float4*)(d + 8) = float4{0, 0, 0, 0}; *(float4*)(d + 12) = float4{0, 0, 0, 0};
      }
    }
    wave_lds_sync();
    const int nsub = (count + 15) >> 4;
    for (int sub = 0; sub < nsub; ++sub) {
      for (int tt = 0; tt < 16; ++tt) {
        const int t = sub * 16 + tt;
        float wr_ = 0.f, wi_ = 0.f;
        if (t < count) {
          float bur = 0.f, bui = 0.f;
#pragma unroll
          for (int c = 0; c < 4; ++c) {
            float4 u = *(const float4*)(Us + t * 16 + c * 4);
            bur += bbr[c * 4] * u.x + bbr[c * 4 + 1] * u.y + bbr[c * 4 + 2] * u.z + bbr[c * 4 + 3] * u.w;
            bui += bbi[c * 4] * u.x + bbi[c * 4 + 1] * u.y + bbi[c * 4 + 2] * u.z + bbi[c * 4 + 3] * u.w;
          }
          float nr = abr * hr - abi * hi + bur, ni = abr * hi + abi * hr + bui;
          hr = nr; hi = ni; wr_ = hr; wi_ = hi;
        }
        Hs[tt * 136 + lane] = f2bf(wr_);
        Hs[tt * 136 + 64 + lane] = f2bf(wi_);
      }
      wave_lds_sync();
      f32x4 acc = f32x4{0.f, 0.f, 0.f, 0.f};
#pragma unroll
      for (int ks = 0; ks < 4; ++ks) {
        bf16x8 hf = *(const bf16x8*)(Hs + fr * 136 + ks * 32 + fq * 8);
        acc = mfma16(ctf[ks], hf, acc);
      }
      const int t = sub * 16 + fr;
      if (t < count) {
        float4 u4 = *(const float4*)(Us + t * 16 + fq * 4);
        float y0 = gelu_tanh(acc[0] + d4.x * u4.x), y1 = gelu_tanh(acc[1] + d4.y * u4.y);
        float y2 = gelu_tanh(acc[2] + d4.z * u4.z), y3 = gelu_tanh(acc[3] + d4.w * u4.w);
        st_bf4(G + (t0 + t) * 512 + g * 16 + fq * 4, y0, y1, y2, y3);
      }
      wave_lds_sync();
    }
    if (smp) {
      const size_t so = (((size_t)i * 128 + b) * 32 + g) * 64 + lane;
      p.out[O_SS5RE + so] = hr; p.out[O_SS5IM + so] = hi;
    } else if (chunk == 31) {
      const size_t so = (((size_t)i * 8 + b) * 32 + g) * 64 + lane;
      p.out[O_PS5RE + so] = hr; p.out[O_PS5IM + so] = hi;
    }
  }
}

constexpr int VTS = 264;
DI void swa_prompt(const Params& p, int i, char* smem) {
  const int tid = otid(), lane = tid & 63, w = tid >> 6, fr = lane & 15, fq = lane >> 4;
  u16* Vt = (u16*)smem;
  const u16* PE = (const u16*)(p.ws + WS_PE);
  u16* CAT = (u16*)(p.ws + WS_CAT);
  for (int it = obid(); it < 1024; it += gridDim.x) {
    const int qb = it & 15, h = (it >> 4) & 7, b = it >> 7, kvh = h >> 2;
    const float slope = exp2f(-(float)(h + 1));
    const float sink = p.in[18][i * 8 + h];
    __syncthreads();
    {
      const int l = qb * 128 - 128 + tid;
      u32x4 v[8];
      if (l >= 0) {
        const u16* row = PE + ((size_t)b * 2048 + l) * 1280 + 1152 + kvh * 64;
#pragma unroll
        for (int c = 0; c < 8; ++c) v[c] = *(const u32x4*)(row + c * 8);
      } else {
#pragma unroll
        for (int c = 0; c < 8; ++c) v[c] = u32x4{0, 0, 0, 0};
      }
#pragma unroll
      for (int c = 0; c < 8; ++c) {
#pragma unroll
        for (int q = 0; q < 4; ++q) {
          Vt[(c * 8 + 2 * q) * VTS + tid] = (u16)(v[c][q] & 0xffff);
          Vt[(c * 8 + 2 * q + 1) * VTS + tid] = (u16)(v[c][q] >> 16);
        }
      }
    }
    __syncthreads();
#pragma unroll 1
    for (int qt = 0; qt < 2; ++qt) {
      const int rq = 32 * w + 16 * qt, kt0 = 2 * w + qt;
      const size_t qtok = (size_t)b * 2048 + qb * 128 + rq + fr;
      bf16x8 qf[2];
#pragma unroll
      for (int ks = 0; ks < 2; ++ks) qf[ks] = *(const bf16x8*)(PE + qtok * 1280 + 512 + h * 64 + ks * 32 + fq * 8);
      f32x4 s[9];
#pragma unroll
      for (int c = 0; c < 9; ++c) {
        s[c] = f32x4{0.f, 0.f, 0.f, 0.f};
        const int l = qb * 128 - 128 + (kt0 + c) * 16 + fr;
#pragma unroll
        for (int ks = 0; ks < 2; ++ks) {
          bf16x8 kf = bf16x8{0, 0, 0, 0, 0, 0, 0, 0};
          if (l >= 0) kf = *(const bf16x8*)(PE + ((size_t)b * 2048 + l) * 1280 + 1024 + kvh * 64 + ks * 32 + fq * 8);
          s[c] = mfma16(kf, qf[ks], s[c]);
        }
      }
      const int r = rq + fr;
      float mx = -1e30f;
#pragma unroll
      for (int c = 0; c < 9; ++c)
#pragma unroll
        for (int j = 0; j < 4; ++j) {
          const int kl = (kt0 + c) * 16 + fq * 4 + j;
          const int dist = 128 + r - kl;
          const bool valid = dist >= 0 && dist < 128 && (qb * 128 - 128 + kl) >= 0;
          float sc = valid ? s[c][j] * 0.125f - slope * (float)dist : -1e30f;
          s[c][j] = sc; mx = fmaxf(mx, sc);
        }
      mx = fmaxf(mx, __shfl_xor(mx, 16)); mx = fmaxf(mx, __shfl_xor(mx, 32));
      const float m = fmaxf(mx, sink);
      float sum = 0.f;
#pragma unroll
      for (int c = 0; c < 9; ++c)
#pragma unroll
        for (int j = 0; j < 4; ++j) { float e = __expf(s[c][j] - m); s[c][j] = e; sum += e; }
      sum += __shfl_xor(sum, 16); sum += __shfl_xor(sum, 32);
      const float inv = 1.f / (sum + __expf(sink - m));
      f32x4 o[4];
#pragma unroll
      for (int d = 0; d < 4; ++d) o[d] = f32x4{0.f, 0.f, 0.f, 0.f};
#pragma unroll
      for (int pr = 0; pr < 5; ++pr) {
        const int ia = 2 * pr, ib = 2 * pr + 1;
        uint4 pk;
        pk.x = pack2(s[ia][0], s[ia][1]); pk.y = pack2(s[ia][2], s[ia][3]);
        if (ib < 9) { pk.z = pack2(s[ib < 9 ? ib : 8][0], s[ib < 9 ? ib : 8][1]); pk.w = pack2(s[ib < 9 ? ib : 8][2], s[ib < 9 ? ib : 8][3]); }
        else { pk.z = 0; pk.w = 0; }
        const bf16x8 pf = mk8(pk);
        int ta = kt0 + ia, tb = kt0 + ib; if (tb > 15) tb = 15;
#pragma unroll
        for (int d = 0; d < 4; ++d) {
          const u16* vr = Vt + (d * 16 + fr) * VTS;
          uint2 va = *(const uint2*)(vr + ta * 16 + fq * 4), vb = *(const uint2*)(vr + tb * 16 + fq * 4);
          o[d] = mfma16(mk8(uint4{va.x, va.y, vb.x, vb.y}), pf, o[d]);
        }
      }
#pragma unroll
      for (int d = 0; d < 4; ++d)
        st_bf4(CAT + qtok * 1024 + 512 + h * 64 + d * 16 + fq * 4, o[d][0] * inv, o[d][1] * inv, o[d][2] * inv, o[d][3] * inv);
    }
  }
}

DI void swa_sample(const Params& p, int i, char* smem) {
  const int lane = otid() & 63, wid = otid() >> 6;
  float* Ps = (float*)smem + wid * 128;
  const u16* PE = (const u16*)(p.ws + WS_PE);
  u16* CAT = (u16*)(p.ws + WS_CAT);
  for (int it = obid() * 4 + wid; it < 1024; it += gridDim.x * 4) {
    const int h = it & 7, s = it >> 3, kvh = h >> 2;
    const float slope = exp2f(-(float)(h + 1));
    const float sink = p.in[18][i * 8 + h];
    const size_t tok = (size_t)TP + s;
    const u16* qrow = PE + tok * 1280 + 512 + h * 64;
    const u16* knew = PE + tok * 1280 + 1024 + kvh * 64;
    const u16* vnew = PE + tok * 1280 + 1152 + kvh * 64;
    const float* kc = p.in[4] + (((size_t)i * 128 + s) * 128) * 128 + kvh * 64;
    const float* vc = p.in[5] + (((size_t)i * 128 + s) * 128) * 128 + kvh * 64;
    float sc[2];
#pragma unroll
    for (int hh = 0; hh < 2; ++hh) {
      const int id = lane + hh * 64;
      float dot = 0.f;
      if (id < 127) {
        const float* kr = kc + (size_t)(id + 1) * 128;
        for (int d = 0; d < 64; d += 4) {
          float4 kv = *(const float4*)(kr + d);
          uint2 qq = *(const uint2*)(qrow + d);
          dot += kv.x * lo2f(qq.x) + kv.y * hi2f(qq.x) + kv.z * lo2f(qq.y) + kv.w * hi2f(qq.y);
        }
      } else {
        for (int d = 0; d < 64; d += 4) {
          uint2 kk = *(const uint2*)(knew + d);
          uint2 qq = *(const uint2*)(qrow + d);
          dot += lo2f(kk.x) * lo2f(qq.x) + hi2f(kk.x) * hi2f(qq.x) + lo2f(kk.y) * lo2f(qq.y) + hi2f(kk.y) * hi2f(qq.y);
        }
      }
      sc[hh] = dot * 0.125f - slope * (float)(127 - id);
    }
    float mx = fmaxf(sc[0], sc[1]);
#pragma unroll
    for (int o = 32; o > 0; o >>= 1) mx = fmaxf(mx, __shfl_xor(mx, o));
    const float m = fmaxf(mx, sink);
    float e0 = __expf(sc[0] - m), e1 = __expf(sc[1] - m);
    float sum = e0 + e1;
#pragma unroll
    for (int o = 32; o > 0; o >>= 1) sum += __shfl_xor(sum, o);
    const float inv = 1.f / (sum + __expf(sink - m));
    wave_lds_sync();
    Ps[lane] = e0 * inv; Ps[lane + 64] = e1 * inv;
    wave_lds_sync();
    float o = 0.f;
    for (int id = 0; id < 127; ++id) o += Ps[id] * vc[(size_t)(id + 1) * 128 + lane];
    o += Ps[127] * bf2f(vnew[lane]);
    CAT[tok * 1024 + 512 + h * 64 + lane] = f2bf(o);
  }
}

DI void phase_e_glu(const Params& p, int i, char* smem) {
  const u16* G = (const u16*)(p.ws + WS_G);
  const u16* W = (const u16*)(p.ws + WS_WGLU) + (size_t)i * 512 * 512;
  u16* CAT = (u16*)(p.ws + WS_CAT);
  for (int t = obid(); t < 129 * 4; t += gridDim.x) {
    const int mt = t / 4, nt = t % 4;
    gemm_tile(G, 512, W, 512, 512, mt * 128, nt * 128, (u16*)smem, [&](int tok, int n, f32x4 v, int, int) {
      uint2 gg = *(const uint2*)(G + (size_t)tok * 512 + n);
      float g0 = lo2f(gg.x), g1 = hi2f(gg.x), g2 = lo2f(gg.y), g3 = hi2f(gg.y);
      st_bf4(CAT + (size_t)tok * 1024 + n, g0 * sigmoidf_(v[0]), g1 * sigmoidf_(v[1]), g2 * sigmoidf_(v[2]), g3 * sigmoidf_(v[3]));
    });
  }
}

DI void phase_outproj(const Params& p, const u16* A, int K, const u16* W, bool use_ssq, char* smem) {
  const float* X = (const float*)(p.ws + WS_X);
  float* R = (float*)(p.ws + WS_R);
  const float* SSQ = (const float*)(p.ws + WS_SSQ);
  for (int t = obid(); t < 129 * 8; t += gridDim.x) {
    const int mt = t / 8, nt = t % 8;
    gemm_tile(A, K, W, K, K, mt * 128, nt * 128, (u16*)smem, [&](int tok, int n, f32x4 v, int, int) {
      float sc = 1.f;
      if (use_ssq) {
        float ssum = 0.f;
#pragma unroll
        for (int q = 0; q < 8; ++q) { float4 s4 = *(const float4*)(SSQ + (size_t)tok * 32 + q * 4); ssum += (s4.x + s4.y) + (s4.z + s4.w); }
        sc = rsqrtf(ssum * (1.f / 2048.f) + 1e-5f);
      }
      float4 x = *(const float4*)(X + (size_t)tok * 1024 + n);
      *(float4*)(R + (size_t)tok * 1024 + n) = float4{ALPHA * x.x + sc * v[0], ALPHA * x.y + sc * v[1], ALPHA * x.z + sc * v[2], ALPHA * x.w + sc * v[3]};
    });
  }
}

DI void phase_ln1(const Params& p, int layer) {
  const int lane = otid() & 63, wid = otid() >> 6;
  const float* R = (const float*)(p.ws + WS_R);
  float* X = (float*)(p.ws + WS_X); u16* Xb = (u16*)(p.ws + WS_XB);
  const float* gam = p.in[28] + (size_t)layer * 1024; const float* bet = p.in[29] + (size_t)layer * 1024;
  for (int tok = obid() * 4 + wid; tok < T; tok += gridDim.x * 4) {
    float4 v[4];
    float s = 0.f;
#pragma unroll
    for (int c = 0; c < 4; ++c) { v[c] = *(const float4*)(R + (size_t)tok * 1024 + c * 256 + lane * 4); s += v[c].x + v[c].y + v[c].z + v[c].w; }
#pragma unroll
    for (int o = 32; o > 0; o >>= 1) s += __shfl_xor(s, o);
    const float mu = s * (1.f / 1024.f);
    float q = 0.f;
#pragma unroll
    for (int c = 0; c < 4; ++c) { float a = v[c].x - mu, b = v[c].y - mu, cc = v[c].z - mu, d = v[c].w - mu; q += a * a + b * b + cc * cc + d * d; }
#pragma unroll
    for (int o = 32; o > 0; o >>= 1) q += __shfl_xor(q, o);
    const float rstd = rsqrtf(q * (1.f / 1024.f) + 1e-5f);
#pragma unroll
    for (int c = 0; c < 4; ++c) {
      const int col = c * 256 + lane * 4;
      float4 g = *(const float4*)(gam + col), bb = *(const float4*)(bet + col);
      float4 o = float4{(v[c].x - mu) * rstd * g.x + bb.x, (v[c].y - mu) * rstd * g.y + bb.y, (v[c].z - mu) * rstd * g.z + bb.z, (v[c].w - mu) * rstd * g.w + bb.w};
      *(float4*)(X + (size_t)tok * 1024 + col) = o;
      st_bf4(Xb + (size_t)tok * 1024 + col, o.x, o.y, o.z, o.w);
    }
  }
}

DI unsigned sortkey(float f) { unsigned u = __float_as_uint(f); return u ^ ((u >> 31) ? 0xffffffffu : 0x80000000u); }
DI float unsortkey(unsigned k) { unsigned u = (k & 0x80000000u) ? (k ^ 0x80000000u) : ~k; return __uint_as_float(u); }

constexpr int QSS = 136;
constexpr int PEER_LST_OFF = GEMM_SMEM;
DI void phase_peer1(const Params& p, int layer, char* smem) {
  const int tid = otid(), lane = tid & 63, w = tid >> 6, fr = lane & 15, fq = lane >> 4;
  const u16* Xb = (const u16*)(p.ws + WS_XB);
  const u16* WQ = (const u16*)(p.ws + WS_WQ) + (size_t)layer * 2048 * 1024;
  u16* Qs = (u16*)smem;
  unsigned* Ls = (unsigned*)(smem + PEER_LST_OFF);
  int* IDX = (int*)(p.ws + WS_IDXP); float* GATE = (float*)(p.ws + WS_GATE);
  for (int it = obid(); it < 129 * 8; it += gridDim.x) {
    const int mt = it >> 3, h = it & 7;
#pragma unroll 1
    for (int half = 0; half < 2; ++half) {
      const int m0 = mt * 128, n0 = h * 256 + half * 128;
      gemm_tile<true>(Xb, 1024, WQ, 1024, 1024, m0, n0, (u16*)smem, [&](int tok, int n, f32x4 v, int, int) {
        st_bf4(Qs + (tok - m0) * QSS + (n - n0), v[0], v[1], v[2], v[3]);
      });
      __syncthreads();
      const u16* KT = (const u16*)(p.ws + (half ? WS_K2 : WS_K1)) + ((size_t)layer * 8 + h) * 128 * 128;
#pragma unroll 1
      for (int tt = 0; tt < 2; ++tt) {
        bf16x8 qf[4];
#pragma unroll
        for (int ks = 0; ks < 4; ++ks) qf[ks] = *(const bf16x8*)(Qs + (32 * w + tt * 16 + fr) * QSS + ks * 32 + fq * 8);
        unsigned k[32];
#pragma unroll
        for (int kt = 0; kt < 8; ++kt) {
          f32x4 sc = f32x4{0.f, 0.f, 0.f, 0.f};
#pragma unroll
          for (int ks = 0; ks < 4; ++ks) {
            bf16x8 kf = *(const bf16x8*)(KT + (size_t)(kt * 16 + fr) * 128 + ks * 32 + fq * 8);
            sc = mfma16(kf, qf[ks], sc);
          }
#pragma unroll
          for (int j = 0; j < 4; ++j) k[kt * 4 + j] = (sortkey(sc[j]) & ~127u) | (unsigned)(kt * 16 + fq * 4 + j);
          if (kt & 1) __builtin_amdgcn_sched_barrier(0);
        }
        unsigned* lp = Ls + (32 * w + tt * 16 + fr) * 32 + half * 16;
#pragma unroll 1
        for (int r = 0; r < 16; ++r) {
          unsigned m = k[0];
#pragma unroll
          for (int q = 1; q < 32; ++q) m = m > k[q] ? m : k[q];
          unsigned o = __shfl_xor(m, 16); m = m > o ? m : o;
          o = __shfl_xor(m, 32); m = m > o ? m : o;
          if (fq == 0) lp[r] = m;
#pragma unroll
          for (int q = 0; q < 32; ++q) k[q] = (k[q] == m) ? 0u : k[q];
        }
      }
    }
    wave_lds_sync();
#pragma unroll 1
    for (int tt = 0; tt < 2; ++tt) {
      const unsigned* lp = Ls + (32 * w + tt * 16 + fr) * 32;
      float sum[21]; unsigned key[21]; int eidx[21];
      unsigned l2[16];
#pragma unroll
      for (int j = 0; j < 16; ++j) l2[j] = lp[16 + j];
#pragma unroll
      for (int m = 0; m < 4; ++m) {
        const unsigned a = lp[4 * m + fq];
        const float av = unsortkey(a & ~127u); const int ai = (int)(a & 127u);
        const int J = m == 0 ? 16 : m == 1 ? 3 : 1;
        const int base = m == 0 ? 0 : m == 1 ? 16 : m == 2 ? 19 : 20;
#pragma unroll
        for (int j = 0; j < J; ++j) {
          const unsigned b = l2[j];
          const float sj = av + unsortkey(b & ~127u);
          sum[base + j] = sj;
          key[base + j] = (sortkey(sj) & ~127u) | (unsigned)(fq << 5) | (unsigned)(base + j);
          eidx[base + j] = ai * 128 + (int)(b & 127u);
        }
      }
      const size_t tok = (size_t)mt * 128 + 32 * w + tt * 16 + fr;
      int* ip = IDX + tok * 128; float* gp = GATE + tok * 128 + h * 16;
      float mxs = 0.f;
#pragma unroll 1
      for (int r = 0; r < 16; ++r) {
        unsigned m = key[0];
#pragma unroll
        for (int c = 1; c < 21; ++c) m = m > key[c] ? m : key[c];
        unsigned o = __shfl_xor(m, 16); m = m > o ? m : o;
        o = __shfl_xor(m, 32); m = m > o ? m : o;
        float ws_ = -3.0e38f; int wi = 0;
#pragma unroll
        for (int c = 0; c < 21; ++c) { const bool hit = key[c] == m; ws_ = hit ? sum[c] : ws_; wi = hit ? eidx[c] : wi; key[c] = hit ? 0u : key[c]; }
        ws_ = fmaxf(ws_, __shfl_xor(ws_, 16)); ws_ = fmaxf(ws_, __shfl_xor(ws_, 32));
        int oi = __shfl_xor(wi, 16); wi = wi > oi ? wi : oi;
        oi = __shfl_xor(wi, 32); wi = wi > oi ? wi : oi;
        if (r == 0) mxs = ws_;
        if (fq == 0) { ip[(r & 7) * 16 + 2 * h + (r >> 3)] = wi; gp[r] = __expf(ws_ - mxs); }
      }
    }
    wave_lds_sync();
  }
}

typedef __attribute__((ext_vector_type(2))) float f32x2;
DI void dec16(u32x4 r, f32x2 (&o)[8]) {
#pragma unroll
  for (int q = 0; q < 4; ++q) { o[2 * q] = __builtin_amdgcn_cvt_pk_f32_fp8((int)r[q], false); o[2 * q + 1] = __builtin_amdgcn_cvt_pk_f32_fp8((int)r[q], true); }
}
DI float dpp_f(float v, const int ctrl_sel) {
  const int x = __builtin_bit_cast(int, v);
  int r;
  if (ctrl_sel == 0) r = __builtin_amdgcn_update_dpp(0, x, 0xB1, 0xF, 0xF, true);
  else if (ctrl_sel == 1) r = __builtin_amdgcn_update_dpp(0, x, 0x4E, 0xF, 0xF, true);
  else if (ctrl_sel == 2) r = __builtin_amdgcn_update_dpp(0, x, 0x141, 0xF, 0xF, true);
  else r = __builtin_amdgcn_update_dpp(0, x, 0x140, 0xF, 0xF, true);
  return __builtin_bit_cast(float, r);
}
DI float wave_sum_uniform(float v) {
  v += dpp_f(v, 0); v += dpp_f(v, 1); v += dpp_f(v, 2); v += dpp_f(v, 3);
  const int x = __builtin_bit_cast(int, v);
  const float r0 = __builtin_bit_cast(float, __builtin_amdgcn_readlane(x, 0)), r1 = __builtin_bit_cast(float, __builtin_amdgcn_readlane(x, 16));
  const float r2 = __builtin_bit_cast(float, __builtin_amdgcn_readlane(x, 32)), r3 = __builtin_bit_cast(float, __builtin_amdgcn_readlane(x, 48));
  return (r0 + r1) + (r2 + r3);
}
DI float row16_sum(float v) { v += dpp_f(v, 0); v += dpp_f(v, 1); v += dpp_f(v, 2); v += dpp_f(v, 3); return v; }

DI void phase_peer3u(const Params& p, int layer) {
  const int lane = otid() & 63, wid = otid() >> 6;
  const unsigned char* UB = (const unsigned char*)(p.ws + WS_UB);
  const int* IDXP = (const int*)(p.ws + WS_IDXP); const float* GATE = (const float*)(p.ws + WS_GATE);
  const u16* Xb = (const u16*)(p.ws + WS_XB);
  float* ACTP = (float*)(p.ws + WS_ACTP); float* HP = (float*)(p.ws + WS_IDX);
  const int r = lane >> 3, c = lane & 7;
  const bool b0 = c & 1, b1 = c & 2, b2 = c & 4;
  const int itbase = (b0 ? 8 : 0) + (b1 ? 4 : 0) + (b2 ? 2 : 0);
  const int stride = gridDim.x * 4;
#pragma unroll 1
  for (int cb = 0; cb < 8; ++cb) {
    int tok = obid() * 4 + wid;
    int idp[16]; u32x4 xa, xb; f32x2 hp = f32x2{0.f, 0.f};
    if (tok < T) {
#pragma unroll
      for (int q = 0; q < 4; ++q) { const int4 iv = *(const int4*)(IDXP + (size_t)tok * 128 + r * 16 + q * 4); idp[q * 4] = iv.x; idp[q * 4 + 1] = iv.y; idp[q * 4 + 2] = iv.z; idp[q * 4 + 3] = iv.w; }
      xa = *(const u32x4*)(Xb + (size_t)tok * 1024 + cb * 128 + c * 16); xb = *(const u32x4*)(Xb + (size_t)tok * 1024 + cb * 128 + c * 16 + 8);
      if (cb > 0) hp = *(const f32x2*)(HP + (size_t)tok * 128 + r * 16 + itbase);
    }
#pragma unroll 1
    while (tok < T) {
      u32x4 rr[16];
#pragma unroll
      for (int it = 0; it < 16; ++it) rr[it] = *(const u32x4*)(UB + (size_t)cb * 2097152 + (size_t)idp[it] * 128 + c * 16);
      const int tokn = tok + stride;
      int idn[16]; u32x4 xan = xa, xbn = xb; f32x2 hpn = f32x2{0.f, 0.f};
#pragma unroll
      for (int q = 0; q < 16; ++q) idn[q] = 0;
      if (tokn < T) {
#pragma unroll
        for (int q = 0; q < 4; ++q) { const int4 iv = *(const int4*)(IDXP + (size_t)tokn * 128 + r * 16 + q * 4); idn[q * 4] = iv.x; idn[q * 4 + 1] = iv.y; idn[q * 4 + 2] = iv.z; idn[q * 4 + 3] = iv.w; }
        xan = *(const u32x4*)(Xb + (size_t)tokn * 1024 + cb * 128 + c * 16); xbn = *(const u32x4*)(Xb + (size_t)tokn * 1024 + cb * 128 + c * 16 + 8);
        if (cb > 0) hpn = *(const f32x2*)(HP + (size_t)tokn * 128 + r * 16 + itbase);
      }
      f32x2 x2[8];
#pragma unroll
      for (int q = 0; q < 4; ++q) { x2[q] = f32x2{lo2f(xa[q]), hi2f(xa[q])}; x2[4 + q] = f32x2{lo2f(xb[q]), hi2f(xb[q])}; }
      float v[16];
#pragma unroll
      for (int it = 0; it < 16; ++it) {
        f32x2 d[8]; dec16(rr[it], d);
        f32x2 a2 = d[0] * x2[0];
#pragma unroll
        for (int k = 1; k < 8; ++k) a2 += d[k] * x2[k];
        v[it] = a2.x + a2.y;
      }
      float w8[8];
#pragma unroll
      for (int k = 0; k < 8; ++k) { const float send = b0 ? v[k] : v[8 + k]; const float keep = b0 ? v[8 + k] : v[k]; w8[k] = keep + dpp_f(send, 0); }
      float w4[4];
#pragma unroll
      for (int k = 0; k < 4; ++k) { const float send = b1 ? w8[k] : w8[4 + k]; const float keep = b1 ? w8[4 + k] : w8[k]; w4[k] = keep + dpp_f(send, 1); }
      float w2[2];
#pragma unroll
      for (int k = 0; k < 2; ++k) { const float send = b2 ? w4[k] : w4[2 + k]; const float keep = b2 ? w4[2 + k] : w4[k]; w2[k] = keep + __shfl_xor(send, 4); }
      const float h0 = hp.x + w2[0], h1 = hp.y + w2[1];
      if (cb < 7) {
        *(f32x2*)(HP + (size_t)tok * 128 + r * 16 + itbase) = f32x2{h0, h1};
      } else {
        const int hc = itbase >> 1;
        const float ga = GATE[(size_t)tok * 128 + hc * 16 + r], gb = GATE[(size_t)tok * 128 + hc * 16 + 8 + r];
        float den = ga + gb;
        den += __builtin_bit_cast(float, __builtin_amdgcn_update_dpp(0, __builtin_bit_cast(int, den), 0x128, 0xF, 0xF, true));
        den += __shfl_xor(den, 16); den += __shfl_xor(den, 32);
        const float sc = 1.f / (den * V8_SCALE);
        *(f32x2*)(ACTP + (size_t)tok * 128 + r * 16 + itbase) = f32x2{gelu_tanh(h0 * (1.f / U8_SCALE)) * ga * sc, gelu_tanh(h1 * (1.f / U8_SCALE)) * gb * sc};
      }
#pragma unroll
      for (int q = 0; q < 16; ++q) idp[q] = idn[q];
      xa = xan; xb = xbn; hp = hpn; tok = tokn;
    }
  }
}

DI void phase_peer3v(const Params& p, int layer) {
  const int lane = otid() & 63, wid = otid() >> 6;
  const unsigned char* VB = (const unsigned char*)(p.ws + WS_VB);
  const float* ACTP = (const float*)(p.ws + WS_ACTP); const int* IDXP = (const int*)(p.ws + WS_IDXP);
  float* Y = (float*)(p.ws + WS_R);
  const int r = lane >> 3, c = lane & 7;
  const int stride = gridDim.x * 4;
#pragma unroll 1
  for (int cb = 0; cb < 8; ++cb) {
    int tok = obid() * 4 + wid;
    int idp[16]; float ap[16];
#pragma unroll
    for (int q = 0; q < 16; ++q) { idp[q] = 0; ap[q] = 0.f; }
    if (tok < T) {
#pragma unroll
      for (int q = 0; q < 4; ++q) {
        const int4 iv = *(const int4*)(IDXP + (size_t)tok * 128 + r * 16 + q * 4);
        const float4 av = *(const float4*)(ACTP + (size_t)tok * 128 + r * 16 + q * 4);
        idp[q * 4] = iv.x; idp[q * 4 + 1] = iv.y; idp[q * 4 + 2] = iv.z; idp[q * 4 + 3] = iv.w;
        ap[q * 4] = av.x; ap[q * 4 + 1] = av.y; ap[q * 4 + 2] = av.z; ap[q * 4 + 3] = av.w;
      }
    }
#pragma unroll 1
    while (tok < T) {
      u32x4 rr[16];
#pragma unroll
      for (int it = 0; it < 16; ++it) rr[it] = *(const u32x4*)(VB + (size_t)cb * 2097152 + (size_t)idp[it] * 128 + c * 16);
      const int tokn = tok + stride;
      int idn[16]; float an[16];
#pragma unroll
      for (int q = 0; q < 16; ++q) { idn[q] = 0; an[q] = 0.f; }
      if (tokn < T) {
#pragma unroll
        for (int q = 0; q < 4; ++q) {
          const int4 iv = *(const int4*)(IDXP + (size_t)tokn * 128 + r * 16 + q * 4);
          const float4 av = *(const float4*)(ACTP + (size_t)tokn * 128 + r * 16 + q * 4);
          idn[q * 4] = iv.x; idn[q * 4 + 1] = iv.y; idn[q * 4 + 2] = iv.z; idn[q * 4 + 3] = iv.w;
          an[q * 4] = av.x; an[q * 4 + 1] = av.y; an[q * 4 + 2] = av.z; an[q * 4 + 3] = av.w;
        }
      }
      f32x2 acc[8];
#pragma unroll
      for (int k = 0; k < 8; ++k) acc[k] = f32x2{0.f, 0.f};
#pragma unroll
      for (int it = 0; it < 16; ++it) {
        f32x2 d[8]; dec16(rr[it], d);
        const f32x2 a2 = f32x2{ap[it], ap[it]};
#pragma unroll
        for (int k = 0; k < 8; ++k) acc[k] += d[k] * a2;
      }
      float v[16];
#pragma unroll
      for (int k = 0; k < 8; ++k) { v[2 * k] = acc[k].x; v[2 * k + 1] = acc[k].y; }
#pragma unroll
      for (int k = 0; k < 16; ++k) v[k] += __builtin_bit_cast(float, __builtin_amdgcn_update_dpp(0, __builtin_bit_cast(int, v[k]), 0x128, 0xF, 0xF, true));
      const bool b4 = lane & 16, b5 = lane & 32;
      float w8[8];
#pragma unroll
      for (int k = 0; k < 8; ++k) { const float send = b4 ? v[k] : v[8 + k]; const float keep = b4 ? v[8 + k] : v[k]; w8[k] = keep + __shfl_xor(send, 16); }
      float z[4];
#pragma unroll
      for (int k = 0; k < 4; ++k) { const float send = b5 ? w8[k] : w8[4 + k]; const float keep = b5 ? w8[4 + k] : w8[k]; z[k] = keep + __shfl_xor(send, 32); }
      if ((lane & 8) == 0) *(float4*)(Y + (size_t)tok * 1024 + cb * 128 + c * 16 + (b4 ? 8 : 0) + (b5 ? 4 : 0)) = float4{z[0], z[1], z[2], z[3]};
#pragma unroll
      for (int q = 0; q < 16; ++q) { idp[q] = idn[q]; ap[q] = an[q]; }
      tok = tokn;
    }
  }
}

DI void phase_peer3n(const Params& p, int layer) {
  const int lane = otid() & 63, wid = otid() >> 6;
  const float* Y = (const float*)(p.ws + WS_R);
  float* X = (float*)(p.ws + WS_X); u16* Xb = (u16*)(p.ws + WS_XB);
  const float* gam = p.in[30] + (size_t)layer * 1024; const float* bet = p.in[31] + (size_t)layer * 1024;
  const bool last = layer == 3;
  for (int tok = obid() * 4 + wid; tok < T; tok += gridDim.x * 4) {
    float4 v[4];
    float s = 0.f;
#pragma unroll
    for (int cc = 0; cc < 4; ++cc) {
      const size_t o = (size_t)tok * 1024 + cc * 256 + lane * 4;
      const float4 y = *(const float4*)(Y + o), x = *(const float4*)(X + o);
      v[cc] = float4{ALPHA * x.x + y.x, ALPHA * x.y + y.y, ALPHA * x.z + y.z, ALPHA * x.w + y.w};
      s += v[cc].x + v[cc].y + v[cc].z + v[cc].w;
    }
#pragma unroll
    for (int o = 32; o > 0; o >>= 1) s += __shfl_xor(s, o);
    const float mu = s * (1.f / 1024.f);
    float q = 0.f;
#pragma unroll
    for (int cc = 0; cc < 4; ++cc) { float a = v[cc].x - mu, b = v[cc].y - mu, c2 = v[cc].z - mu, d = v[cc].w - mu; q += a * a + b * b + c2 * c2 + d * d; }
#pragma unroll
    for (int o = 32; o > 0; o >>= 1) q += __shfl_xor(q, o);
    const float rstd = rsqrtf(q * (1.f / 1024.f) + 1e-5f);
#pragma unroll
    for (int cc = 0; cc < 4; ++cc) {
      const int col = cc * 256 + lane * 4;
      float4 g = *(const float4*)(gam + col), bb = *(const float4*)(bet + col);
      float4 o = float4{(v[cc].x - mu) * rstd * g.x + bb.x, (v[cc].y - mu) * rstd * g.y + bb.y, (v[cc].z - mu) * rstd * g.z + bb.z, (v[cc].w - mu) * rstd * g.w + bb.w};
      if (last) *(float4*)(p.out + O_Y + (size_t)tok * 1024 + col) = o;
      else { *(float4*)(X + (size_t)tok * 1024 + col) = o; st_bf4(Xb + (size_t)tok * 1024 + col, o.x, o.y, o.z, o.w); }
    }
  }
}

DI void phase_o_inproj(const Params& p, int i, char* smem) {
  const u16* Xb = (const u16*)(p.ws + WS_XB);
  const u16* W = (const u16*)(p.ws + WS_WINO) + (size_t)i * 5248 * 1024;
  u16* Z = (u16*)(p.ws + WS_Z); u16* XBCR = (u16*)(p.ws + WS_XBCR); float* DTR = (float*)(p.ws + WS_DTR);
  float* out = p.out;
  for (int t = obid(); t < 129 * 41; t += gridDim.x) {
    const int mt = t / 41, nt = t % 41;
    gemm_tile(Xb, 1024, W, 1024, 1024, mt * 128, nt * 128, (u16*)smem, [&](int tok, int n, f32x4 v, int, int) {
      if (n < 2048) st_bf4(Z + (size_t)tok * 2048 + n, v[0], v[1], v[2], v[3]);
      else if (n < 5120) {
        const int c = n - 2048;
        st_bf4(XBCR + (size_t)tok * 3072 + c, v[0], v[1], v[2], v[3]);
        if (tok >= TP) *(float4*)(out + O_SCONV + (((size_t)i * 128 + (tok - TP)) * 3 + 2) * 3072 + c) = float4{v[0], v[1], v[2], v[3]};
        else {
          const int b = tok >> 11, l = tok & 2047;
          if (l >= 2045) *(float4*)(out + O_PCONV + (((size_t)i * 8 + b) * 3 + (l - 2045)) * 3072 + c) = float4{v[0], v[1], v[2], v[3]};
        }
      } else if (n < 5152) *(float4*)(DTR + (size_t)tok * 32 + (n - 5120)) = float4{v[0], v[1], v[2], v[3]};
    });
  }
}

DI void phase_o_conv(const Params& p, int i, char* smem) {
  const int tid = otid();
  const size_t gtid = (size_t)obid() * 256 + tid, gsz = (size_t)gridDim.x * 256;
  const u16* XBCR = (const u16*)(p.ws + WS_XBCR);
  u16* XS = (u16*)(p.ws + WS_XS); u16* BM = (u16*)(p.ws + WS_BM); u16* CM = (u16*)(p.ws + WS_CM);
  u16* XST = (u16*)(p.ws + WS_XST); u16* BMT = (u16*)(p.ws + WS_BMT);
  const float* cw = p.in[21] + (size_t)i * 4 * 3072; const float* cb = p.in[22] + (size_t)i * 3072;
  float* raw = (float*)smem;
  u16* ys = (u16*)(smem + 67 * 64 * 4);
  for (int it = obid(); it < 256 * 48; it += gridDim.x) {
    const int ct = it % 48, tt = it / 48;
    const int t0 = tt * 64, l0 = t0 & 2047, c0 = ct * 64, b = t0 >> 11;
    const int c = tid & 63, r4 = tid >> 6;
    __syncthreads();
    for (int r = r4; r < 67; r += 4) {
      const int l = l0 - 3 + r;
      raw[r * 64 + c] = l >= 0 ? bf2f(XBCR[(size_t)(t0 - 3 + r) * 3072 + c0 + c]) : 0.f;
    }
    __syncthreads();
    const int ch = c0 + c;
    const float w0 = cw[ch], w1 = cw[3072 + ch], w2 = cw[2 * 3072 + ch], w3 = cw[3 * 3072 + ch], bs = cb[ch];
#pragma unroll
    for (int k = 0; k < 16; ++k) {
      const int r = r4 + 4 * k;
      float y = bs + w0 * raw[r * 64 + c] + w1 * raw[(r + 1) * 64 + c] + w2 * raw[(r + 2) * 64 + c] + w3 * raw[(r + 3) * 64 + c];
      const u16 yb = f2bf(siluf_(y));
      const size_t tok = (size_t)t0 + r;
      if (ch < 2048) XS[tok * 2048 + ch] = yb;
      else if (ch < 2560) BM[tok * 512 + ch - 2048] = yb;
      else CM[tok * 512 + ch - 2560] = yb;
      ys[r * 66 + c] = yb;
    }
    if (c0 < 2560) {
      __syncthreads();
      const int s = tid & 63, chunk = l0 >> 7, so = (l0 & 127) + s;
#pragma unroll
      for (int k = 0; k < 16; ++k) {
        const int cc = r4 + 4 * k;
        const u16 val = ys[s * 66 + cc];
        if (c0 < 2048) XST[(((size_t)b * 16 + chunk) * 2048 + c0 + cc) * 128 + so] = val;
        else BMT[(((size_t)b * 16 + chunk) * 512 + (c0 - 2048) + cc) * 128 + so] = val;
      }
    }
  }
  for (size_t e = gtid; e < (size_t)128 * 3072; e += gsz) {
    const int s = (int)(e / 3072), ch = (int)(e % 3072);
    const float* st = p.in[7] + ((size_t)i * 128 + s) * 3 * 3072 + ch;
    const size_t tok = (size_t)TP + s;
    float y = cb[ch] + cw[ch] * st[0] + cw[3072 + ch] * st[3072] + cw[2 * 3072 + ch] * st[2 * 3072] + cw[3 * 3072 + ch] * bf2f(XBCR[tok * 3072 + ch]);
    const u16 yb = f2bf(siluf_(y));
    if (ch < 2048) XS[tok * 2048 + ch] = yb;
    else if (ch < 2560) BM[tok * 512 + ch - 2048] = yb;
    else CM[tok * 512 + ch - 2560] = yb;
  }
  {
    const float* DTR = (const float*)(p.ws + WS_DTR); float* DT = (float*)(p.ws + WS_DT);
    const float* bias = p.in[23] + (size_t)i * 32;
    for (size_t e = gtid; e < (size_t)T * 32; e += gsz) {
      float x = DTR[e] + bias[e & 31];
      DT[e] = x > 20.f ? x : log1pf(expf(x));
    }
  }
}

DI void chunk_scan(const float* DT, size_t tok0, int h, float a, float* acs, float* dts, float* tot) {
  const int tid = otid(), lane = tid & 63;
  float d = 0.f, v = 0.f;
  __syncthreads();
  if (tid < 128) {
    d = DT[(tok0 + tid) * 32 + h];
    v = d * a;
#pragma unroll
    for (int o = 1; o < 64; o <<= 1) { float n = __shfl_up(v, o); if (lane >= o) v += n; }
    if (tid == 63) tot[0] = v;
  }
  __syncthreads();
  if (tid < 128) {
    if (tid >= 64) v += tot[0];
    acs[tid] = v; dts[tid] = d;
  }
  __syncthreads();
}

DI void phase_o_states(const Params& p, int i, char* smem) {
  const int tid = otid(), lane = tid & 63, w = tid >> 6, fr = lane & 15, fq = lane >> 4;
  float* acs = (float*)smem; float* dts = acs + 128; float* wgt = dts + 128; float* tot = wgt + 128;
  const float* DT = (const float*)(p.ws + WS_DT);
  const u16* XST = (const u16*)(p.ws + WS_XST); const u16* BMT = (const u16*)(p.ws + WS_BMT);
  float* ST = (float*)(p.ws + WS_ST); float* DEC = (float*)(p.ws + WS_DEC);
  for (int it = obid(); it < 4096; it += gridDim.x) {
    const int h = it & 31, chunk = (it >> 5) & 15, b = it >> 9, g = h >> 3;
    const float a = -expf(p.in[24][i * 32 + h]);
    const size_t tok0 = (size_t)b * 2048 + chunk * 128;
    chunk_scan(DT, tok0, h, a, acs, dts, tot);
    const float lastv = acs[127];
    if (tid < 128) wgt[tid] = __expf(lastv - acs[tid]) * dts[tid];
    if (tid == 0) DEC[((size_t)b * 16 + chunk) * 32 + h] = __expf(lastv);
    __syncthreads();
    const size_t bc = (size_t)b * 16 + chunk;
    f32x4 acc[4][2];
#pragma unroll
    for (int pt = 0; pt < 4; ++pt) { acc[pt][0] = f32x4{0.f, 0.f, 0.f, 0.f}; acc[pt][1] = f32x4{0.f, 0.f, 0.f, 0.f}; }
#pragma unroll
    for (int ks = 0; ks < 4; ++ks) {
      const int s0 = ks * 32 + fq * 8;
      const float4 wa = *(const float4*)(wgt + s0), wb = *(const float4*)(wgt + s0 + 4);
      bf16x8 bmf[2];
#pragma unroll
      for (int nt = 0; nt < 2; ++nt) bmf[nt] = *(const bf16x8*)(BMT + ((bc * 512 + g * 128 + 32 * w + nt * 16 + fr) * 128 + s0));
#pragma unroll
      for (int pt = 0; pt < 4; ++pt) {
        uint4 xr = *(const uint4*)(XST + ((bc * 2048 + h * 64 + pt * 16 + fr) * 128 + s0));
        uint4 xw;
        xw.x = pack2(lo2f(xr.x) * wa.x, hi2f(xr.x) * wa.y); xw.y = pack2(lo2f(xr.y) * wa.z, hi2f(xr.y) * wa.w);
        xw.z = pack2(lo2f(xr.z) * wb.x, hi2f(xr.z) * wb.y); xw.w = pack2(lo2f(xr.w) * wb.z, hi2f(xr.w) * wb.w);
        const bf16x8 xf = mk8(xw);
        acc[pt][0] = mfma16(bmf[0], xf, acc[pt][0]);
        acc[pt][1] = mfma16(bmf[1], xf, acc[pt][1]);
      }
    }
#pragma unroll
    for (int pt = 0; pt < 4; ++pt)
#pragma unroll
      for (int nt = 0; nt < 2; ++nt)
        *(float4*)(ST + (((bc * 32 + h) * 64 + pt * 16 + fr) * 128 + 32 * w + nt * 16 + fq * 4)) = float4{acc[pt][nt][0], acc[pt][nt][1], acc[pt][nt][2], acc[pt][nt][3]};
  }
}

DI void phase_o_scan(const Params& p, int i) {
  const size_t gtid = (size_t)obid() * 256 + otid(), gsz = (size_t)gridDim.x * 256;
  float* ST = (float*)(p.ws + WS_ST); const float* DEC = (const float*)(p.ws + WS_DEC);
  for (size_t e = gtid; e < (size_t)524288; e += gsz) {
    const int n4 = (int)(e & 31), pp = (int)((e >> 5) & 63), h = (int)((e >> 11) & 31), b = (int)(e >> 16);
    float4 carry = float4{0.f, 0.f, 0.f, 0.f};
    for (int c = 0; c < 16; ++c) {
      const size_t ad = ((((size_t)b * 16 + c) * 32 + h) * 64 + pp) * 128 + n4 * 4;
      const float dec = DEC[((size_t)b * 16 + c) * 32 + h];
      const float4 tmp = *(const float4*)(ST + ad);
      *(float4*)(ST + ad) = carry;
      carry = float4{dec * carry.x + tmp.x, dec * carry.y + tmp.y, dec * carry.z + tmp.z, dec * carry.w + tmp.w};
    }
    *(float4*)(p.out + O_PSSD + ((((size_t)i * 8 + b) * 32 + h) * 64 + pp) * 128 + n4 * 4) = carry;
  }
}

DI void phase_o_y(const Params& p, int i, char* smem) {
  const int tid = otid(), lane = tid & 63, w = tid >> 6, fr = lane & 15, fq = lane >> 4;
  float* acs = (float*)smem; float* dts = acs + 128; float* tot = dts + 128;
  const float* DT = (const float*)(p.ws + WS_DT);
  const u16* XST = (const u16*)(p.ws + WS_XST); const u16* XS = (const u16*)(p.ws + WS_XS);
  const u16* BM = (const u16*)(p.ws + WS_BM); const u16* CM = (const u16*)(p.ws + WS_CM); const u16* Z = (const u16*)(p.ws + WS_Z);
  const float* ST = (const float*)(p.ws + WS_ST);
  u16* YG = (u16*)(p.ws + WS_YG); float* SSQ = (float*)(p.ws + WS_SSQ);
  for (int it = obid(); it < 8192; it += gridDim.x) {
    if (it < 4096) {
      const int h = it & 31, chunk = (it >> 5) & 15, b = it >> 9, g = h >> 3;
      const float a = -expf(p.in[24][i * 32 + h]);
      const float Dh = p.in[25][i * 32 + h];
      const size_t tok0 = (size_t)b * 2048 + chunk * 128;
      const size_t bc = (size_t)b * 16 + chunk;
      chunk_scan(DT, tok0, h, a, acs, dts, tot);
      for (int q = 0; q < 2; ++q) {
        const int tt = q == 0 ? w : 7 - w;
        const int tl = tt * 16 + fr;
        bf16x8 cmf[4];
#pragma unroll
        for (int ks = 0; ks < 4; ++ks) cmf[ks] = *(const bf16x8*)(CM + (tok0 + tl) * 512 + g * 128 + ks * 32 + fq * 8);
        f32x4 acc[4];
#pragma unroll
        for (int pt = 0; pt < 4; ++pt) acc[pt] = f32x4{0.f, 0.f, 0.f, 0.f};
#pragma unroll
        for (int ks = 0; ks < 4; ++ks)
#pragma unroll
          for (int pt = 0; pt < 4; ++pt) {
            const float* sp = ST + (((bc * 32 + h) * 64 + pt * 16 + fr) * 128 + ks * 32 + fq * 8);
            float4 sa = *(const float4*)sp, sb = *(const float4*)(sp + 4);
            uint4 sv; sv.x = pack2(sa.x, sa.y); sv.y = pack2(sa.z, sa.w); sv.z = pack2(sb.x, sb.y); sv.w = pack2(sb.z, sb.w);
            acc[pt] = mfma16(mk8(sv), cmf[ks], acc[pt]);
          }
        const float at = acs[tl];
        const float ea = __expf(at);
#pragma unroll
        for (int pt = 0; pt < 4; ++pt) { acc[pt][0] *= ea; acc[pt][1] *= ea; acc[pt][2] *= ea; acc[pt][3] *= ea; }
        for (int sp = 0; sp * 2 <= tt; ++sp) {
          uint4 mk;
#pragma unroll
          for (int half = 0; half < 2; ++half) {
            const int st = 2 * sp + half;
            f32x4 cb = f32x4{0.f, 0.f, 0.f, 0.f};
            if (st <= tt) {
#pragma unroll
              for (int ks = 0; ks < 4; ++ks) {
                bf16x8 bmf = *(const bf16x8*)(BM + (tok0 + st * 16 + fr) * 512 + g * 128 + ks * 32 + fq * 8);
                cb = mfma16(bmf, cmf[ks], cb);
              }
            }
            float mv[4];
#pragma unroll
            for (int j = 0; j < 4; ++j) {
              const int sl = st * 16 + fq * 4 + j;
              float m = 0.f;
              if (st <= tt && sl <= tl) m = cb[j] * __expf(at - acs[sl]) * dts[sl];
              mv[j] = m;
            }
            if (half == 0) { mk.x = pack2(mv[0], mv[1]); mk.y = pack2(mv[2], mv[3]); }
            else { mk.z = pack2(mv[0], mv[1]); mk.w = pack2(mv[2], mv[3]); }
          }
          const bf16x8 mf = mk8(mk);
#pragma unroll
          for (int pt = 0; pt < 4; ++pt) {
            const u16* xr = XST + ((bc * 2048 + h * 64 + pt * 16 + fr) * 128);
            uint2 xa = *(const uint2*)(xr + (2 * sp) * 16 + fq * 4), xb = *(const uint2*)(xr + (2 * sp + 1) * 16 + fq * 4);
            acc[pt] = mfma16(mk8(uint4{xa.x, xa.y, xb.x, xb.y}), mf, acc[pt]);
          }
        }
        const size_t tok = tok0 + tl;
        float ss = 0.f;
#pragma unroll
        for (int pt = 0; pt < 4; ++pt) {
          const int col = h * 64 + pt * 16 + fq * 4;
          uint2 xv = *(const uint2*)(XS + tok * 2048 + col), zv = *(const uint2*)(Z + tok * 2048 + col);
          float y0 = (acc[pt][0] + Dh * lo2f(xv.x)) * siluf_(lo2f(zv.x));
          float y1 = (acc[pt][1] + Dh * hi2f(xv.x)) * siluf_(hi2f(zv.x));
          float y2 = (acc[pt][2] + Dh * lo2f(xv.y)) * siluf_(lo2f(zv.y));
          float y3 = (acc[pt][3] + Dh * hi2f(xv.y)) * siluf_(hi2f(zv.y));
          st_bf4(YG + tok * 2048 + col, y0, y1, y2, y3);
          ss += y0 * y0 + y1 * y1 + y2 * y2 + y3 * y3;
        }
        ss += __shfl_xor(ss, 16); ss += __shfl_xor(ss, 32);
        if (fq == 0) SSQ[tok * 32 + h] = ss;
      }
    } else {
      const int r = it - 4096, h = r & 31, s = r >> 5, g = h >> 3;
      const float a = -expf(p.in[24][i * 32 + h]);
      const float Dh = p.in[25][i * 32 + h];
      const size_t tok = (size_t)TP + s;
      const int pp = tid >> 2, nq = tid & 3;
      const float dtv = DT[tok * 32 + h];
      const float dA = __expf(dtv * a);
      const float xv = bf2f(XS[tok * 2048 + h * 64 + pp]);
      const size_t ad = ((((size_t)i * 128 + s) * 32 + h) * 64 + pp) * 128 + nq * 32;
      const float dx = dtv * xv;
      float yp = 0.f;
#pragma unroll
      for (int k = 0; k < 8; ++k) {
        float4 s0 = *(const float4*)(p.in[6] + ad + 4 * k);
        uint2 bv = *(const uint2*)(BM + tok * 512 + g * 128 + nq * 32 + 4 * k), cv = *(const uint2*)(CM + tok * 512 + g * 128 + nq * 32 + 4 * k);
        float4 nw = float4{dA * s0.x + dx * lo2f(bv.x), dA * s0.y + dx * hi2f(bv.x), dA * s0.z + dx * lo2f(bv.y), dA * s0.w + dx * hi2f(bv.y)};
        *(float4*)(p.out + O_SSSD + ad + 4 * k) = nw;
        yp += nw.x * lo2f(cv.x) + nw.y * hi2f(cv.x) + nw.z * lo2f(cv.y) + nw.w * hi2f(cv.y);
      }
      yp += __shfl_xor(yp, 1); yp += __shfl_xor(yp, 2);
      const float yg = (yp + Dh * xv) * siluf_(bf2f(Z[tok * 2048 + h * 64 + pp]));
      float ss = 0.f;
      if (nq == 0) { YG[tok * 2048 + h * 64 + pp] = f2bf(yg); ss = yg * yg; }
#pragma unroll
      for (int o = 32; o > 0; o >>= 1) ss += __shfl_xor(ss, o);
      __syncthreads();
      if (lane == 0) tot[w] = ss;
      __syncthreads();
      if (tid == 0) SSQ[tok * 32 + h] = (tot[0] + tot[1]) + (tot[2] + tot[3]);
    }
  }
}

constexpr int SMEM_BYTES = GEMM_SMEM + 128 * 32 * 4;
#ifndef PROBE_ID
#define PROBE_ID 0
#endif
#define TIMED(id, ...) { long long t0_ = 0; if (PROBE_ID == (id)) t0_ = wall_clock64(); __VA_ARGS__; if (PROBE_ID == (id)) tacc += wall_clock64() - t0_; }
__global__ void __launch_bounds__(256, 2) mega_kernel(Params p) {
  __shared__ __attribute__((aligned(16))) char smem[SMEM_BYTES];
  __shared__ uint4 xb_words;
  if (threadIdx.x == 0) xb_words = make_uint4(0u, 0u, 0u, 0u);
  __syncthreads();
  XcdBarrier bar = xcd_barrier_post((unsigned*)(p.ws + WS_BAR), (volatile LAS unsigned*)&xb_words);
  long long tacc = 0;
  TIMED(1, phase_prep(p, smem); cg::this_grid().sync();)
  for (int layer = 0; layer < 4; ++layer) {
    const int i = layer >> 1;
    if ((layer & 1) == 0) {
      TIMED(2, convert_tables(p, layer); phase_e_inproj(p, i, smem); xcd_barrier(bar);)
      TIMED(3,
        s5_pass1(p, i, smem);
        __syncthreads();
        swa_prompt(p, i, smem);
        __syncthreads();
        swa_sample(p, i, smem);
        xcd_barrier(bar);
        s5_pass3(p, i, smem);
        xcd_barrier(bar);
        phase_e_glu(p, i, smem);
        xcd_barrier(bar);)
      TIMED(4, phase_outproj(p, (const u16*)(p.ws + WS_CAT), 1024, (const u16*)(p.ws + WS_WOUTE) + (size_t)i * 1024 * 1024, false, smem);
        xcd_barrier(bar);)
    } else {
      TIMED(2, convert_tables(p, layer); phase_o_inproj(p, i, smem); xcd_barrier(bar);)
      TIMED(51, phase_o_conv(p, i, smem); xcd_barrier(bar);)
      TIMED(52, phase_o_states(p, i, smem); xcd_barrier(bar);)
      TIMED(53, phase_o_scan(p, i); xcd_barrier(bar);)
      TIMED(54, phase_o_y(p, i, smem); xcd_barrier(bar);)
      TIMED(4, phase_outproj(p, (const u16*)(p.ws + WS_YG), 2048, (const u16*)(p.ws + WS_WOUTO) + (size_t)i * 1024 * 2048, true, smem);
        xcd_barrier(bar);)
    }
    TIMED(4, phase_ln1(p, layer); xcd_barrier(bar);)
    TIMED(6, phase_peer1(p, layer, smem); xcd_barrier(bar);)
    TIMED(71, phase_peer3u(p, layer); xcd_barrier(bar);)
    TIMED(72, phase_peer3v(p, layer); xcd_barrier(bar);)
    TIMED(73, phase_peer3n(p, layer); xcd_barrier(bar);)
  }
  if (PROBE_ID != 0 && blockIdx.x == 0 && threadIdx.x == 0) {
    const long long t0 = wall_clock64();
    while (wall_clock64() - t0 < tacc) __builtin_amdgcn_s_sleep(8);
  }
}

extern "C" void kernel_launch(void* const* d_in, const int* in_sizes, int n_in, void* d_out, int out_size, void* d_ws,
                              size_t ws_size, hipStream_t stream) {
  static int grid_blocks = 0;
  if (!grid_blocks) {
    int dev = 0, cus = 0, per_cu = 0;
    hipGetDevice(&dev);
    hipDeviceGetAttribute(&cus, hipDeviceAttributeMultiprocessorCount, dev);
    hipOccupancyMaxActiveBlocksPerMultiprocessor(&per_cu, mega_kernel, 256, 0);
    if (per_cu > 2) per_cu = 2;
    if (per_cu < 1) per_cu = 1;
    grid_blocks = cus * per_cu;
  }
  if (ws_size < WS_END) { fprintf(stderr, "workspace too small: %zu < %zu\n", ws_size, (size_t)WS_END); return; }
  Params p{};
  for (int k = 0; k < 37; ++k) p.in[k] = (const float*)d_in[k];
  p.out = (float*)d_out;
  p.ws = (char*)d_ws;
  hipMemsetAsync((char*)d_ws + WS_BAR, 0, 16384, stream);
  void* args[] = {&p};
  hipError_t e = hipLaunchCooperativeKernel((void*)mega_kernel, dim3(grid_blocks), dim3(256), args, 0, stream);
  if (e != hipSuccess) fprintf(stderr, "cooperative launch failed: %s (grid %d)\n", hipGetErrorString(e), grid_blocks);
}
```

```cpp
#include <hip/hip_runtime.h>
#include <hip/hip_cooperative_groups.h>
#include <cstdio>
#include <cstdint>
namespace cg = cooperative_groups;

typedef unsigned short u16;
typedef __attribute__((ext_vector_type(8))) short bf16x8;
typedef __attribute__((ext_vector_type(4))) short bf16x4;
typedef __attribute__((ext_vector_type(4))) float f32x4;
typedef __attribute__((ext_vector_type(2))) __bf16 bf2;
typedef __attribute__((ext_vector_type(4))) unsigned u32x4;

#define DI __device__ __forceinline__

constexpr int T = 16512, TP = 16384, NSMP = 128;
constexpr float ALPHA = 1.681792830507429f;

constexpr size_t O_Y = 0;
constexpr size_t O_PS5RE = (size_t)T * 1024;
constexpr size_t O_PS5IM = O_PS5RE + 32768;
constexpr size_t O_PSWAK = O_PS5IM + 32768;
constexpr size_t O_PSWAV = O_PSWAK + 262144;
constexpr size_t O_PSSD = O_PSWAV + 262144;
constexpr size_t O_PCONV = O_PSSD + 4194304;
constexpr size_t O_SS5RE = O_PCONV + 147456;
constexpr size_t O_SS5IM = O_SS5RE + 524288;
constexpr size_t O_SSWAK = O_SS5IM + 524288;
constexpr size_t O_SSWAV = O_SSWAK + 4194304;
constexpr size_t O_SSSD = O_SSWAV + 4194304;
constexpr size_t O_SCONV = O_SSSD + 67108864;

constexpr size_t WS_BAR = 0;
constexpr size_t WS_X = 16384;
constexpr size_t WS_XB = WS_X + (size_t)T * 1024 * 4;
constexpr size_t WS_SSQ = WS_XB + (size_t)T * 1024 * 2;
constexpr size_t WS_IDX = WS_SSQ + (size_t)T * 32 * 4;
constexpr size_t WS_GATE = WS_IDX + (size_t)T * 128 * 4;
constexpr size_t WS_DT = WS_GATE + (size_t)T * 128 * 4;
constexpr size_t WS_DTR = WS_DT + (size_t)T * 32 * 4;
constexpr size_t WS_DEC = WS_DTR + (size_t)T * 32 * 4;
constexpr size_t WS_AB = WS_DEC + 16384;
constexpr size_t WS_BBR = WS_AB + 32768;
constexpr size_t WS_BBI = WS_BBR + 262144;
constexpr size_t WS_CT = WS_BBI + 262144;
constexpr size_t WS_E = WS_CT + 262144;
constexpr size_t WS_WINE = WS_E + 4194304;
constexpr size_t WS_WGLU = WS_WINE + (size_t)2 * 1280 * 1024 * 2;
constexpr size_t WS_WOUTE = WS_WGLU + (size_t)2 * 512 * 512 * 2;
constexpr size_t WS_WINO = WS_WOUTE + (size_t)2 * 1024 * 1024 * 2;
constexpr size_t WS_WOUTO = WS_WINO + (size_t)2 * 5248 * 1024 * 2;
constexpr size_t WS_WQ = WS_WOUTO + (size_t)2 * 1024 * 2048 * 2;
constexpr size_t WS_K1 = WS_WQ + (size_t)4 * 2048 * 1024 * 2;
constexpr size_t WS_K2 = WS_K1 + (size_t)4 * 8 * 128 * 128 * 2;
constexpr size_t WS_UB = WS_K2 + (size_t)4 * 8 * 128 * 128 * 2;
constexpr size_t WS_VB = WS_UB + (size_t)16384 * 1024 * 2;
constexpr size_t WS_ACT = WS_VB + (size_t)16384 * 1024 * 2;
constexpr size_t WS_Z = WS_ACT;
constexpr size_t WS_XBCR = WS_Z + (size_t)T * 2048 * 2;
constexpr size_t WS_R = WS_XBCR;
constexpr size_t WS_XS = WS_XBCR + (size_t)T * 3072 * 2;
constexpr size_t WS_BM = WS_XS + (size_t)T * 2048 * 2;
constexpr size_t WS_CM = WS_BM + (size_t)T * 512 * 2;
constexpr size_t WS_XST = WS_CM + (size_t)T * 512 * 2;
constexpr size_t WS_BMT = WS_XST + (size_t)TP * 2048 * 2;
constexpr size_t WS_ST = WS_BMT + (size_t)TP * 512 * 2;
constexpr size_t WS_YG = WS_ST + (size_t)8 * 16 * 32 * 64 * 128 * 4;
constexpr size_t WS_ACTP = WS_YG + (size_t)T * 2048 * 2;
constexpr size_t WS_IDXP = WS_ACTP + (size_t)T * 128 * 4;
constexpr size_t WS_SINB = WS_IDXP + (size_t)T * 128 * 4;
constexpr size_t WS_END = WS_SINB + (size_t)8 * 16 * 32 * 64 * 128 * 2;
constexpr size_t WS_PE = WS_Z;
constexpr size_t WS_G = WS_XS;
constexpr size_t WS_CAT = WS_YG;

struct Params {
  const float* in[37];
  float* out;
  char* ws;
};

DI u16 f2bf(float f) { unsigned u = __float_as_uint(f); u += 0x7fffu + ((u >> 16) & 1u); return (u16)(u >> 16); }
DI float bf2f(u16 h) { return __uint_as_float(((unsigned)h) << 16); }
DI unsigned pack2(float a, float b) { return (unsigned)f2bf(a) | ((unsigned)f2bf(b) << 16); }
DI float lo2f(unsigned u) { return __uint_as_float(u << 16); }
DI float hi2f(unsigned u) { return __uint_as_float(u & 0xffff0000u); }
DI float gelu_tanh(float x) {
  float u = 0.7978845608028654f * (x + 0.044715f * x * x * x);
  float e = __expf(2.f * u);
  float th = 1.f - 2.f / (e + 1.f);
  return 0.5f * x * (1.f + th);
}
DI float sigmoidf_(float x) { return 1.f / (1.f + __expf(-x)); }
DI float siluf_(float x) { return x / (1.f + __expf(-x)); }
DI f32x4 mfma16(bf16x8 a, bf16x8 b, f32x4 c) { return __builtin_amdgcn_mfma_f32_16x16x32_bf16(a, b, c, 0, 0, 0); }
DI void wave_lds_sync() { __builtin_amdgcn_fence(__ATOMIC_ACQ_REL, "workgroup"); __builtin_amdgcn_wave_barrier(); }
DI void st_bf4(u16* dst, float a, float b, float c, float d) { uint2 v; v.x = pack2(a, b); v.y = pack2(c, d); *(uint2*)dst = v; }
DI bf16x8 mk8(uint4 v) { return __builtin_bit_cast(bf16x8, v); }

#define XB_TMO      128
#define XB_XCNT(j)  (256  + 64 * (j))
#define XB_XSUB(j)  (1280 + 64 * (j))
#define XB_XGEN(j)  (2304 + 64 * (j))
#define XB_TOP      3328
#define XB_TOPGEN   3392
#define XCD_BAR_WORDS 3456
#define XB_SPIN_CAP (1u << 22)
#define LAS __attribute__((address_space(3)))
DI unsigned xb_ld(unsigned* p) { return __hip_atomic_load(p, __ATOMIC_RELAXED, __HIP_MEMORY_SCOPE_AGENT); }
DI unsigned xb_add(unsigned* p, unsigned v) { return __hip_atomic_fetch_add(p, v, __ATOMIC_RELAXED, __HIP_MEMORY_SCOPE_AGENT); }
DI unsigned xb_xcc_id() { return (unsigned)__builtin_amdgcn_s_getreg((3 << 11) | 20) & 0xFu; }
#define XB_SPIN(cond, bar) do { unsigned _sp = 0; while (cond) { __builtin_amdgcn_s_sleep(1); \
    if ((++_sp & 255u) == 0u) { if (xb_ld(&(bar)[XB_TMO])) break; if (_sp > XB_SPIN_CAP) { atomicAdd(&(bar)[XB_TMO], 1u); break; } } } } while (0)
struct XcdBarrier { unsigned* bar; unsigned x; volatile LAS unsigned* st; };
DI XcdBarrier xcd_barrier_post(unsigned* bar, volatile LAS unsigned* st) {
  XcdBarrier b; b.bar = bar; b.x = xb_xcc_id(); b.st = st;
  if (threadIdx.x == 0) (void)xb_add(&bar[XB_XCNT(b.x)], 1u);
  return b;
}
DI void xcd_barrier_complete(unsigned* bar, unsigned x, unsigned& nloc, unsigned& nx) {
  const unsigned G = gridDim.x;
  unsigned sum, cnt, mine, sp = 0u;
  for (;;) {
    sum = 0u; cnt = 0u; mine = 0u;
#pragma unroll
    for (unsigned j = 0; j < 16; ++j) { const unsigned c = xb_ld(&bar[XB_XCNT(j)]); sum += c; cnt += (c > 0u) ? 1u : 0u; mine = (j == x) ? c : mine; }
    if (sum == G) break;
    __builtin_amdgcn_s_sleep(1);
    if ((++sp & 255u) == 0u) { if (xb_ld(&bar[XB_TMO])) break; if (sp > XB_SPIN_CAP) { atomicAdd(&bar[XB_TMO], 1u); break; } }
  }
  nloc = mine > 0u ? mine : 1u; nx = cnt > 0u ? cnt : 1u;
}
DI void xcd_barrier(const XcdBarrier& b) {
  asm volatile("s_waitcnt vmcnt(0)" ::: "memory");
  __syncthreads();
  if (threadIdx.x == 0) {
    unsigned* bar = b.bar;
    __builtin_amdgcn_s_waitcnt(0);
    unsigned nloc = b.st[0], nx = b.st[1];
    if (nloc == 0u) { xcd_barrier_complete(bar, b.x, nloc, nx); b.st[0] = nloc; b.st[1] = nx; }
    const unsigned old = xb_add(&bar[XB_XSUB(b.x)], 1u);
    const unsigned gen = old / nloc;
    if (old + 1u == (gen + 1u) * nloc) {
      __builtin_amdgcn_fence(__ATOMIC_RELEASE, "agent");
      asm volatile("s_waitcnt vmcnt(0)" ::: "memory");
      const unsigned og = xb_add(&bar[XB_TOP], 1u);
      const unsigned tg = og / nx;
      if (og + 1u == (tg + 1u) * nx) xb_add(&bar[XB_TOPGEN], 1u);
      else XB_SPIN(xb_ld(&bar[XB_TOPGEN]) == tg, bar);
      __builtin_amdgcn_fence(__ATOMIC_ACQUIRE, "agent");
      xb_add(&bar[XB_XGEN(b.x)], 1u);
      asm volatile("s_waitcnt vmcnt(0)" ::: "memory");
    } else {
      XB_SPIN(xb_ld(&bar[XB_XGEN(b.x)]) == gen, bar);
      __builtin_amdgcn_fence(__ATOMIC_ACQUIRE, "agent");
      asm volatile("s_waitcnt vmcnt(0)" ::: "memory");
    }
  }
  __syncthreads();
}

DI int otid() { int t = threadIdx.x; asm volatile("" : "+v"(t)); return t; }
DI int obid() { int t = blockIdx.x; asm volatile("" : "+s"(t)); return t; }

constexpr int LDSS = 72;
constexpr int GEMM_SMEM = 2 * 128 * LDSS * 2;
template <bool SYNC_EPI = false, class Epi>
DI void gemm_tile(const u16* __restrict__ A, int lda, const u16* __restrict__ Bt, int ldb, int K, int m0, int n0,
                  u16* sm, Epi&& epi) {
  u16* sA = sm; u16* sB = sm + 128 * LDSS;
  const int tid = otid(), lane = tid & 63, wid = tid >> 6, wr = wid >> 1, wc = wid & 1, fr = lane & 15, fq = lane >> 4;
  const int lr = tid >> 3, lc = (tid & 7) * 8;
  const u16* ga = A + (size_t)(m0 + lr) * lda + lc;
  const u16* gb = Bt + (size_t)(n0 + lr) * ldb + lc;
  u32x4 ra[4], rb[4];
#pragma unroll
  for (int i = 0; i < 4; ++i) { ra[i] = *(const u32x4*)(ga + (size_t)(32 * i) * lda); rb[i] = *(const u32x4*)(gb + (size_t)(32 * i) * ldb); }
  f32x4 acc[4][4];
#pragma unroll
  for (int m = 0; m < 4; ++m)
#pragma unroll
    for (int n = 0; n < 4; ++n) acc[m][n] = f32x4{0.f, 0.f, 0.f, 0.f};
  for (int k0 = 0; k0 < K; k0 += 64) {
    __syncthreads();
#pragma unroll
    for (int i = 0; i < 4; ++i) {
      *(u32x4*)(sA + (lr + 32 * i) * LDSS + lc) = ra[i];
      *(u32x4*)(sB + (lr + 32 * i) * LDSS + lc) = rb[i];
    }
    __syncthreads();
    if (k0 + 64 < K) {
#pragma unroll
      for (int i = 0; i < 4; ++i) {
        ra[i] = *(const u32x4*)(ga + (size_t)(32 * i) * lda + k0 + 64);
        rb[i] = *(const u32x4*)(gb + (size_t)(32 * i) * ldb + k0 + 64);
      }
    }
#pragma unroll
    for (int ks = 0; ks < 2; ++ks) {
      bf16x8 af[4], bfr[4];
#pragma unroll
      for (int m = 0; m < 4; ++m) af[m] = *(const bf16x8*)(sA + (wr * 64 + m * 16 + fr) * LDSS + ks * 32 + fq * 8);
#pragma unroll
      for (int n = 0; n < 4; ++n) bfr[n] = *(const bf16x8*)(sB + (wc * 64 + n * 16 + fr) * LDSS + ks * 32 + fq * 8);
#pragma unroll
      for (int m = 0; m < 4; ++m)
#pragma unroll
        for (int n = 0; n < 4; ++n) acc[m][n] = mfma16(bfr[n], af[m], acc[m][n]);
    }
  }
  if (SYNC_EPI) __syncthreads();
#pragma unroll
  for (int m = 0; m < 4; ++m)
#pragma unroll
    for (int n = 0; n < 4; ++n) epi(m0 + wr * 64 + m * 16 + fr, n0 + wc * 64 + n * 16 + fq * 4, acc[m][n], m, n);
}

struct WJob { const float* src; u16* dst; int K, N, Npad; const float* scale; };
DI WJob get_wjob(const Params& p, int j) {
  WJob w; w.scale = nullptr;
  if (j < 2) { w.src = p.in[8] + (size_t)j * 1024 * 1280; w.dst = (u16*)(p.ws + WS_WINE) + (size_t)j * 1280 * 1024; w.K = 1024; w.N = 1280; w.Npad = 1280; }
  else if (j < 4) { int i = j - 2; w.src = p.in[17] + (size_t)i * 512 * 512; w.dst = (u16*)(p.ws + WS_WGLU) + (size_t)i * 512 * 512; w.K = 512; w.N = 512; w.Npad = 512; }
  else if (j < 6) { int i = j - 4; w.src = p.in[19] + (size_t)i * 1024 * 1024; w.dst = (u16*)(p.ws + WS_WOUTE) + (size_t)i * 1024 * 1024; w.K = 1024; w.N = 1024; w.Npad = 1024; }
  else if (j < 8) { int i = j - 6; w.src = p.in[20] + (size_t)i * 1024 * 5152; w.dst = (u16*)(p.ws + WS_WINO) + (size_t)i * 5248 * 1024; w.K = 1024; w.N = 5152; w.Npad = 5248; }
  else if (j < 10) { int i = j - 8; w.src = p.in[27] + (size_t)i * 2048 * 1024; w.dst = (u16*)(p.ws + WS_WOUTO) + (size_t)i * 1024 * 2048; w.K = 2048; w.N = 1024; w.Npad = 1024; w.scale = p.in[26] + (size_t)i * 2048; }
  else { int i = j - 10; w.src = p.in[32] + (size_t)i * 1024 * 2048; w.dst = (u16*)(p.ws + WS_WQ) + (size_t)i * 2048 * 1024; w.K = 1024; w.N = 2048; w.Npad = 2048; }
  return w;
}

DI void phase_prep(const Params& p, char* smem) {
  const int tid = otid();
  const size_t gtid = (size_t)obid() * 256 + tid, gsz = (size_t)gridDim.x * 256;
  {
    float* X = (float*)(p.ws + WS_X); u16* Xb = (u16*)(p.ws + WS_XB);
    for (size_t i = gtid; i < (size_t)T * 256; i += gsz) {
      size_t e = i * 4;
      const float* src = e < (size_t)TP * 1024 ? p.in[0] + e : p.in[1] + (e - (size_t)TP * 1024);
      float4 v = *(const float4*)src;
      *(float4*)(X + e) = v;
      st_bf4(Xb + e, v.x, v.y, v.z, v.w);
    }
  }
  {
    float* tile = (float*)smem;
    for (int j = 0; j < 14; ++j) {
      WJob w = get_wjob(p, j);
      const int tk = w.K / 64, tn = w.Npad / 64;
      for (int t = obid(); t < tk * tn; t += gridDim.x) {
        const int k0 = (t % tk) * 64, n0 = (t / tk) * 64;
        const int c = tid & 63, r4 = tid >> 6;
        __syncthreads();
#pragma unroll
        for (int i = 0; i < 16; ++i) {
          int r = r4 + 4 * i;
          float v = 0.f;
          if (n0 + c < w.N) { v = w.src[(size_t)(k0 + r) * w.N + n0 + c]; if (w.scale) v *= w.scale[k0 + r]; }
          tile[r * 65 + c] = v;
        }
        __syncthreads();
#pragma unroll
        for (int i = 0; i < 16; ++i) {
          int nn = r4 + 4 * i;
          w.dst[(size_t)(n0 + nn) * w.K + k0 + c] = f2bf(tile[c * 65 + nn]);
        }
      }
    }
  }
  {
    u16* k1 = (u16*)(p.ws + WS_K1); u16* k2 = (u16*)(p.ws + WS_K2);
    for (size_t i = gtid; i < (size_t)131072; i += gsz) {
      float4 a = *(const float4*)(p.in[33] + i * 4), b = *(const float4*)(p.in[34] + i * 4);
      st_bf4(k1 + i * 4, a.x, a.y, a.z, a.w);
      st_bf4(k2 + i * 4, b.x, b.y, b.z, b.w);
    }
  }
  {
    float* AB = (float*)(p.ws + WS_AB); float* BBR = (float*)(p.ws + WS_BBR); float* BBI = (float*)(p.ws + WS_BBI);
    u16* CT = (u16*)(p.ws + WS_CT);
    for (size_t i = gtid; i < 4096; i += gsz) {
      int ig = (int)(i >> 6), pp = (int)(i & 63);
      float dt = expf(p.in[11][ig]);
      float lr = p.in[9][i], li = p.in[10][i];
      float mag = expf(lr * dt);
      float abr = mag * cosf(li * dt), abi = mag * sinf(li * dt);
      float den = lr * lr + li * li;
      float nr = abr - 1.f, ni = abi;
      float cr = (nr * lr + ni * li) / den, ci = (ni * lr - nr * li) / den;
      AB[i * 2] = abr; AB[i * 2 + 1] = abi;
      for (int c = 0; c < 16; ++c) {
        float br = p.in[12][i * 16 + c], bi = p.in[13][i * 16 + c];
        BBR[i * 16 + c] = cr * br - ci * bi;
        BBI[i * 16 + c] = cr * bi + ci * br;
        CT[((size_t)ig * 16 + c) * 128 + pp] = f2bf(p.in[14][((size_t)ig * 16 + c) * 64 + pp]);
        CT[((size_t)ig * 16 + c) * 128 + 64 + pp] = f2bf(-p.in[15][((size_t)ig * 16 + c) * 64 + pp]);
      }
    }
  }
  {
    for (size_t i = gtid; i < (size_t)2 * 128 * 127 * 32; i += gsz) {
      size_t q = i & 31, row = (i >> 5) % 127, is = (i >> 5) / 127;
      size_t so = (is * 128 + row + 1) * 128 + q * 4, dn = (is * 128 + row) * 128 + q * 4;
      *(float4*)(p.out + O_SSWAK + dn) = *(const float4*)(p.in[4] + so);
      *(float4*)(p.out + O_SSWAV + dn) = *(const float4*)(p.in[5] + so);
    }
    for (size_t i = gtid; i < (size_t)2 * 128 * 2 * 768; i += gsz) {
      size_t q = i % 768, row = (i / 768) & 1, is = i / 1536;
      *(float4*)(p.out + O_SCONV + (is * 3 + row) * 3072 + q * 4) = *(const float4*)(p.in[7] + (is * 3 + row + 1) * 3072 + q * 4);
    }
  }
}

constexpr float U8_SCALE = 256.f, V8_SCALE = 64.f;
DI unsigned enc4(float4 a, float sc) {
  int pk = __builtin_amdgcn_cvt_pk_fp8_f32(a.x * sc, a.y * sc, 0, false);
  pk = __builtin_amdgcn_cvt_pk_fp8_f32(a.z * sc, a.w * sc, pk, true);
  return (unsigned)pk;
}
DI void convert_tables(const Params& p, int layer) {
  const size_t gtid = (size_t)obid() * 256 + otid(), gsz = (size_t)gridDim.x * 256;
  const float* u = p.in[35] + (size_t)layer * 16384 * 1024;
  const float* v = p.in[36] + (size_t)layer * 16384 * 1024;
  unsigned char* ub = (unsigned char*)(p.ws + WS_UB); unsigned char* vb = (unsigned char*)(p.ws + WS_VB);
  for (size_t i = gtid; i < (size_t)16384 * 1024 / 16; i += gsz) {
    u32x4 o;
#pragma unroll
    for (int q = 0; q < 4; ++q) o[q] = enc4(*(const float4*)(u + i * 16 + q * 4), U8_SCALE);
    {
      const size_t e0 = i * 16, row = e0 >> 10, col = e0 & 1023;
      *(u32x4*)(ub + (col >> 7) * (size_t)2097152 + row * 128 + (col & 127)) = o;
    }
#pragma unroll
    for (int q = 0; q < 4; ++q) o[q] = enc4(*(const float4*)(v + i * 16 + q * 4), V8_SCALE);
    {
      const size_t e0 = i * 16, row = e0 >> 10, col = e0 & 1023;
      *(u32x4*)(vb + (col >> 7) * (size_t)2097152 + row * 128 + (col & 127)) = o;
    }
  }
}

DI void phase_e_inproj(const Params& p, int i, char* smem) {
  const u16* Xb = (const u16*)(p.ws + WS_XB);
  const u16* W = (const u16*)(p.ws + WS_WINE) + (size_t)i * 1280 * 1024;
  u16* PE = (u16*)(p.ws + WS_PE);
  float* out = p.out;
  for (int t = obid(); t < 129 * 10; t += gridDim.x) {
    const int mt = t / 10, nt = t % 10;
    gemm_tile(Xb, 1024, W, 1024, 1024, mt * 128, nt * 128, (u16*)smem, [&](int tok, int n, f32x4 v, int, int) {
      st_bf4(PE + (size_t)tok * 1280 + n, v[0], v[1], v[2], v[3]);
      if (n >= 1024) {
        const int isv = n >= 1152; const int col = n - (isv ? 1152 : 1024);
        if (tok >= TP) {
          size_t o = (isv ? O_SSWAV : O_SSWAK) + (((size_t)i * 128 + (tok - TP)) * 128 + 127) * 128 + col;
          *(float4*)(out + o) = float4{v[0], v[1], v[2], v[3]};
        } else {
          const int b = tok >> 11, l = tok & 2047;
          if (l >= 1920) {
            size_t o = (isv ? O_PSWAV : O_PSWAK) + (((size_t)i * 8 + b) * 128 + (l - 1920)) * 128 + col;
            *(float4*)(out + o) = float4{v[0], v[1], v[2], v[3]};
          }
        }
      }
    });
  }
}

DI void s5_pass1(const Params& p, int i, char* smem) {
  const int lane = otid() & 63, wid = otid() >> 6;
  float* Us = (float*)smem + wid * 1024;
  const u16* PE = (const u16*)(p.ws + WS_PE);
  const float* AB = (const float*)(p.ws + WS_AB); const float* BBR = (const float*)(p.ws + WS_BBR); const float* BBI = (const float*)(p.ws + WS_BBI);
  float2* E = (float2*)(p.ws + WS_E);
  for (int it = obid() * 4 + wid; it < 8192; it += gridDim.x * 4) {
    const int g = it & 31, chunk = (it >> 5) & 31, b = it >> 10;
    const size_t pi = ((size_t)i * 32 + g) * 64 + lane;
    float bbr[16], bbi[16];
#pragma unroll
    for (int c = 0; c < 4; ++c) {
      float4 a = *(const float4*)(BBR + pi * 16 + c * 4), bb = *(const float4*)(BBI + pi * 16 + c * 4);
      bbr[c * 4] = a.x; bbr[c * 4 + 1] = a.y; bbr[c * 4 + 2] = a.z; bbr[c * 4 + 3] = a.w;
      bbi[c * 4] = bb.x; bbi[c * 4 + 1] = bb.y; bbi[c * 4 + 2] = bb.z; bbi[c * 4 + 3] = bb.w;
    }
    const float abr = AB[pi * 2], abi = AB[pi * 2 + 1];
    const size_t t0 = (size_t)b * 2048 + chunk * 64;
    wave_lds_sync();
    {
      const u16* row = PE + (t0 + lane) * 1280 + g * 16;
      uint4 a = *(const uint4*)row, c = *(const uint4*)(row + 8);
      float* d = Us + lane * 16;
      *(float4*)(d) = float4{lo2f(a.x), hi2f(a.x), lo2f(a.y), hi2f(a.y)};
      *(float4*)(d + 4) = float4{lo2f(a.z), hi2f(a.z), lo2f(a.w), hi2f(a.w)};
      *(float4*)(d + 8) = float4{lo2f(c.x), hi2f(c.x), lo2f(c.y), hi2f(c.y)};
      *(float4*)(d + 12) = float4{lo2f(c.z), hi2f(c.z), lo2f(c.w), hi2f(c.w)};
    }
    wave_lds_sync();
    float hr = 0.f, hi = 0.f;
    for (int t = 0; t < 64; ++t) {
      float bur = 0.f, bui = 0.f;
#pragma unroll
      for (int c = 0; c < 4; ++c) {
        float4 u = *(const float4*)(Us + t * 16 + c * 4);
        bur += bbr[c * 4] * u.x + bbr[c * 4 + 1] * u.y + bbr[c * 4 + 2] * u.z + bbr[c * 4 + 3] * u.w;
        bui += bbi[c * 4] * u.x + bbi[c * 4 + 1] * u.y + bbi[c * 4 + 2] * u.z + bbi[c * 4 + 3] * u.w;
      }
      float nr = abr * hr - abi * hi + bur, ni = abr * hi + abi * hr + bui;
      hr = nr; hi = ni;
    }
    E[(size_t)it * 64 + lane] = float2{hr, hi};
  }
}

DI void s5_pass3(const Params& p, int i, char* smem) {
  const int lane = otid() & 63, wid = otid() >> 6, fr = lane & 15, fq = lane >> 4;
  float* Us = (float*)smem + wid * 1024;
  u16* Hs = (u16*)(smem + 16384) + wid * (16 * 136);
  const u16* PE = (const u16*)(p.ws + WS_PE);
  const float* AB = (const float*)(p.ws + WS_AB); const float* BBR = (const float*)(p.ws + WS_BBR); const float* BBI = (const float*)(p.ws + WS_BBI);
  const u16* CT = (const u16*)(p.ws + WS_CT);
  const float2* E = (const float2*)(p.ws + WS_E);
  u16* G = (u16*)(p.ws + WS_G);
  for (int it = obid() * 4 + wid; it < 8192 + 4096; it += gridDim.x * 4) {
    const bool smp = it >= 8192;
    int g, chunk, b, count; size_t t0;
    if (!smp) { g = it & 31; chunk = (it >> 5) & 31; b = it >> 10; count = 64; t0 = (size_t)b * 2048 + chunk * 64; }
    else { int r = it - 8192; g = r & 31; b = r >> 5; chunk = 0; count = 1; t0 = (size_t)TP + b; }
    const size_t pi = ((size_t)i * 32 + g) * 64 + lane;
    float bbr[16], bbi[16];
#pragma unroll
    for (int c = 0; c < 4; ++c) {
      float4 a = *(const float4*)(BBR + pi * 16 + c * 4), bb = *(const float4*)(BBI + pi * 16 + c * 4);
      bbr[c * 4] = a.x; bbr[c * 4 + 1] = a.y; bbr[c * 4 + 2] = a.z; bbr[c * 4 + 3] = a.w;
      bbi[c * 4] = bb.x; bbi[c * 4 + 1] = bb.y; bbi[c * 4 + 2] = bb.z; bbi[c * 4 + 3] = bb.w;
    }
    const float abr = AB[pi * 2], abi = AB[pi * 2 + 1];
    float hr = 0.f, hi = 0.f;
    if (!smp) {
      float qr = abr, qi = abi;
#pragma unroll
      for (int s = 0; s < 6; ++s) { float nr = qr * qr - qi * qi, ni = 2.f * qr * qi; qr = nr; qi = ni; }
      for (int j = 0; j < chunk; ++j) {
        float2 e = E[(((size_t)b * 32 + j) * 32 + g) * 64 + lane];
        float nr = qr * hr - qi * hi + e.x, ni = qr * hi + qi * hr + e.y;
        hr = nr; hi = ni;
      }
    } else {
      const size_t so = (((size_t)i * 128 + b) * 32 + g) * 64 + lane;
      float h0r = p.in[2][so], h0i = p.in[3][so];
      hr = h0r; hi = h0i;
    }
    bf16x8 ctf[4];
#pragma unroll
    for (int ks = 0; ks < 4; ++ks) ctf[ks] = *(const bf16x8*)(CT + (((size_t)i * 32 + g) * 16 + fr) * 128 + ks * 32 + fq * 8);
    const float4 d4 = *(const float4*)(p.in[16] + (size_t)i * 512 + g * 16 + fq * 4);
    wave_lds_sync();
    {
      float* d = Us + lane * 16;
      if (lane < count) {
        const u16* row = PE + (t0 + lane) * 1280 + g * 16;
        uint4 a = *(const uint4*)row, c = *(const uint4*)(row + 8);
        *(float4*)(d) = float4{lo2f(a.x), hi2f(a.x), lo2f(a.y), hi2f(a.y)};
        *(float4*)(d + 4) = float4{lo2f(a.z), hi2f(a.z), lo2f(a.w), hi2f(a.w)};
        *(float4*)(d + 8) = float4{lo2f(c.x), hi2f(c.x), lo2f(c.y), hi2f(c.y)};
        *(float4*)(d + 12) = float4{lo2f(c.z), hi2f(c.z), lo2f(c.w), hi2f(c.w)};
      } else {
        *(float4*)(d) = float4{0, 0, 0, 0}; *(float4*)(d + 4) = float4{0, 0, 0, 0};
        *(float4*)(d + 8) = float4{0, 0, 0, 0}; *(float4*)(d + 12) = float4{0, 0, 0, 0};
      }
    }
    wave_lds_sync();
    const int nsub = (count + 15) >> 4;
    for (int sub = 0; sub < nsub; ++sub) {
      for (int tt = 0; tt < 16; ++tt) {
        const int t = sub * 16 + tt;
        float wr_ = 0.f, wi_ = 0.f;
        if (t < count) {
          float bur = 0.f, bui = 0.f;
#pragma unroll
          for (int c = 0; c < 4; ++c) {
            float4 u = *(const float4*)(Us + t * 16 + c * 4);
            bur += bbr[c * 4] * u.x + bbr[c * 4 + 1] * u.y + bbr[c * 4 + 2] * u.z + bbr[c * 4 + 3] * u.w;
            bui += bbi[c * 4] * u.x + bbi[c * 4 + 1] * u.y + bbi[c * 4 + 2] * u.z + bbi[c * 4 + 3] * u.w;
          }
          float nr = abr * hr - abi * hi + bur, ni = abr * hi + abi * hr + bui;
          hr = nr; hi = ni; wr_ = hr; wi_ = hi;
        }
        Hs[tt * 136 + lane] = f2bf(wr_);
        Hs[tt * 136 + 64 + lane] = f2bf(wi_);
      }
      wave_lds_sync();
      f32x4 acc = f32x4{0.f, 0.f, 0.f, 0.f};
#pragma unroll
      for (int ks = 0; ks < 4; ++ks) {
        bf16x8 hf = *(const bf16x8*)(Hs + fr * 136 + ks * 32 + fq * 8);
        acc = mfma16(ctf[ks], hf, acc);
      }
      const int t = sub * 16 + fr;
      if (t < count) {
        float4 u4 = *(const float4*)(Us + t * 16 + fq * 4);
        float y0 = gelu_tanh(acc[0] + d4.x * u4.x), y1 = gelu_tanh(acc[1] + d4.y * u4.y);
        float y2 = gelu_tanh(acc[2] + d4.z * u4.z), y3 = gelu_tanh(acc[3] + d4.w * u4.w);
        st_bf4(G + (t0 + t) * 512 + g * 16 + fq * 4, y0, y1, y2, y3);
      }
      wave_lds_sync();
    }
    if (smp) {
      const size_t so = (((size_t)i * 128 + b) * 32 + g) * 64 + lane;
      p.out[O_SS5RE + so] = hr; p.out[O_SS5IM + so] = hi;
    } else if (chunk == 31) {
      const size_t so = (((size_t)i * 8 + b) * 32 + g) * 64 + lane;
      p.out[O_PS5RE + so] = hr; p.out[O_PS5IM + so] = hi;
    }
  }
}

constexpr int VTS = 264;
DI void swa_prompt(const Params& p, int i, char* smem) {
  const int tid = otid(), lane = tid & 63, w = tid >> 6, fr = lane & 15, fq = lane >> 4;
  u16* Vt = (u16*)smem;
  const u16* PE = (const u16*)(p.ws + WS_PE);
  u16* CAT = (u16*)(p.ws + WS_CAT);
  for (int it = obid(); it < 1024; it += gridDim.x) {
    const int qb = it & 15, h = (it >> 4) & 7, b = it >> 7, kvh = h >> 2;
    const float slope = exp2f(-(float)(h + 1));
    const float sink = p.in[18][i * 8 + h];
    __syncthreads();
    {
      const int l = qb * 128 - 128 + tid;
      u32x4 v[8];
      if (l >= 0) {
        const u16* row = PE + ((size_t)b * 2048 + l) * 1280 + 1152 + kvh * 64;
#pragma unroll
        for (int c = 0; c < 8; ++c) v[c] = *(const u32x4*)(row + c * 8);
      } else {
#pragma unroll
        for (int c = 0; c < 8; ++c) v[c] = u32x4{0, 0, 0, 0};
      }
#pragma unroll
      for (int c = 0; c < 8; ++c) {
#pragma unroll
        for (int q = 0; q < 4; ++q) {
          Vt[(c * 8 + 2 * q) * VTS + tid] = (u16)(v[c][q] & 0xffff);
          Vt[(c * 8 + 2 * q + 1) * VTS + tid] = (u16)(v[c][q] >> 16);
        }
      }
    }
    __syncthreads();
#pragma unroll 1
    for (int qt = 0; qt < 2; ++qt) {
      const int rq = 32 * w + 16 * qt, kt0 = 2 * w + qt;
      const size_t qtok = (size_t)b * 2048 + qb * 128 + rq + fr;
      bf16x8 qf[2];
#pragma unroll
      for (int ks = 0; ks < 2; ++ks) qf[ks] = *(const bf16x8*)(PE + qtok * 1280 + 512 + h * 64 + ks * 32 + fq * 8);
      f32x4 s[9];
#pragma unroll
      for (int c = 0; c < 9; ++c) {
        s[c] = f32x4{0.f, 0.f, 0.f, 0.f};
        const int l = qb * 128 - 128 + (kt0 + c) * 16 + fr;
#pragma unroll
        for (int ks = 0; ks < 2; ++ks) {
          bf16x8 kf = bf16x8{0, 0, 0, 0, 0, 0, 0, 0};
          if (l >= 0) kf = *(const bf16x8*)(PE + ((size_t)b * 2048 + l) * 1280 + 1024 + kvh * 64 + ks * 32 + fq * 8);
          s[c] = mfma16(kf, qf[ks], s[c]);
        }
      }
      const int r = rq + fr;
      float mx = -1e30f;
#pragma unroll
      for (int c = 0; c < 9; ++c)
#pragma unroll
        for (int j = 0; j < 4; ++j) {
          const int kl = (kt0 + c) * 16 + fq * 4 + j;
          const int dist = 128 + r - kl;
          const bool valid = dist >= 0 && dist < 128 && (qb * 128 - 128 + kl) >= 0;
          float sc = valid ? s[c][j] * 0.125f - slope * (float)dist : -1e30f;
          s[c][j] = sc; mx = fmaxf(mx, sc);
        }
      mx = fmaxf(mx, __shfl_xor(mx, 16)); mx = fmaxf(mx, __shfl_xor(mx, 32));
      const float m = fmaxf(mx, sink);
      float sum = 0.f;
#pragma unroll
      for (int c = 0; c < 9; ++c)
#pragma unroll
        for (int j = 0; j < 4; ++j) { float e = __expf(s[c][j] - m); s[c][j] = e; sum += e; }
      sum += __shfl_xor(sum, 16); sum += __shfl_xor(sum, 32);
      const float inv = 1.f / (sum + __expf(sink - m));
      f32x4 o[4];
#pragma unroll
      for (int d = 0; d < 4; ++d) o[d] = f32x4{0.f, 0.f, 0.f, 0.f};
#pragma unroll
      for (int pr = 0; pr < 5; ++pr) {
        const int ia = 2 * pr, ib = 2 * pr + 1;
        uint4 pk;
        pk.x = pack2(s[ia][0], s[ia][1]); pk.y = pack2(s[ia][2], s[ia][3]);
        if (ib < 9) { pk.z = pack2(s[ib < 9 ? ib : 8][0], s[ib < 9 ? ib : 8][1]); pk.w = pack2(s[ib < 9 ? ib : 8][2], s[ib < 9 ? ib : 8][3]); }
        else { pk.z = 0; pk.w = 0; }
        const bf16x8 pf = mk8(pk);
        int ta = kt0 + ia, tb = kt0 + ib; if (tb > 15) tb = 15;
#pragma unroll
        for (int d = 0; d < 4; ++d) {
          const u16* vr = Vt + (d * 16 + fr) * VTS;
          uint2 va = *(const uint2*)(vr + ta * 16 + fq * 4), vb = *(const uint2*)(vr + tb * 16 + fq * 4);
          o[d] = mfma16(mk8(uint4{va.x, va.y, vb.x, vb.y}), pf, o[d]);
        }
      }
#pragma unroll
      for (int d = 0; d < 4; ++d)
        st_bf4(CAT + qtok * 1024 + 512 + h * 64 + d * 16 + fq * 4, o[d][0] * inv, o[d][1] * inv, o[d][2] * inv, o[d][3] * inv);
    }
  }
}

DI void swa_sample(const Params& p, int i, char* smem) {
  const int lane = otid() & 63, wid = otid() >> 6;
  float* Ps = (float*)smem + wid * 128;
  const u16* PE = (const u16*)(p.ws + WS_PE);
  u16* CAT = (u16*)(p.ws + WS_CAT);
  for (int it = obid() * 4 + wid; it < 1024; it += gridDim.x * 4) {
    const int h = it & 7, s = it >> 3, kvh = h >> 2;
    const float slope = exp2f(-(float)(h + 1));
    const float sink = p.in[18][i * 8 + h];
    const size_t tok = (size_t)TP + s;
    const u16* qrow = PE + tok * 1280 + 512 + h * 64;
    const u16* knew = PE + tok * 1280 + 1024 + kvh * 64;
    const u16* vnew = PE + tok * 1280 + 1152 + kvh * 64;
    const float* kc = p.in[4] + (((size_t)i * 128 + s) * 128) * 128 + kvh * 64;
    const float* vc = p.in[5] + (((size_t)i * 128 + s) * 128) * 128 + kvh * 64;
    float sc[2];
#pragma unroll
    for (int hh = 0; hh < 2; ++hh) {
      const int id = lane + hh * 64;
      float dot = 0.f;
      if (id < 127) {
        const float* kr = kc + (size_t)(id + 1) * 128;
        for (int d = 0; d < 64; d += 4) {
          float4 kv = *(const float4*)(kr + d);
          uint2 qq = *(const uint2*)(qrow + d);
          dot += kv.x * lo2f(qq.x) + kv.y * hi2f(qq.x) + kv.z * lo2f(qq.y) + kv.w * hi2f(qq.y);
        }
      } else {
        for (int d = 0; d < 64; d += 4) {
          uint2 kk = *(const uint2*)(knew + d);
          uint2 qq = *(const uint2*)(qrow + d);
          dot += lo2f(kk.x) * lo2f(qq.x) + hi2f(kk.x) * hi2f(qq.x) + lo2f(kk.y) * lo2f(qq.y) + hi2f(kk.y) * hi2f(qq.y);
        }
      }
      sc[hh] = dot * 0.125f - slope * (float)(127 - id);
    }
    float mx = fmaxf(sc[0], sc[1]);
#pragma unroll
    for (int o = 32; o > 0; o >>= 1) mx = fmaxf(mx, __shfl_xor(mx, o));
    const float m = fmaxf(mx, sink);
    float e0 = __expf(sc[0] - m), e1 = __expf(sc[1] - m);
    float sum = e0 + e1;
#pragma unroll
    for (int o = 32; o > 0; o >>= 1) sum += __shfl_xor(sum, o);
    const float inv = 1.f / (sum + __expf(sink - m));
    wave_lds_sync();
    Ps[lane] = e0 * inv; Ps[lane + 64] = e1 * inv;
    wave_lds_sync();
    float o = 0.f;
    for (int id = 0; id < 127; ++id) o += Ps[id] * vc[(size_t)(id + 1) * 128 + lane];
    o += Ps[127] * bf2f(vnew[lane]);
    CAT[tok * 1024 + 512 + h * 64 + lane] = f2bf(o);
  }
}

DI void phase_e_glu(const Params& p, int i, char* smem) {
  const u16* G = (const u16*)(p.ws + WS_G);
  const u16* W = (const u16*)(p.ws + WS_WGLU) + (size_t)i * 512 * 512;
  u16* CAT = (u16*)(p.ws + WS_CAT);
  for (int t = obid(); t < 129 * 4; t += gridDim.x) {
    const int mt = t / 4, nt = t % 4;
    gemm_tile(G, 512, W, 512, 512, mt * 128, nt * 128, (u16*)smem, [&](int tok, int n, f32x4 v, int, int) {
      uint2 gg = *(const uint2*)(G + (size_t)tok * 512 + n);
      float g0 = lo2f(gg.x), g1 = hi2f(gg.x), g2 = lo2f(gg.y), g3 = hi2f(gg.y);
      st_bf4(CAT + (size_t)tok * 1024 + n, g0 * sigmoidf_(v[0]), g1 * sigmoidf_(v[1]), g2 * sigmoidf_(v[2]), g3 * sigmoidf_(v[3]));
    });
  }
}

DI void phase_outproj(const Params& p, const u16* A, int K, const u16* W, bool use_ssq, char* smem) {
  const float* X = (const float*)(p.ws + WS_X);
  float* R = (float*)(p.ws + WS_R);
  const float* SSQ = (const float*)(p.ws + WS_SSQ);
  for (int t = obid(); t < 129 * 8; t += gridDim.x) {
    const int mt = t / 8, nt = t % 8;
    gemm_tile(A, K, W, K, K, mt * 128, nt * 128, (u16*)smem, [&](int tok, int n, f32x4 v, int, int) {
      float sc = 1.f;
      if (use_ssq) {
        float ssum = 0.f;
#pragma unroll
        for (int q = 0; q < 8; ++q) { float4 s4 = *(const float4*)(SSQ + (size_t)tok * 32 + q * 4); ssum += (s4.x + s4.y) + (s4.z + s4.w); }
        sc = rsqrtf(ssum * (1.f / 2048.f) + 1e-5f);
      }
      float4 x = *(const float4*)(X + (size_t)tok * 1024 + n);
      *(float4*)(R + (size_t)tok * 1024 + n) = float4{ALPHA * x.x + sc * v[0], ALPHA * x.y + sc * v[1], ALPHA * x.z + sc * v[2], ALPHA * x.w + sc * v[3]};
    });
  }
}

DI void phase_ln1(const Params& p, int layer) {
  const int lane = otid() & 63, wid = otid() >> 6;
  const float* R = (const float*)(p.ws + WS_R);
  float* X = (float*)(p.ws + WS_X); u16* Xb = (u16*)(p.ws + WS_XB);
  const float* gam = p.in[28] + (size_t)layer * 1024; const float* bet = p.in[29] + (size_t)layer * 1024;
  for (int tok = obid() * 4 + wid; tok < T; tok += gridDim.x * 4) {
    float4 v[4];
    float s = 0.f;
#pragma unroll
    for (int c = 0; c < 4; ++c) { v[c] = *(const float4*)(R + (size_t)tok * 1024 + c * 256 + lane * 4); s += v[c].x + v[c].y + v[c].z + v[c].w; }
#pragma unroll
    for (int o = 32; o > 0; o >>= 1) s += __shfl_xor(s, o);
    const float mu = s * (1.f / 1024.f);
    float q = 0.f;
#pragma unroll
    for (int c = 0; c < 4; ++c) { float a = v[c].x - mu, b = v[c].y - mu, cc = v[c].z - mu, d = v[c].w - mu; q += a * a + b * b + cc * cc + d * d; }
#pragma unroll
    for (int o = 32; o > 0; o >>= 1) q += __shfl_xor(q, o);
    const float rstd = rsqrtf(q * (1.f / 1024.f) + 1e-5f);
#pragma unroll
    for (int c = 0; c < 4; ++c) {
      const int col = c * 256 + lane * 4;
      float4 g = *(const float4*)(gam + col), bb = *(const float4*)(bet + col);
      float4 o = float4{(v[c].x - mu) * rstd * g.x + bb.x, (v[c].y - mu) * rstd * g.y + bb.y, (v[c].z - mu) * rstd * g.z + bb.z, (v[c].w - mu) * rstd * g.w + bb.w};
      *(float4*)(X + (size_t)tok * 1024 + col) = o;
      st_bf4(Xb + (size_t)tok * 1024 + col, o.x, o.y, o.z, o.w);
    }
  }
}

DI unsigned sortkey(float f) { unsigned u = __float_as_uint(f); return u ^ ((u >> 31) ? 0xffffffffu : 0x80000000u); }
DI float unsortkey(unsigned k) { unsigned u = (k & 0x80000000u) ? (k ^ 0x80000000u) : ~k; return __uint_as_float(u); }

constexpr int QSS = 136;
constexpr int PEER_LST_OFF = GEMM_SMEM;
DI void phase_peer1(const Params& p, int layer, char* smem) {
  const int tid = otid(), lane = tid & 63, w = tid >> 6, fr = lane & 15, fq = lane >> 4;
  const u16* Xb = (const u16*)(p.ws + WS_XB);
  const u16* WQ = (const u16*)(p.ws + WS_WQ) + (size_t)layer * 2048 * 1024;
  u16* Qs = (u16*)smem;
  unsigned* Ls = (unsigned*)(smem + PEER_LST_OFF);
  int* IDX = (int*)(p.ws + WS_IDXP); float* GATE = (float*)(p.ws + WS_GATE);
  for (int it = obid(); it < 129 * 8; it += gridDim.x) {
    const int mt = it >> 3, h = it & 7;
#pragma unroll 1
    for (int half = 0; half < 2; ++half) {
      const int m0 = mt * 128, n0 = h * 256 + half * 128;
      gemm_tile<true>(Xb, 1024, WQ, 1024, 1024, m0, n0, (u16*)smem, [&](int tok, int n, f32x4 v, int, int) {
        st_bf4(Qs + (tok - m0) * QSS + (n - n0), v[0], v[1], v[2], v[3]);
      });
      __syncthreads();
      const u16* KT = (const u16*)(p.ws + (half ? WS_K2 : WS_K1)) + ((size_t)layer * 8 + h) * 128 * 128;
#pragma unroll 1
      for (int tt = 0; tt < 2; ++tt) {
        bf16x8 qf[4];
#pragma unroll
        for (int ks = 0; ks < 4; ++ks) qf[ks] = *(const bf16x8*)(Qs + (32 * w + tt * 16 + fr) * QSS + ks * 32 + fq * 8);
        unsigned k[32];
#pragma unroll
        for (int kt = 0; kt < 8; ++kt) {
          f32x4 sc = f32x4{0.f, 0.f, 0.f, 0.f};
#pragma unroll
          for (int ks = 0; ks < 4; ++ks) {
            bf16x8 kf = *(const bf16x8*)(KT + (size_t)(kt * 16 + fr) * 128 + ks * 32 + fq * 8);
            sc = mfma16(kf, qf[ks], sc);
          }
#pragma unroll
          for (int j = 0; j < 4; ++j) k[kt * 4 + j] = (sortkey(sc[j]) & ~127u) | (unsigned)(kt * 16 + fq * 4 + j);
          if (kt & 1) __builtin_amdgcn_sched_barrier(0);
        }
        unsigned* lp = Ls + (32 * w + tt * 16 + fr) * 32 + half * 16;
#pragma unroll 1
        for (int r = 0; r < 16; ++r) {
          unsigned m = k[0];
#pragma unroll
          for (int q = 1; q < 32; ++q) m = m > k[q] ? m : k[q];
          unsigned o = __shfl_xor(m, 16); m = m > o ? m : o;
          o = __shfl_xor(m, 32); m = m > o ? m : o;
          if (fq == 0) lp[r] = m;
#pragma unroll
          for (int q = 0; q < 32; ++q) k[q] = (k[q] == m) ? 0u : k[q];
        }
      }
    }
    wave_lds_sync();
#pragma unroll 1
    for (int tt = 0; tt < 2; ++tt) {
      const unsigned* lp = Ls + (32 * w + tt * 16 + fr) * 32;
      float sum[21]; unsigned key[21]; int eidx[21];
      unsigned l2[16];
#pragma unroll
      for (int j = 0; j < 16; ++j) l2[j] = lp[16 + j];
#pragma unroll
      for (int m = 0; m < 4; ++m) {
        const unsigned a = lp[4 * m + fq];
        const float av = unsortkey(a & ~127u); const int ai = (int)(a & 127u);
        const int J = m == 0 ? 16 : m == 1 ? 3 : 1;
        const int base = m == 0 ? 0 : m == 1 ? 16 : m == 2 ? 19 : 20;
#pragma unroll
        for (int j = 0; j < J; ++j) {
          const unsigned b = l2[j];
          const float sj = av + unsortkey(b & ~127u);
          sum[base + j] = sj;
          key[base + j] = (sortkey(sj) & ~127u) | (unsigned)(fq << 5) | (unsigned)(base + j);
          eidx[base + j] = ai * 128 + (int)(b & 127u);
        }
      }
      const size_t tok = (size_t)mt * 128 + 32 * w + tt * 16 + fr;
      int* ip = IDX + tok * 128; float* gp = GATE + tok * 128 + h * 16;
      float mxs = 0.f;
#pragma unroll 1
      for (int r = 0; r < 16; ++r) {
        unsigned m = key[0];
#pragma unroll
        for (int c = 1; c < 21; ++c) m = m > key[c] ? m : key[c];
        unsigned o = __shfl_xor(m, 16); m = m > o ? m : o;
        o = __shfl_xor(m, 32); m = m > o ? m : o;
        float ws_ = -3.0e38f; int wi = 0;
#pragma unroll
        for (int c = 0; c < 21; ++c) { const bool hit = key[c] == m; ws_ = hit ? sum[c] : ws_; wi = hit ? eidx[c] : wi; key[c] = hit ? 0u : key[c]; }
        ws_ = fmaxf(ws_, __shfl_xor(ws_, 16)); ws_ = fmaxf(ws_, __shfl_xor(ws_, 32));
        int oi = __shfl_xor(wi, 16); wi = wi > oi ? wi : oi;
        oi = __shfl_xor(wi, 32); wi = wi > oi ? wi : oi;
        if (r == 0) mxs = ws_;
        if (fq == 0) { ip[(r & 7) * 16 + 2 * h + (r >> 3)] = wi; gp[r] = __expf(ws_ - mxs); }
      }
    }
    wave_lds_sync();
  }
}

typedef __attribute__((ext_vector_type(2))) float f32x2;
DI void dec16(u32x4 r, f32x2 (&o)[8]) {
#pragma unroll
  for (int q = 0; q < 4; ++q) { o[2 * q] = __builtin_amdgcn_cvt_pk_f32_fp8((int)r[q], false); o[2 * q + 1] = __builtin_amdgcn_cvt_pk_f32_fp8((int)r[q], true); }
}
DI float dpp_f(float v, const int ctrl_sel) {
  const int x = __builtin_bit_cast(int, v);
  int r;
  if (ctrl_sel == 0) r = __builtin_amdgcn_update_dpp(0, x, 0xB1, 0xF, 0xF, true);
  else if (ctrl_sel == 1) r = __builtin_amdgcn_update_dpp(0, x, 0x4E, 0xF, 0xF, true);
  else if (ctrl_sel == 2) r = __builtin_amdgcn_update_dpp(0, x, 0x141, 0xF, 0xF, true);
  else r = __builtin_amdgcn_update_dpp(0, x, 0x140, 0xF, 0xF, true);
  return __builtin_bit_cast(float, r);
}
DI float wave_sum_uniform(float v) {
  v += dpp_f(v, 0); v += dpp_f(v, 1); v += dpp_f(v, 2); v += dpp_f(v, 3);
  const int x = __builtin_bit_cast(int, v);
  const float r0 = __builtin_bit_cast(float, __builtin_amdgcn_readlane(x, 0)), r1 = __builtin_bit_cast(float, __builtin_amdgcn_readlane(x, 16));
  const float r2 = __builtin_bit_cast(float, __builtin_amdgcn_readlane(x, 32)), r3 = __builtin_bit_cast(float, __builtin_amdgcn_readlane(x, 48));
  return (r0 + r1) + (r2 + r3);
}
DI float row16_sum(float v) { v += dpp_f(v, 0); v += dpp_f(v, 1); v += dpp_f(v, 2); v += dpp_f(v, 3); return v; }

DI void phase_peer3u(const Params& p, int layer) {
  const int lane = otid() & 63, wid = otid() >> 6;
  const unsigned char* UB = (const unsigned char*)(p.ws + WS_UB);
  const int* IDXP = (const int*)(p.ws + WS_IDXP); const float* GATE = (const float*)(p.ws + WS_GATE);
  const u16* Xb = (const u16*)(p.ws + WS_XB);
  float* ACTP = (float*)(p.ws + WS_ACTP); float* HP = (float*)(p.ws + WS_IDX);
  const int r = lane >> 3, c = lane & 7;
  const bool b0 = c & 1, b1 = c & 2, b2 = c & 4;
  const int itbase = (b0 ? 8 : 0) + (b1 ? 4 : 0) + (b2 ? 2 : 0);
  const int stride = gridDim.x * 4;
#pragma unroll 1
  for (int cb = 0; cb < 8; ++cb) {
    int tok = obid() * 4 + wid;
    int idp[16]; u32x4 xa, xb; f32x2 hp = f32x2{0.f, 0.f};
    if (tok < T) {
#pragma unroll
      for (int q = 0; q < 4; ++q) { const int4 iv = *(const int4*)(IDXP + (size_t)tok * 128 + r * 16 + q * 4); idp[q * 4] = iv.x; idp[q * 4 + 1] = iv.y; idp[q * 4 + 2] = iv.z; idp[q * 4 + 3] = iv.w; }
      xa = *(const u32x4*)(Xb + (size_t)tok * 1024 + cb * 128 + c * 16); xb = *(const u32x4*)(Xb + (size_t)tok * 1024 + cb * 128 + c * 16 + 8);
      if (cb > 0) hp = *(const f32x2*)(HP + (size_t)tok * 128 + r * 16 + itbase);
    }
#pragma unroll 1
    while (tok < T) {
      u32x4 rr[16];
#pragma unroll
      for (int it = 0; it < 16; ++it) rr[it] = *(const u32x4*)(UB + (size_t)cb * 2097152 + (size_t)idp[it] * 128 + c * 16);
      const int tokn = tok + stride;
      int idn[16]; u32x4 xan = xa, xbn = xb; f32x2 hpn = f32x2{0.f, 0.f};
#pragma unroll
      for (int q = 0; q < 16; ++q) idn[q] = 0;
      if (tokn < T) {
#pragma unroll
        for (int q = 0; q < 4; ++q) { const int4 iv = *(const int4*)(IDXP + (size_t)tokn * 128 + r * 16 + q * 4); idn[q * 4] = iv.x; idn[q * 4 + 1] = iv.y; idn[q * 4 + 2] = iv.z; idn[q * 4 + 3] = iv.w; }
        xan = *(const u32x4*)(Xb + (size_t)tokn * 1024 + cb * 128 + c * 16); xbn = *(const u32x4*)(Xb + (size_t)tokn * 1024 + cb * 128 + c * 16 + 8);
        if (cb > 0) hpn = *(const f32x2*)(HP + (size_t)tokn * 128 + r * 16 + itbase);
      }
      f32x2 x2[8];
#pragma unroll
      for (int q = 0; q < 4; ++q) { x2[q] = f32x2{lo2f(xa[q]), hi2f(xa[q])}; x2[4 + q] = f32x2{lo2f(xb[q]), hi2f(xb[q])}; }
      float v[16];
#pragma unroll
      for (int it = 0; it < 16; ++it) {
        f32x2 d[8]; dec16(rr[it], d);
        f32x2 a2 = d[0] * x2[0];
#pragma unroll
        for (int k = 1; k < 8; ++k) a2 += d[k] * x2[k];
        v[it] = a2.x + a2.y;
      }
      float w8[8];
#pragma unroll
      for (int k = 0; k < 8; ++k) { const float send = b0 ? v[k] : v[8 + k]; const float keep = b0 ? v[8 + k] : v[k]; w8[k] = keep + dpp_f(send, 0); }
      float w4[4];
#pragma unroll
      for (int k = 0; k < 4; ++k) { const float send = b1 ? w8[k] : w8[4 + k]; const float keep = b1 ? w8[4 + k] : w8[k]; w4[k] = keep + dpp_f(send, 1); }
      float w2[2];
#pragma unroll
      for (int k = 0; k < 2; ++k) { const float send = b2 ? w4[k] : w4[2 + k]; const float keep = b2 ? w4[2 + k] : w4[k]; w2[k] = keep + __shfl_xor(send, 4); }
      const float h0 = hp.x + w2[0], h1 = hp.y + w2[1];
      if (cb < 7) {
        *(f32x2*)(HP + (size_t)tok * 128 + r * 16 + itbase) = f32x2{h0, h1};
      } else {
        const int hc = itbase >> 1;
        const float ga = GATE[(size_t)tok * 128 + hc * 16 + r], gb = GATE[(size_t)tok * 128 + hc * 16 + 8 + r];
        float den = ga + gb;
        den += __builtin_bit_cast(float, __builtin_amdgcn_update_dpp(0, __builtin_bit_cast(int, den), 0x128, 0xF, 0xF, true));
        den += __shfl_xor(den, 16); den += __shfl_xor(den, 32);
        const float sc = 1.f / (den * V8_SCALE);
        *(f32x2*)(ACTP + (size_t)tok * 128 + r * 16 + itbase) = f32x2{gelu_tanh(h0 * (1.f / U8_SCALE)) * ga * sc, gelu_tanh(h1 * (1.f / U8_SCALE)) * gb * sc};
      }
#pragma unroll
      for (int q = 0; q < 16; ++q) idp[q] = idn[q];
      xa = xan; xb = xbn; hp = hpn; tok = tokn;
    }
  }
}

DI void phase_peer3v(const Params& p, int layer) {
  const int lane = otid() & 63, wid = otid() >> 6;
  const unsigned char* VB = (const unsigned char*)(p.ws + WS_VB);
  const float* ACTP = (const float*)(p.ws + WS_ACTP); const int* IDXP = (const int*)(p.ws + WS_IDXP);
  float* Y = (float*)(p.ws + WS_R);
  const int r = lane >> 3, c = lane & 7;
  const int stride = gridDim.x * 4;
#pragma unroll 1
  for (int cb = 0; cb < 8; ++cb) {
    int tok = obid() * 4 + wid;
    int idp[16]; float ap[16];
#pragma unroll
    for (int q = 0; q < 16; ++q) { idp[q] = 0; ap[q] = 0.f; }
    if (tok < T) {
#pragma unroll
      for (int q = 0; q < 4; ++q) {
        const int4 iv = *(const int4*)(IDXP + (size_t)tok * 128 + r * 16 + q * 4);
        const float4 av = *(const float4*)(ACTP + (size_t)tok * 128 + r * 16 + q * 4);
        idp[q * 4] = iv.x; idp[q * 4 + 1] = iv.y; idp[q * 4 + 2] = iv.z; idp[q * 4 + 3] = iv.w;
        ap[q * 4] = av.x; ap[q * 4 + 1] = av.y; ap[q * 4 + 2] = av.z; ap[q * 4 + 3] = av.w;
      }
    }
#pragma unroll 1
    while (tok < T) {
      u32x4 rr[16];
#pragma unroll
      for (int it = 0; it < 16; ++it) rr[it] = *(const u32x4*)(VB + (size_t)cb * 2097152 + (size_t)idp[it] * 128 + c * 16);
      const int tokn = tok + stride;
      int idn[16]; float an[16];
#pragma unroll
      for (int q = 0; q < 16; ++q) { idn[q] = 0; an[q] = 0.f; }
      if (tokn < T) {
#pragma unroll
        for (int q = 0; q < 4; ++q) {
          const int4 iv = *(const int4*)(IDXP + (size_t)tokn * 128 + r * 16 + q * 4);
          const float4 av = *(const float4*)(ACTP + (size_t)tokn * 128 + r * 16 + q * 4);
          idn[q * 4] = iv.x; idn[q * 4 + 1] = iv.y; idn[q * 4 + 2] = iv.z; idn[q * 4 + 3] = iv.w;
          an[q * 4] = av.x; an[q * 4 + 1] = av.y; an[q * 4 + 2] = av.z; an[q * 4 + 3] = av.w;
        }
      }
      f32x2 acc[8];
#pragma unroll
      for (int k = 0; k < 8; ++k) acc[k] = f32x2{0.f, 0.f};
#pragma unroll
      for (int it = 0; it < 16; ++it) {
        f32x2 d[8]; dec16(rr[it], d);
        const f32x2 a2 = f32x2{ap[it], ap[it]};
#pragma unroll
        for (int k = 0; k < 8; ++k) acc[k] += d[k] * a2;
      }
      float v[16];
#pragma unroll
      for (int k = 0; k < 8; ++k) { v[2 * k] = acc[k].x; v[2 * k + 1] = acc[k].y; }
#pragma unroll
      for (int k = 0; k < 16; ++k) v[k] += __builtin_bit_cast(float, __builtin_amdgcn_update_dpp(0, __builtin_bit_cast(int, v[k]), 0x128, 0xF, 0xF, true));
      const bool b4 = lane & 16, b5 = lane & 32;
      float w8[8];
#pragma unroll
      for (int k = 0; k < 8; ++k) { const float send = b4 ? v[k] : v[8 + k]; const float keep = b4 ? v[8 + k] : v[k]; w8[k] = keep + __shfl_xor(send, 16); }
      float z[4];
#pragma unroll
      for (int k = 0; k < 4; ++k) { const float send = b5 ? w8[k] : w8[4 + k]; const float keep = b5 ? w8[4 + k] : w8[k]; z[k] = keep + __shfl_xor(send, 32); }
      if ((lane & 8) == 0) *(float4*)(Y + (size_t)tok * 1024 + cb * 128 + c * 16 + (b4 ? 8 : 0) + (b5 ? 4 : 0)) = float4{z[0], z[1], z[2], z[3]};
#pragma unroll
      for (int q = 0; q < 16; ++q) { idp[q] = idn[q]; ap[q] = an[q]; }
      tok = tokn;
    }
  }
}

DI void phase_peer3n(const Params& p, int layer) {
  const int lane = otid() & 63, wid = otid() >> 6;
  const float* Y = (const float*)(p.ws + WS_R);
  float* X = (float*)(p.ws + WS_X); u16* Xb = (u16*)(p.ws + WS_XB);
  const float* gam = p.in[30] + (size_t)layer * 1024; const float* bet = p.in[31] + (size_t)layer * 1024;
  const bool last = layer == 3;
  for (int tok = obid() * 4 + wid; tok < T; tok += gridDim.x * 4) {
    float4 v[4];
    float s = 0.f;
#pragma unroll
    for (int cc = 0; cc < 4; ++cc) {
      const size_t o = (size_t)tok * 1024 + cc * 256 + lane * 4;
      const float4 y = *(const float4*)(Y + o), x = *(const float4*)(X + o);
      v[cc] = float4{ALPHA * x.x + y.x, ALPHA * x.y + y.y, ALPHA * x.z + y.z, ALPHA * x.w + y.w};
      s += v[cc].x + v[cc].y + v[cc].z + v[cc].w;
    }
#pragma unroll
    for (int o = 32; o > 0; o >>= 1) s += __shfl_xor(s, o);
    const float mu = s * (1.f / 1024.f);
    float q = 0.f;
#pragma unroll
    for (int cc = 0; cc < 4; ++cc) { float a = v[cc].x - mu, b = v[cc].y - mu, c2 = v[cc].z - mu, d = v[cc].w - mu; q += a * a + b * b + c2 * c2 + d * d; }
#pragma unroll
    for (int o = 32; o > 0; o >>= 1) q += __shfl_xor(q, o);
    const float rstd = rsqrtf(q * (1.f / 1024.f) + 1e-5f);
#pragma unroll
    for (int cc = 0; cc < 4; ++cc) {
      const int col = cc * 256 + lane * 4;
      float4 g = *(const float4*)(gam + col), bb = *(const float4*)(bet + col);
      float4 o = float4{(v[cc].x - mu) * rstd * g.x + bb.x, (v[cc].y - mu) * rstd * g.y + bb.y, (v[cc].z - mu) * rstd * g.z + bb.z, (v[cc].w - mu) * rstd * g.w + bb.w};
      if (last) *(float4*)(p.out + O_Y + (size_t)tok * 1024 + col) = o;
      else { *(float4*)(X + (size_t)tok * 1024 + col) = o; st_bf4(Xb + (size_t)tok * 1024 + col, o.x, o.y, o.z, o.w); }
    }
  }
}

DI void phase_o_inproj(const Params& p, int i, char* smem) {
  const u16* Xb = (const u16*)(p.ws + WS_XB);
  const u16* W = (const u16*)(p.ws + WS_WINO) + (size_t)i * 5248 * 1024;
  u16* Z = (u16*)(p.ws + WS_Z); u16* XBCR = (u16*)(p.ws + WS_XBCR); float* DTR = (float*)(p.ws + WS_DTR);
  float* out = p.out;
  for (int t = obid(); t < 129 * 41; t += gridDim.x) {
    const int mt = t / 41, nt = t % 41;
    gemm_tile(Xb, 1024, W, 1024, 1024, mt * 128, nt * 128, (u16*)smem, [&](int tok, int n, f32x4 v, int, int) {
      if (n < 2048) st_bf4(Z + (size_t)tok * 2048 + n, v[0], v[1], v[2], v[3]);
      else if (n < 5120) {
        const int c = n - 2048;
        st_bf4(XBCR + (size_t)tok * 3072 + c, v[0], v[1], v[2], v[3]);
        if (tok >= TP) *(float4*)(out + O_SCONV + (((size_t)i * 128 + (tok - TP)) * 3 + 2) * 3072 + c) = float4{v[0], v[1], v[2], v[3]};
        else {
          const int b = tok >> 11, l = tok & 2047;
          if (l >= 2045) *(float4*)(out + O_PCONV + (((size_t)i * 8 + b) * 3 + (l - 2045)) * 3072 + c) = float4{v[0], v[1], v[2], v[3]};
        }
      } else if (n < 5152) *(float4*)(DTR + (size_t)tok * 32 + (n - 5120)) = float4{v[0], v[1], v[2], v[3]};
    });
  }
}

DI void phase_o_conv(const Params& p, int i, char* smem) {
  const int tid = otid();
  const size_t gtid = (size_t)obid() * 256 + tid, gsz = (size_t)gridDim.x * 256;
  const u16* XBCR = (const u16*)(p.ws + WS_XBCR);
  u16* XS = (u16*)(p.ws + WS_XS); u16* BM = (u16*)(p.ws + WS_BM); u16* CM = (u16*)(p.ws + WS_CM);
  u16* XST = (u16*)(p.ws + WS_XST); u16* BMT = (u16*)(p.ws + WS_BMT);
  const float* cw = p.in[21] + (size_t)i * 4 * 3072; const float* cb = p.in[22] + (size_t)i * 3072;
  for (int unit = obid(); unit < 64 * 24; unit += gridDim.x) {
    const int cbk = unit % 24, tbk = unit / 24;
    const int cg = tid & 15, tr = tid >> 4;
    const int ch = cbk * 128 + cg * 8, t0 = tbk * 256 + tr * 16, l0 = t0 & 2047, b = t0 >> 11;
    float w[4][8], bs[8];
#pragma unroll
    for (int k = 0; k < 4; ++k) {
      const float4 wa = *(const float4*)(cw + (size_t)k * 3072 + ch), wb = *(const float4*)(cw + (size_t)k * 3072 + ch + 4);
      w[k][0] = wa.x; w[k][1] = wa.y; w[k][2] = wa.z; w[k][3] = wa.w; w[k][4] = wb.x; w[k][5] = wb.y; w[k][6] = wb.z; w[k][7] = wb.w;
    }
    {
      const float4 ba = *(const float4*)(cb + ch), bb = *(const float4*)(cb + ch + 4);
      bs[0] = ba.x; bs[1] = ba.y; bs[2] = ba.z; bs[3] = ba.w; bs[4] = bb.x; bs[5] = bb.y; bs[6] = bb.z; bs[7] = bb.w;
    }
    float x0[8], x1[8], x2[8];
    {
      u32x4 r0 = u32x4{0, 0, 0, 0}, r1 = r0, r2 = r0;
      if (l0 >= 3) {
        r0 = *(const u32x4*)(XBCR + (size_t)(t0 - 3) * 3072 + ch);
        r1 = *(const u32x4*)(XBCR + (size_t)(t0 - 2) * 3072 + ch);
        r2 = *(const u32x4*)(XBCR + (size_t)(t0 - 1) * 3072 + ch);
      }
#pragma unroll
      for (int q = 0; q < 4; ++q) { x0[2 * q] = lo2f(r0[q]); x0[2 * q + 1] = hi2f(r0[q]); x1[2 * q] = lo2f(r1[q]); x1[2 * q + 1] = hi2f(r1[q]); x2[2 * q] = lo2f(r2[q]); x2[2 * q + 1] = hi2f(r2[q]); }
    }
#pragma unroll
    for (int half = 0; half < 2; ++half) {
      u32x4 rows[8];
#pragma unroll
      for (int k = 0; k < 8; ++k) rows[k] = *(const u32x4*)(XBCR + (size_t)(t0 + half * 8 + k) * 3072 + ch);
      unsigned outp[8][4];
#pragma unroll
      for (int k = 0; k < 8; ++k) {
        float cur[8], y[8];
#pragma unroll
        for (int q = 0; q < 4; ++q) { cur[2 * q] = lo2f(rows[k][q]); cur[2 * q + 1] = hi2f(rows[k][q]); }
#pragma unroll
        for (int c = 0; c < 8; ++c) {
          y[c] = siluf_(bs[c] + w[0][c] * x0[c] + w[1][c] * x1[c] + w[2][c] * x2[c] + w[3][c] * cur[c]);
          x0[c] = x1[c]; x1[c] = x2[c]; x2[c] = cur[c];
        }
        u32x4 o; o[0] = pack2(y[0], y[1]); o[1] = pack2(y[2], y[3]); o[2] = pack2(y[4], y[5]); o[3] = pack2(y[6], y[7]);
        const size_t tok = (size_t)t0 + half * 8 + k;
        if (ch < 2048) *(u32x4*)(XS + tok * 2048 + ch) = o;
        else if (ch < 2560) *(u32x4*)(BM + tok * 512 + (ch - 2048)) = o;
        else *(u32x4*)(CM + tok * 512 + (ch - 2560)) = o;
#pragma unroll
        for (int c = 0; c < 8; ++c) {
          const unsigned hv = (c & 1) ? (o[c >> 1] >> 16) : (o[c >> 1] & 0xffffu);
          if (k & 1) outp[c][k >> 1] |= hv << 16; else outp[c][k >> 1] = hv;
        }
      }
      if (ch < 2560) {
        const int l = l0 + half * 8, chunk = l >> 7, so = l & 127;
#pragma unroll
        for (int c = 0; c < 8; ++c) {
          const u32x4 o = u32x4{outp[c][0], outp[c][1], outp[c][2], outp[c][3]};
          if (ch < 2048) *(u32x4*)(XST + (((size_t)b * 16 + chunk) * 2048 + ch + c) * 128 + so) = o;
          else *(u32x4*)(BMT + (((size_t)b * 16 + chunk) * 512 + (ch - 2048) + c) * 128 + so) = o;
        }
      }
    }
  }
  for (size_t e = gtid; e < (size_t)128 * 3072; e += gsz) {
    const int s = (int)(e / 3072), ch = (int)(e % 3072);
    const float* st = p.in[7] + ((size_t)i * 128 + s) * 3 * 3072 + ch;
    const size_t tok = (size_t)TP + s;
    float y = cb[ch] + cw[ch] * st[0] + cw[3072 + ch] * st[3072] + cw[2 * 3072 + ch] * st[2 * 3072] + cw[3 * 3072 + ch] * bf2f(XBCR[tok * 3072 + ch]);
    const u16 yb = f2bf(siluf_(y));
    if (ch < 2048) XS[tok * 2048 + ch] = yb;
    else if (ch < 2560) BM[tok * 512 + ch - 2048] = yb;
    else CM[tok * 512 + ch - 2560] = yb;
  }
  {
    const float* DTR = (const float*)(p.ws + WS_DTR); float* DT = (float*)(p.ws + WS_DT);
    const float* bias = p.in[23] + (size_t)i * 32;
    for (size_t e = gtid; e < (size_t)T * 32; e += gsz) {
      float x = DTR[e] + bias[e & 31];
      DT[e] = x > 20.f ? x : log1pf(expf(x));
    }
  }
}

DI void chunk_scan(const float* DT, size_t tok0, int h, float a, float* acs, float* dts, float* tot) {
  const int tid = otid(), lane = tid & 63;
  float d = 0.f, v = 0.f;
  __syncthreads();
  if (tid < 128) {
    d = DT[(tok0 + tid) * 32 + h];
    v = d * a;
#pragma unroll
    for (int o = 1; o < 64; o <<= 1) { float n = __shfl_up(v, o); if (lane >= o) v += n; }
    if (tid == 63) tot[0] = v;
  }
  __syncthreads();
  if (tid < 128) {
    if (tid >= 64) v += tot[0];
    acs[tid] = v; dts[tid] = d;
  }
  __syncthreads();
}

DI void phase_o_states(const Params& p, int i, char* smem) {
  const int tid = otid(), lane = tid & 63, w = tid >> 6, fr = lane & 15, fq = lane >> 4;
  float* acs = (float*)smem; float* dts = acs + 128; float* wgt = dts + 128; float* tot = wgt + 128;
  const float* DT = (const float*)(p.ws + WS_DT);
  const u16* XST = (const u16*)(p.ws + WS_XST); const u16* BMT = (const u16*)(p.ws + WS_BMT);
  float* ST = (float*)(p.ws + WS_ST); float* DEC = (float*)(p.ws + WS_DEC);
  for (int it = obid(); it < 4096; it += gridDim.x) {
    const int h = it & 31, chunk = (it >> 5) & 15, b = it >> 9, g = h >> 3;
    const float a = -expf(p.in[24][i * 32 + h]);
    const size_t tok0 = (size_t)b * 2048 + chunk * 128;
    chunk_scan(DT, tok0, h, a, acs, dts, tot);
    const float lastv = acs[127];
    if (tid < 128) wgt[tid] = __expf(lastv - acs[tid]) * dts[tid];
    if (tid == 0) DEC[((size_t)b * 16 + chunk) * 32 + h] = __expf(lastv);
    __syncthreads();
    const size_t bc = (size_t)b * 16 + chunk;
    f32x4 acc[4][2];
#pragma unroll
    for (int pt = 0; pt < 4; ++pt) { acc[pt][0] = f32x4{0.f, 0.f, 0.f, 0.f}; acc[pt][1] = f32x4{0.f, 0.f, 0.f, 0.f}; }
#pragma unroll
    for (int ks = 0; ks < 4; ++ks) {
      const int s0 = ks * 32 + fq * 8;
      const float4 wa = *(const float4*)(wgt + s0), wb = *(const float4*)(wgt + s0 + 4);
      bf16x8 bmf[2];
#pragma unroll
      for (int nt = 0; nt < 2; ++nt) bmf[nt] = *(const bf16x8*)(BMT + ((bc * 512 + g * 128 + 32 * w + nt * 16 + fr) * 128 + s0));
#pragma unroll
      for (int pt = 0; pt < 4; ++pt) {
        uint4 xr = *(const uint4*)(XST + ((bc * 2048 + h * 64 + pt * 16 + fr) * 128 + s0));
        uint4 xw;
        xw.x = pack2(lo2f(xr.x) * wa.x, hi2f(xr.x) * wa.y); xw.y = pack2(lo2f(xr.y) * wa.z, hi2f(xr.y) * wa.w);
        xw.z = pack2(lo2f(xr.z) * wb.x, hi2f(xr.z) * wb.y); xw.w = pack2(lo2f(xr.w) * wb.z, hi2f(xr.w) * wb.w);
        const bf16x8 xf = mk8(xw);
        acc[pt][0] = mfma16(bmf[0], xf, acc[pt][0]);
        acc[pt][1] = mfma16(bmf[1], xf, acc[pt][1]);
      }
    }
#pragma unroll
    for (int pt = 0; pt < 4; ++pt)
#pragma unroll
      for (int nt = 0; nt < 2; ++nt)
        *(float4*)(ST + (((bc * 32 + h) * 64 + pt * 16 + fr) * 128 + 32 * w + nt * 16 + fq * 4)) = float4{acc[pt][nt][0], acc[pt][nt][1], acc[pt][nt][2], acc[pt][nt][3]};
  }
}

DI void phase_o_scan(const Params& p, int i) {
  const size_t gtid = (size_t)obid() * 256 + otid(), gsz = (size_t)gridDim.x * 256;
  const float* ST = (const float*)(p.ws + WS_ST); const float* DEC = (const float*)(p.ws + WS_DEC);
  u16* SINB = (u16*)(p.ws + WS_SINB);
  for (size_t e = gtid; e < (size_t)524288; e += gsz) {
    const int n4 = (int)(e & 31), pp = (int)((e >> 5) & 63), h = (int)((e >> 11) & 31), b = (int)(e >> 16);
    float4 carry = float4{0.f, 0.f, 0.f, 0.f};
    for (int c = 0; c < 16; ++c) {
      const size_t ad = ((((size_t)b * 16 + c) * 32 + h) * 64 + pp) * 128 + n4 * 4;
      const float dec = DEC[((size_t)b * 16 + c) * 32 + h];
      const float4 tmp = *(const float4*)(ST + ad);
      st_bf4(SINB + ad, carry.x, carry.y, carry.z, carry.w);
      carry = float4{dec * carry.x + tmp.x, dec * carry.y + tmp.y, dec * carry.z + tmp.z, dec * carry.w + tmp.w};
    }
    *(float4*)(p.out + O_PSSD + ((((size_t)i * 8 + b) * 32 + h) * 64 + pp) * 128 + n4 * 4) = carry;
  }
}

constexpr int OY_XT = 8192;
constexpr int OY_XTS = 144;
constexpr int OY_S = OY_XT + 64 * OY_XTS * 2;
constexpr int OY_SS = 136;
constexpr int OY_CB = OY_S + 64 * OY_SS * 2;
DI void phase_o_y(const Params& p, int i, char* smem) {
  const int tid = otid(), lane = tid & 63, w = tid >> 6, fr = lane & 15, fq = lane >> 4;
  float* acs = (float*)smem;
  float* dts = acs + 1024;
  u16* XT = (u16*)(smem + OY_XT);
  u16* Ssm = (u16*)(smem + OY_S);
  float* tot = (float*)smem;
  uint2* CBs = (uint2*)(smem + OY_CB) + w * 512;
  const float* DT = (const float*)(p.ws + WS_DT);
  const u16* XST = (const u16*)(p.ws + WS_XST); const u16* XS = (const u16*)(p.ws + WS_XS);
  const u16* BM = (const u16*)(p.ws + WS_BM); const u16* CM = (const u16*)(p.ws + WS_CM); const u16* Z = (const u16*)(p.ws + WS_Z);
  const u16* SINB = (const u16*)(p.ws + WS_SINB);
  u16* YG = (u16*)(p.ws + WS_YG); float* SSQ = (float*)(p.ws + WS_SSQ);
  for (int it = obid(); it < 512; it += gridDim.x) {
    {
      const int g = it & 3, chunk = (it >> 2) & 15, b = it >> 6;
      const size_t tok0 = (size_t)b * 2048 + chunk * 128;
      const size_t bc = (size_t)b * 16 + chunk;
      __syncthreads();
      {
        const int hh = tid >> 5, j = tid & 31, h = g * 8 + hh;
        const float a = -expf(p.in[24][i * 32 + h]);
        float d[4], v[4];
#pragma unroll
        for (int k = 0; k < 4; ++k) { d[k] = DT[(tok0 + 4 * j + k) * 32 + h]; v[k] = d[k] * a; }
        v[1] += v[0]; v[2] += v[1]; v[3] += v[2];
        float run = v[3];
#pragma unroll
        for (int o = 1; o < 32; o <<= 1) { const float n = __shfl_up(run, o, 32); if (j >= o) run += n; }
        const float off = run - v[3];
#pragma unroll
        for (int k = 0; k < 4; ++k) { acs[hh * 128 + 4 * j + k] = v[k] + off; dts[hh * 128 + 4 * j + k] = d[k]; }
      }
      const int ttA = w, ttB = 7 - w;
      bf16x8 cmfA[4], cmfB[4];
#pragma unroll
      for (int ks = 0; ks < 4; ++ks) {
        cmfA[ks] = *(const bf16x8*)(CM + (tok0 + ttA * 16 + fr) * 512 + g * 128 + ks * 32 + fq * 8);
        cmfB[ks] = *(const bf16x8*)(CM + (tok0 + ttB * 16 + fr) * 512 + g * 128 + ks * 32 + fq * 8);
      }
      uint2 cbA[4];
#pragma unroll
      for (int st = 0; st < 8; ++st) {
        f32x4 ca = f32x4{0.f, 0.f, 0.f, 0.f}, cbv = f32x4{0.f, 0.f, 0.f, 0.f};
        if (st <= ttB) {
#pragma unroll
          for (int ks = 0; ks < 4; ++ks) {
            const bf16x8 bmf = *(const bf16x8*)(BM + (tok0 + st * 16 + fr) * 512 + g * 128 + ks * 32 + fq * 8);
            cbv = mfma16(bmf, cmfB[ks], cbv);
            if (st < 4 && st <= ttA) ca = mfma16(bmf, cmfA[ks], ca);
          }
        }
        CBs[st * 64 + lane] = uint2{pack2(cbv[0], cbv[1]), pack2(cbv[2], cbv[3])};
        if (st < 4) cbA[st] = uint2{pack2(ca[0], ca[1]), pack2(ca[2], ca[3])};
        if (st & 1) __builtin_amdgcn_sched_barrier(0);
      }
      u32x4 px[4], ps[4];
      {
        const u16* xsrc = XST + (bc * 2048 + (size_t)(g * 8) * 64) * 128;
        const u16* ssrc = SINB + ((bc * 32 + g * 8) * 64) * 128;
#pragma unroll
        for (int k = 0; k < 4; ++k) { px[k] = *(const u32x4*)(xsrc + (size_t)(tid + 256 * k) * 8); ps[k] = *(const u32x4*)(ssrc + (size_t)(tid + 256 * k) * 8); }
      }
#pragma unroll 1
      for (int hh = 0; hh < 8; ++hh) {
        const int h = g * 8 + hh;
        const float Dh = p.in[25][i * 32 + h];
        __syncthreads();
#pragma unroll
        for (int k = 0; k < 4; ++k) { const int e = (tid + 256 * k) * 8; *(u32x4*)(XT + (e >> 7) * OY_XTS + (e & 127)) = px[k]; *(u32x4*)(Ssm + (e >> 7) * OY_SS + (e & 127)) = ps[k]; }
        __syncthreads();
        if (hh < 7) {
          const u16* xsrc = XST + (bc * 2048 + (size_t)(h + 1) * 64) * 128;
          const u16* ssrc = SINB + ((bc * 32 + h + 1) * 64) * 128;
#pragma unroll
          for (int k = 0; k < 4; ++k) { px[k] = *(const u32x4*)(xsrc + (size_t)(tid + 256 * k) * 8); ps[k] = *(const u32x4*)(ssrc + (size_t)(tid + 256 * k) * 8); }
        }
        const float* ah = acs + hh * 128; const float* dh = dts + hh * 128;
#pragma unroll
        for (int q = 0; q < 2; ++q) {
          const int tt = q == 0 ? ttA : ttB;
          const int tl = tt * 16 + fr;
          f32x4 acc[4];
#pragma unroll
          for (int pt = 0; pt < 4; ++pt) acc[pt] = f32x4{0.f, 0.f, 0.f, 0.f};
#pragma unroll
          for (int ks = 0; ks < 4; ++ks)
#pragma unroll
            for (int pt = 0; pt < 4; ++pt) {
              const bf16x8 sf = *(const bf16x8*)(Ssm + (pt * 16 + fr) * OY_SS + ks * 32 + fq * 8);
              acc[pt] = mfma16(sf, q == 0 ? cmfA[ks] : cmfB[ks], acc[pt]);
              if (pt == 3) __builtin_amdgcn_sched_barrier(0);
            }
          const float at = ah[tl];
          const float ea = __expf(at);
#pragma unroll
          for (int pt = 0; pt < 4; ++pt) { acc[pt][0] *= ea; acc[pt][1] *= ea; acc[pt][2] *= ea; acc[pt][3] *= ea; }
#pragma unroll
          for (int sp = 0; sp < (q == 0 ? 2 : 4); ++sp) {
            if (2 * sp <= tt) {
              uint4 mk;
#pragma unroll
              for (int half = 0; half < 2; ++half) {
                const int st = 2 * sp + half;
                const uint2 cbp = q == 0 ? cbA[st < 4 ? st : 0] : CBs[st * 64 + lane];
                const float cb[4] = {lo2f(cbp.x), hi2f(cbp.x), lo2f(cbp.y), hi2f(cbp.y)};
                float mv[4];
#pragma unroll
                for (int j = 0; j < 4; ++j) {
                  const int sl = st * 16 + fq * 4 + j;
                  float m = 0.f;
                  if (sl <= tl) m = cb[j] * __expf(at - ah[sl]) * dh[sl];
                  mv[j] = m;
                }
                if (half == 0) { mk.x = pack2(mv[0], mv[1]); mk.y = pack2(mv[2], mv[3]); }
                else { mk.z = pack2(mv[0], mv[1]); mk.w = pack2(mv[2], mv[3]); }
                __builtin_amdgcn_sched_barrier(0);
              }
              const bf16x8 mf = mk8(mk);
#pragma unroll
              for (int pt = 0; pt < 4; ++pt) {
                const u16* xr = XT + (pt * 16 + fr) * OY_XTS;
                const uint2 xa = *(const uint2*)(xr + (2 * sp) * 16 + fq * 4), xb = *(const uint2*)(xr + (2 * sp + 1) * 16 + fq * 4);
                acc[pt] = mfma16(mk8(uint4{xa.x, xa.y, xb.x, xb.y}), mf, acc[pt]);
              }
              __builtin_amdgcn_sched_barrier(0);
            }
          }
          __builtin_amdgcn_sched_barrier(0);
          const size_t tok = tok0 + tl;
          float ss = 0.f;
#pragma unroll
          for (int pt = 0; pt < 4; ++pt) {
            const int col = h * 64 + pt * 16 + fq * 4;
            uint2 xv = *(const uint2*)(XS + tok * 2048 + col), zv = *(const uint2*)(Z + tok * 2048 + col);
            float y0 = (acc[pt][0] + Dh * lo2f(xv.x)) * siluf_(lo2f(zv.x));
            float y1 = (acc[pt][1] + Dh * hi2f(xv.x)) * siluf_(hi2f(zv.x));
            float y2 = (acc[pt][2] + Dh * lo2f(xv.y)) * siluf_(lo2f(zv.y));
            float y3 = (acc[pt][3] + Dh * hi2f(xv.y)) * siluf_(hi2f(zv.y));
            st_bf4(YG + tok * 2048 + col, y0, y1, y2, y3);
            ss += y0 * y0 + y1 * y1 + y2 * y2 + y3 * y3;
          }
          ss += __shfl_xor(ss, 16); ss += __shfl_xor(ss, 32);
          if (fq == 0) SSQ[tok * 32 + h] = ss;
          __builtin_amdgcn_sched_barrier(0);
        }
      }
    }
  }
  __syncthreads();
  for (int it = obid(); it < 4096; it += gridDim.x) {
    {
      const int r = it, h = r & 31, s = r >> 5, g = h >> 3;
      const float a = -expf(p.in[24][i * 32 + h]);
      const float Dh = p.in[25][i * 32 + h];
      const size_t tok = (size_t)TP + s;
      const int pp = tid >> 2, nq = tid & 3;
      const float dtv = DT[tok * 32 + h];
      const float dA = __expf(dtv * a);
      const float xv = bf2f(XS[tok * 2048 + h * 64 + pp]);
      const size_t ad = ((((size_t)i * 128 + s) * 32 + h) * 64 + pp) * 128 + nq * 32;
      const float dx = dtv * xv;
      float yp = 0.f;
#pragma unroll
      for (int k = 0; k < 8; ++k) {
        float4 s0 = *(const float4*)(p.in[6] + ad + 4 * k);
        uint2 bv = *(const uint2*)(BM + tok * 512 + g * 128 + nq * 32 + 4 * k), cv = *(const uint2*)(CM + tok * 512 + g * 128 + nq * 32 + 4 * k);
        float4 nw = float4{dA * s0.x + dx * lo2f(bv.x), dA * s0.y + dx * hi2f(bv.x), dA * s0.z + dx * lo2f(bv.y), dA * s0.w + dx * hi2f(bv.y)};
        *(float4*)(p.out + O_SSSD + ad + 4 * k) = nw;
        yp += nw.x * lo2f(cv.x) + nw.y * hi2f(cv.x) + nw.z * lo2f(cv.y) + nw.w * hi2f(cv.y);
      }
      yp += __shfl_xor(yp, 1); yp += __shfl_xor(yp, 2);
      const float yg = (yp + Dh * xv) * siluf_(bf2f(Z[tok * 2048 + h * 64 + pp]));
      float ss = 0.f;
      if (nq == 0) { YG[tok * 2048 + h * 64 + pp] = f2bf(yg); ss = yg * yg; }
#pragma unroll
      for (int o = 32; o > 0; o >>= 1) ss += __shfl_xor(ss, o);
      __syncthreads();
      if (lane == 0) tot[w] = ss;
      __syncthreads();
      if (tid == 0) SSQ[tok * 32 + h] = (tot[0] + tot[1]) + (tot[2] + tot[3]);
    }
  }
}

constexpr int SMEM_BYTES = 61440;
#ifndef PROBE_ID
#define PROBE_ID 0
#endif
#define TIMED(id, ...) { long long t0_ = 0; if (PROBE_ID == (id)) t0_ = wall_clock64(); __VA_ARGS__; if (PROBE_ID == (id)) tacc += wall_clock64() - t0_; }
__global__ void __launch_bounds__(256, 2) mega_kernel(Params p) {
  __shared__ __attribute__((aligned(16))) char smem[SMEM_BYTES];
  __shared__ uint4 xb_words;
  if (threadIdx.x == 0) xb_words = make_uint4(0u, 0u, 0u, 0u);
  __syncthreads();
  XcdBarrier bar = xcd_barrier_post((unsigned*)(p.ws + WS_BAR), (volatile LAS unsigned*)&xb_words);
  long long tacc = 0;
  TIMED(1, phase_prep(p, smem); cg::this_grid().sync();)
  for (int layer = 0; layer < 4; ++layer) {
    const int i = layer >> 1;
    if ((layer & 1) == 0) {
      TIMED(2, convert_tables(p, layer); phase_e_inproj(p, i, smem); xcd_barrier(bar);)
      TIMED(3,
        s5_pass1(p, i, smem);
        __syncthreads();
        swa_prompt(p, i, smem);
        __syncthreads();
        swa_sample(p, i, smem);
        xcd_barrier(bar);
        s5_pass3(p, i, smem);
        xcd_barrier(bar);
        phase_e_glu(p, i, smem);
        xcd_barrier(bar);)
      TIMED(4, phase_outproj(p, (const u16*)(p.ws + WS_CAT), 1024, (const u16*)(p.ws + WS_WOUTE) + (size_t)i * 1024 * 1024, false, smem);
        xcd_barrier(bar);)
    } else {
      TIMED(2, convert_tables(p, layer); phase_o_inproj(p, i, smem); xcd_barrier(bar);)
      TIMED(51, phase_o_conv(p, i, smem); xcd_barrier(bar);)
      TIMED(52, phase_o_states(p, i, smem); xcd_barrier(bar);)
      TIMED(53, phase_o_scan(p, i); xcd_barrier(bar);)
      TIMED(54, phase_o_y(p, i, smem); xcd_barrier(bar);)
      TIMED(4, phase_outproj(p, (const u16*)(p.ws + WS_YG), 2048, (const u16*)(p.ws + WS_WOUTO) + (size_t)i * 1024 * 2048, true, smem);
        xcd_barrier(bar);)
    }
    TIMED(4, phase_ln1(p, layer); xcd_barrier(bar);)
    TIMED(6, phase_peer1(p, layer, smem); xcd_barrier(bar);)
    TIMED(71, phase_peer3u(p, layer); xcd_barrier(bar);)
    TIMED(72, phase_peer3v(p, layer); xcd_barrier(bar);)
    TIMED(73, phase_peer3n(p, layer); xcd_barrier(bar);)
  }
  if (PROBE_ID != 0 && blockIdx.x == 0 && threadIdx.x == 0) {
    const long long t0 = wall_clock64();
    while (wall_clock64() - t0 < tacc) __builtin_amdgcn_s_sleep(8);
  }
}

extern "C" void kernel_launch(void* const* d_in, const int* in_sizes, int n_in, void* d_out, int out_size, void* d_ws,
                              size_t ws_size, hipStream_t stream) {
  static int grid_blocks = 0;
  if (!grid_blocks) {
    int dev = 0, cus = 0, per_cu = 0;
    hipGetDevice(&dev);
    hipDeviceGetAttribute(&cus, hipDeviceAttributeMultiprocessorCount, dev);
    hipOccupancyMaxActiveBlocksPerMultiprocessor(&per_cu, mega_kernel, 256, 0);
    if (per_cu > 2) per_cu = 2;
    if (per_cu < 1) per_cu = 1;
    grid_blocks = cus * per_cu;
  }
  if (ws_size < WS_END) { fprintf(stderr, "workspace too small: %zu < %zu\n", ws_size, (size_t)WS_END); return; }
  Params p{};
  for (int k = 0; k < 37; ++k) p.in[k] = (const float*)d_in[k];
  p.out = (float*)d_out;
  p.ws = (char*)d_ws;
  hipMemsetAsync((char*)d_ws + WS_BAR, 0, 16384, stream);
  void* args[] = {&p};
  hipError_t e = hipLaunchCooperativeKernel((void*)mega_kernel, dim3(grid_blocks), dim3(256), args, 0, stream);
  if (e != hipSuccess) fprintf(stderr, "cooperative launch failed: %s (grid %d)\n", hipGetErrorString(e), grid_blocks);
}
```

```cpp
#include <hip/hip_runtime.h>
#include <hip/hip_cooperative_groups.h>
#include <cstdio>
#include <cstdint>
namespace cg = cooperative_groups;

typedef unsigned short u16;
typedef __attribute__((ext_vector_type(8))) short bf16x8;
typedef __attribute__((ext_vector_type(4))) short bf16x4;
typedef __attribute__((ext_vector_type(4))) float f32x4;
typedef __attribute__((ext_vector_type(2))) __bf16 bf2;
typedef __attribute__((ext_vector_type(4))) unsigned u32x4;

#define DI __device__ __forceinline__

constexpr int T = 16512, TP = 16384, NSMP = 128;
constexpr float ALPHA = 1.681792830507429f;

constexpr size_t O_Y = 0;
constexpr size_t O_PS5RE = (size_t)T * 1024;
constexpr size_t O_PS5IM = O_PS5RE + 32768;
constexpr size_t O_PSWAK = O_PS5IM + 32768;
constexpr size_t O_PSWAV = O_PSWAK + 262144;
constexpr size_t O_PSSD = O_PSWAV + 262144;
constexpr size_t O_PCONV = O_PSSD + 4194304;
constexpr size_t O_SS5RE = O_PCONV + 147456;
constexpr size_t O_SS5IM = O_SS5RE + 524288;
constexpr size_t O_SSWAK = O_SS5IM + 524288;
constexpr size_t O_SSWAV = O_SSWAK + 4194304;
constexpr size_t O_SSSD = O_SSWAV + 4194304;
constexpr size_t O_SCONV = O_SSSD + 67108864;

constexpr size_t WS_BAR = 0;
constexpr size_t WS_X = 16384;
constexpr size_t WS_XB = WS_X + (size_t)T * 1024 * 4;
constexpr size_t WS_SSQ = WS_XB + (size_t)T * 1024 * 2;
constexpr size_t WS_IDX = WS_SSQ + (size_t)T * 32 * 4;
constexpr size_t WS_GATE = WS_IDX + (size_t)T * 128 * 4;
constexpr size_t WS_DT = WS_GATE + (size_t)T * 128 * 4;
constexpr size_t WS_DTR = WS_DT + (size_t)T * 32 * 4;
constexpr size_t WS_DEC = WS_DTR + (size_t)T * 32 * 4;
constexpr size_t WS_AB = WS_DEC + 16384;
constexpr size_t WS_BBR = WS_AB + 32768;
constexpr size_t WS_BBI = WS_BBR + 262144;
constexpr size_t WS_CT = WS_BBI + 262144;
constexpr size_t WS_E = WS_CT + 262144;
constexpr size_t WS_WINE = WS_E + 4194304;
constexpr size_t WS_WGLU = WS_WINE + (size_t)2 * 1280 * 1024 * 2;
constexpr size_t WS_WOUTE = WS_WGLU + (size_t)2 * 512 * 512 * 2;
constexpr size_t WS_WINO = WS_WOUTE + (size_t)2 * 1024 * 1024 * 2;
constexpr size_t WS_WOUTO = WS_WINO + (size_t)2 * 5248 * 1024 * 2;
constexpr size_t WS_WQ = WS_WOUTO + (size_t)2 * 1024 * 2048 * 2;
constexpr size_t WS_K1 = WS_WQ + (size_t)4 * 2048 * 1024 * 2;
constexpr size_t WS_K2 = WS_K1 + (size_t)4 * 8 * 128 * 128 * 2;
constexpr size_t WS_UB = WS_K2 + (size_t)4 * 8 * 128 * 128 * 2;
constexpr size_t WS_VB = WS_UB + (size_t)16384 * 1024 * 2;
constexpr size_t WS_ACT = WS_VB + (size_t)16384 * 1024 * 2;
constexpr size_t WS_Z = WS_ACT;
constexpr size_t WS_XBCR = WS_Z + (size_t)T * 2048 * 2;
constexpr size_t WS_R = WS_XBCR;
constexpr size_t WS_XS = WS_XBCR + (size_t)T * 3072 * 2;
constexpr size_t WS_BM = WS_XS + (size_t)T * 2048 * 2;
constexpr size_t WS_CM = WS_BM + (size_t)T * 512 * 2;
constexpr size_t WS_XST = WS_CM + (size_t)T * 512 * 2;
constexpr size_t WS_BMT = WS_XST + (size_t)TP * 2048 * 2;
constexpr size_t WS_ST = WS_BMT + (size_t)TP * 512 * 2;
constexpr size_t WS_YG = WS_ST + (size_t)8 * 16 * 32 * 64 * 128 * 4;
constexpr size_t WS_ACTP = WS_YG + (size_t)T * 2048 * 2;
constexpr size_t WS_IDXP = WS_ACTP + (size_t)T * 128 * 4;
constexpr size_t WS_SINB = WS_IDXP + (size_t)T * 128 * 4;
constexpr size_t WS_END = WS_SINB + (size_t)8 * 16 * 32 * 64 * 128 * 2;
constexpr size_t WS_PE = WS_Z;
constexpr size_t WS_G = WS_XS;
constexpr size_t WS_CAT = WS_YG;

struct Params {
  const float* in[37];
  float* out;
  char* ws;
};

DI u16 f2bf(float f) { unsigned u = __float_as_uint(f); u += 0x7fffu + ((u >> 16) & 1u); return (u16)(u >> 16); }
DI float bf2f(u16 h) { return __uint_as_float(((unsigned)h) << 16); }
DI unsigned pack2(float a, float b) { return (unsigned)f2bf(a) | ((unsigned)f2bf(b) << 16); }
DI float lo2f(unsigned u) { return __uint_as_float(u << 16); }
DI float hi2f(unsigned u) { return __uint_as_float(u & 0xffff0000u); }
DI float gelu_tanh(float x) {
  float u = 0.7978845608028654f * (x + 0.044715f * x * x * x);
  float e = __expf(2.f * u);
  float th = 1.f - 2.f / (e + 1.f);
  return 0.5f * x * (1.f + th);
}
DI float sigmoidf_(float x) { return 1.f / (1.f + __expf(-x)); }
DI float siluf_(float x) { return x / (1.f + __expf(-x)); }
DI f32x4 mfma16(bf16x8 a, bf16x8 b, f32x4 c) { return __builtin_amdgcn_mfma_f32_16x16x32_bf16(a, b, c, 0, 0, 0); }
DI void wave_lds_sync() { __builtin_amdgcn_fence(__ATOMIC_ACQ_REL, "workgroup"); __builtin_amdgcn_wave_barrier(); }
DI void st_bf4(u16* dst, float a, float b, float c, float d) { uint2 v; v.x = pack2(a, b); v.y = pack2(c, d); *(uint2*)dst = v; }
DI bf16x8 mk8(uint4 v) { return __builtin_bit_cast(bf16x8, v); }

#define XB_TMO      128
#define XB_XCNT(j)  (256  + 64 * (j))
#define XB_XSUB(j)  (1280 + 64 * (j))
#define XB_XGEN(j)  (2304 + 64 * (j))
#define XB_TOP      3328
#define XB_TOPGEN   3392
#define XCD_BAR_WORDS 3456
#define XB_SPIN_CAP (1u << 22)
#define LAS __attribute__((address_space(3)))
DI unsigned xb_ld(unsigned* p) { return __hip_atomic_load(p, __ATOMIC_RELAXED, __HIP_MEMORY_SCOPE_AGENT); }
DI unsigned xb_add(unsigned* p, unsigned v) { return __hip_atomic_fetch_add(p, v, __ATOMIC_RELAXED, __HIP_MEMORY_SCOPE_AGENT); }
DI unsigned xb_xcc_id() { return (unsigned)__builtin_amdgcn_s_getreg((3 << 11) | 20) & 0xFu; }
#define XB_SPIN(cond, bar) do { unsigned _sp = 0; while (cond) { __builtin_amdgcn_s_sleep(1); \
    if ((++_sp & 255u) == 0u) { if (xb_ld(&(bar)[XB_TMO])) break; if (_sp > XB_SPIN_CAP) { atomicAdd(&(bar)[XB_TMO], 1u); break; } } } } while (0)
struct XcdBarrier { unsigned* bar; unsigned x; volatile LAS unsigned* st; };
DI XcdBarrier xcd_barrier_post(unsigned* bar, volatile LAS unsigned* st) {
  XcdBarrier b; b.bar = bar; b.x = xb_xcc_id(); b.st = st;
  if (threadIdx.x == 0) (void)xb_add(&bar[XB_XCNT(b.x)], 1u);
  return b;
}
DI void xcd_barrier_complete(unsigned* bar, unsigned x, unsigned& nloc, unsigned& nx) {
  const unsigned G = gridDim.x;
  unsigned sum, cnt, mine, sp = 0u;
  for (;;) {
    sum = 0u; cnt = 0u; mine = 0u;
#pragma unroll
    for (unsigned j = 0; j < 16; ++j) { const unsigned c = xb_ld(&bar[XB_XCNT(j)]); sum += c; cnt += (c > 0u) ? 1u : 0u; mine = (j == x) ? c : mine; }
    if (sum == G) break;
    __builtin_amdgcn_s_sleep(1);
    if ((++sp & 255u) == 0u) { if (xb_ld(&bar[XB_TMO])) break; if (sp > XB_SPIN_CAP) { atomicAdd(&bar[XB_TMO], 1u); break; } }
  }
  nloc = mine > 0u ? mine : 1u; nx = cnt > 0u ? cnt : 1u;
}
DI void xcd_barrier(const XcdBarrier& b) {
  asm volatile("s_waitcnt vmcnt(0)" ::: "memory");
  __syncthreads();
  if (threadIdx.x == 0) {
    unsigned* bar = b.bar;
    __builtin_amdgcn_s_waitcnt(0);
    unsigned nloc = b.st[0], nx = b.st[1];
    if (nloc == 0u) { xcd_barrier_complete(bar, b.x, nloc, nx); b.st[0] = nloc; b.st[1] = nx; }
    const unsigned old = xb_add(&bar[XB_XSUB(b.x)], 1u);
    const unsigned gen = old / nloc;
    if (old + 1u == (gen + 1u) * nloc) {
      __builtin_amdgcn_fence(__ATOMIC_RELEASE, "agent");
      asm volatile("s_waitcnt vmcnt(0)" ::: "memory");
      const unsigned og = xb_add(&bar[XB_TOP], 1u);
      const unsigned tg = og / nx;
      if (og + 1u == (tg + 1u) * nx) xb_add(&bar[XB_TOPGEN], 1u);
      else XB_SPIN(xb_ld(&bar[XB_TOPGEN]) == tg, bar);
      __builtin_amdgcn_fence(__ATOMIC_ACQUIRE, "agent");
      xb_add(&bar[XB_XGEN(b.x)], 1u);
      asm volatile("s_waitcnt vmcnt(0)" ::: "memory");
    } else {
      XB_SPIN(xb_ld(&bar[XB_XGEN(b.x)]) == gen, bar);
      __builtin_amdgcn_fence(__ATOMIC_ACQUIRE, "agent");
      asm volatile("s_waitcnt vmcnt(0)" ::: "memory");
    }
  }
  __syncthreads();
}

DI int otid() { int t = threadIdx.x; asm volatile("" : "+v"(t)); return t; }
DI int obid() { int t = blockIdx.x; asm volatile("" : "+s"(t)); return t; }

constexpr int LDSS = 72;
constexpr int GEMM_SMEM = 2 * 128 * LDSS * 2;
template <bool SYNC_EPI = false, class Epi>
DI void gemm_tile(const u16* __restrict__ A, int lda, const u16* __restrict__ Bt, int ldb, int K, int m0, int n0,
                  u16* sm, Epi&& epi) {
  u16* sA = sm; u16* sB = sm + 128 * LDSS;
  const int tid = otid(), lane = tid & 63, wid = tid >> 6, wr = wid >> 1, wc = wid & 1, fr = lane & 15, fq = lane >> 4;
  const int lr = tid >> 3, lc = (tid & 7) * 8;
  const u16* ga = A + (size_t)(m0 + lr) * lda + lc;
  const u16* gb = Bt + (size_t)(n0 + lr) * ldb + lc;
  u32x4 ra[4], rb[4];
#pragma unroll
  for (int i = 0; i < 4; ++i) { ra[i] = *(const u32x4*)(ga + (size_t)(32 * i) * lda); rb[i] = *(const u32x4*)(gb + (size_t)(32 * i) * ldb); }
  f32x4 acc[4][4];
#pragma unroll
  for (int m = 0; m < 4; ++m)
#pragma unroll
    for (int n = 0; n < 4; ++n) acc[m][n] = f32x4{0.f, 0.f, 0.f, 0.f};
  for (int k0 = 0; k0 < K; k0 += 64) {
    __syncthreads();
#pragma unroll
    for (int i = 0; i < 4; ++i) {
      *(u32x4*)(sA + (lr + 32 * i) * LDSS + lc) = ra[i];
      *(u32x4*)(sB + (lr + 32 * i) * LDSS + lc) = rb[i];
    }
    __syncthreads();
    if (k0 + 64 < K) {
#pragma unroll
      for (int i = 0; i < 4; ++i) {
        ra[i] = *(const u32x4*)(ga + (size_t)(32 * i) * lda + k0 + 64);
        rb[i] = *(const u32x4*)(gb + (size_t)(32 * i) * ldb + k0 + 64);
      }
    }
#pragma unroll
    for (int ks = 0; ks < 2; ++ks) {
      bf16x8 af[4], bfr[4];
#pragma unroll
      for (int m = 0; m < 4; ++m) af[m] = *(const bf16x8*)(sA + (wr * 64 + m * 16 + fr) * LDSS + ks * 32 + fq * 8);
#pragma unroll
      for (int n = 0; n < 4; ++n) bfr[n] = *(const bf16x8*)(sB + (wc * 64 + n * 16 + fr) * LDSS + ks * 32 + fq * 8);
#pragma unroll
      for (int m = 0; m < 4; ++m)
#pragma unroll
        for (int n = 0; n < 4; ++n) acc[m][n] = mfma16(bfr[n], af[m], acc[m][n]);
    }
  }
  if (SYNC_EPI) __syncthreads();
#pragma unroll
  for (int m = 0; m < 4; ++m)
#pragma unroll
    for (int n = 0; n < 4; ++n) epi(m0 + wr * 64 + m * 16 + fr, n0 + wc * 64 + n * 16 + fq * 4, acc[m][n], m, n);
}

struct WJob { const float* src; u16* dst; int K, N, Npad; const float* scale; };
DI WJob get_wjob(const Params& p, int j) {
  WJob w; w.scale = nullptr;
  if (j < 2) { w.src = p.in[8] + (size_t)j * 1024 * 1280; w.dst = (u16*)(p.ws + WS_WINE) + (size_t)j * 1280 * 1024; w.K = 1024; w.N = 1280; w.Npad = 1280; }
  else if (j < 4) { int i = j - 2; w.src = p.in[17] + (size_t)i * 512 * 512; w.dst = (u16*)(p.ws + WS_WGLU) + (size_t)i * 512 * 512; w.K = 512; w.N = 512; w.Npad = 512; }
  else if (j < 6) { int i = j - 4; w.src = p.in[19] + (size_t)i * 1024 * 1024; w.dst = (u16*)(p.ws + WS_WOUTE) + (size_t)i * 1024 * 1024; w.K = 1024; w.N = 1024; w.Npad = 1024; }
  else if (j < 8) { int i = j - 6; w.src = p.in[20] + (size_t)i * 1024 * 5152; w.dst = (u16*)(p.ws + WS_WINO) + (size_t)i * 5248 * 1024; w.K = 1024; w.N = 5152; w.Npad = 5248; }
  else if (j < 10) { int i = j - 8; w.src = p.in[27] + (size_t)i * 2048 * 1024; w.dst = (u16*)(p.ws + WS_WOUTO) + (size_t)i * 1024 * 2048; w.K = 2048; w.N = 1024; w.Npad = 1024; w.scale = p.in[26] + (size_t)i * 2048; }
  else { int i = j - 10; w.src = p.in[32] + (size_t)i * 1024 * 2048; w.dst = (u16*)(p.ws + WS_WQ) + (size_t)i * 2048 * 1024; w.K = 1024; w.N = 2048; w.Npad = 2048; }
  return w;
}

DI void phase_prep(const Params& p, char* smem) {
  const int tid = otid();
  const size_t gtid = (size_t)obid() * 256 + tid, gsz = (size_t)gridDim.x * 256;
  {
    float* X = (float*)(p.ws + WS_X); u16* Xb = (u16*)(p.ws + WS_XB);
    for (size_t i = gtid; i < (size_t)T * 256; i += gsz) {
      size_t e = i * 4;
      const float* src = e < (size_t)TP * 1024 ? p.in[0] + e : p.in[1] + (e - (size_t)TP * 1024);
      float4 v = *(const float4*)src;
      *(float4*)(X + e) = v;
      st_bf4(Xb + e, v.x, v.y, v.z, v.w);
    }
  }
  {
    float* tile = (float*)smem;
    for (int j = 0; j < 14; ++j) {
      WJob w = get_wjob(p, j);
      const int tk = w.K / 64, tn = w.Npad / 64;
      for (int t = obid(); t < tk * tn; t += gridDim.x) {
        const int k0 = (t % tk) * 64, n0 = (t / tk) * 64;
        const int c = tid & 63, r4 = tid >> 6;
        __syncthreads();
#pragma unroll
        for (int i = 0; i < 16; ++i) {
          int r = r4 + 4 * i;
          float v = 0.f;
          if (n0 + c < w.N) { v = w.src[(size_t)(k0 + r) * w.N + n0 + c]; if (w.scale) v *= w.scale[k0 + r]; }
          tile[r * 65 + c] = v;
        }
        __syncthreads();
#pragma unroll
        for (int i = 0; i < 16; ++i) {
          int nn = r4 + 4 * i;
          w.dst[(size_t)(n0 + nn) * w.K + k0 + c] = f2bf(tile[c * 65 + nn]);
        }
      }
    }
  }
  {
    u16* k1 = (u16*)(p.ws + WS_K1); u16* k2 = (u16*)(p.ws + WS_K2);
    for (size_t i = gtid; i < (size_t)131072; i += gsz) {
      float4 a = *(const float4*)(p.in[33] + i * 4), b = *(const float4*)(p.in[34] + i * 4);
      st_bf4(k1 + i * 4, a.x, a.y, a.z, a.w);
      st_bf4(k2 + i * 4, b.x, b.y, b.z, b.w);
    }
  }
  {
    float* AB = (float*)(p.ws + WS_AB); float* BBR = (float*)(p.ws + WS_BBR); float* BBI = (float*)(p.ws + WS_BBI);
    u16* CT = (u16*)(p.ws + WS_CT);
    for (size_t i = gtid; i < 4096; i += gsz) {
      int ig = (int)(i >> 6), pp = (int)(i & 63);
      float dt = expf(p.in[11][ig]);
      float lr = p.in[9][i], li = p.in[10][i];
      float mag = expf(lr * dt);
      float abr = mag * cosf(li * dt), abi = mag * sinf(li * dt);
      float den = lr * lr + li * li;
      float nr = abr - 1.f, ni = abi;
      float cr = (nr * lr + ni * li) / den, ci = (ni * lr - nr * li) / den;
      AB[i * 2] = abr; AB[i * 2 + 1] = abi;
      for (int c = 0; c < 16; ++c) {
        float br = p.in[12][i * 16 + c], bi = p.in[13][i * 16 + c];
        BBR[i * 16 + c] = cr * br - ci * bi;
        BBI[i * 16 + c] = cr * bi + ci * br;
        CT[((size_t)ig * 16 + c) * 128 + pp] = f2bf(p.in[14][((size_t)ig * 16 + c) * 64 + pp]);
        CT[((size_t)ig * 16 + c) * 128 + 64 + pp] = f2bf(-p.in[15][((size_t)ig * 16 + c) * 64 + pp]);
      }
    }
  }
  {
    for (size_t i = gtid; i < (size_t)2 * 128 * 127 * 32; i += gsz) {
      size_t q = i & 31, row = (i >> 5) % 127, is = (i >> 5) / 127;
      size_t so = (is * 128 + row + 1) * 128 + q * 4, dn = (is * 128 + row) * 128 + q * 4;
      *(float4*)(p.out + O_SSWAK + dn) = *(const float4*)(p.in[4] + so);
      *(float4*)(p.out + O_SSWAV + dn) = *(const float4*)(p.in[5] + so);
    }
    for (size_t i = gtid; i < (size_t)2 * 128 * 2 * 768; i += gsz) {
      size_t q = i % 768, row = (i / 768) & 1, is = i / 1536;
      *(float4*)(p.out + O_SCONV + (is * 3 + row) * 3072 + q * 4) = *(const float4*)(p.in[7] + (is * 3 + row + 1) * 3072 + q * 4);
    }
  }
}

constexpr float U8_SCALE = 256.f, V8_SCALE = 64.f;
DI unsigned enc4(float4 a, float sc) {
  int pk = __builtin_amdgcn_cvt_pk_fp8_f32(a.x * sc, a.y * sc, 0, false);
  pk = __builtin_amdgcn_cvt_pk_fp8_f32(a.z * sc, a.w * sc, pk, true);
  return (unsigned)pk;
}
DI void convert_tables(const Params& p, int layer) {
  const size_t gtid = (size_t)obid() * 256 + otid(), gsz = (size_t)gridDim.x * 256;
  const float* u = p.in[35] + (size_t)layer * 16384 * 1024;
  const float* v = p.in[36] + (size_t)layer * 16384 * 1024;
  unsigned char* ub = (unsigned char*)(p.ws + WS_UB); unsigned char* vb = (unsigned char*)(p.ws + WS_VB);
  for (size_t i = gtid; i < (size_t)16384 * 1024 / 16; i += gsz) {
    u32x4 o;
#pragma unroll
    for (int q = 0; q < 4; ++q) o[q] = enc4(*(const float4*)(u + i * 16 + q * 4), U8_SCALE);
    {
      const size_t e0 = i * 16, row = e0 >> 10, col = e0 & 1023;
      *(u32x4*)(ub + (col >> 7) * (size_t)2097152 + row * 128 + (col & 127)) = o;
    }
#pragma unroll
    for (int q = 0; q < 4; ++q) o[q] = enc4(*(const float4*)(v + i * 16 + q * 4), V8_SCALE);
    {
      const size_t e0 = i * 16, row = e0 >> 10, col = e0 & 1023;
      *(u32x4*)(vb + (col >> 7) * (size_t)2097152 + row * 128 + (col & 127)) = o;
    }
  }
}

DI void phase_e_inproj(const Params& p, int i, char* smem) {
  const u16* Xb = (const u16*)(p.ws + WS_XB);
  const u16* W = (const u16*)(p.ws + WS_WINE) + (size_t)i * 1280 * 1024;
  u16* PE = (u16*)(p.ws + WS_PE);
  float* out = p.out;
  for (int t = obid(); t < 129 * 10; t += gridDim.x) {
    const int mt = t / 10, nt = t % 10;
    gemm_tile(Xb, 1024, W, 1024, 1024, mt * 128, nt * 128, (u16*)smem, [&](int tok, int n, f32x4 v, int, int) {
      st_bf4(PE + (size_t)tok * 1280 + n, v[0], v[1], v[2], v[3]);
      if (n >= 1024) {
        const int isv = n >= 1152; const int col = n - (isv ? 1152 : 1024);
        if (tok >= TP) {
          size_t o = (isv ? O_SSWAV : O_SSWAK) + (((size_t)i * 128 + (tok - TP)) * 128 + 127) * 128 + col;
          *(float4*)(out + o) = float4{v[0], v[1], v[2], v[3]};
        } else {
          const int b = tok >> 11, l = tok & 2047;
          if (l >= 1920) {
            size_t o = (isv ? O_PSWAV : O_PSWAK) + (((size_t)i * 8 + b) * 128 + (l - 1920)) * 128 + col;
            *(float4*)(out + o) = float4{v[0], v[1], v[2], v[3]};
          }
        }
      }
    });
  }
}

DI void s5_pass1(const Params& p, int i, char* smem) {
  const int lane = otid() & 63, wid = otid() >> 6;
  float* Us = (float*)smem + wid * 1024;
  const u16* PE = (const u16*)(p.ws + WS_PE);
  const float* AB = (const float*)(p.ws + WS_AB); const float* BBR = (const float*)(p.ws + WS_BBR); const float* BBI = (const float*)(p.ws + WS_BBI);
  float2* E = (float2*)(p.ws + WS_E);
  for (int it = obid() * 4 + wid; it < 8192; it += gridDim.x * 4) {
    const int g = it & 31, chunk = (it >> 5) & 31, b = it >> 10;
    const size_t pi = ((size_t)i * 32 + g) * 64 + lane;
    float bbr[16], bbi[16];
#pragma unroll
    for (int c = 0; c < 4; ++c) {
      float4 a = *(const float4*)(BBR + pi * 16 + c * 4), bb = *(const float4*)(BBI + pi * 16 + c * 4);
      bbr[c * 4] = a.x; bbr[c * 4 + 1] = a.y; bbr[c * 4 + 2] = a.z; bbr[c * 4 + 3] = a.w;
      bbi[c * 4] = bb.x; bbi[c * 4 + 1] = bb.y; bbi[c * 4 + 2] = bb.z; bbi[c * 4 + 3] = bb.w;
    }
    const float abr = AB[pi * 2], abi = AB[pi * 2 + 1];
    const size_t t0 = (size_t)b * 2048 + chunk * 64;
    wave_lds_sync();
    {
      const u16* row = PE + (t0 + lane) * 1280 + g * 16;
      uint4 a = *(const uint4*)row, c = *(const uint4*)(row + 8);
      float* d = Us + lane * 16;
      *(float4*)(d) = float4{lo2f(a.x), hi2f(a.x), lo2f(a.y), hi2f(a.y)};
      *(float4*)(d + 4) = float4{lo2f(a.z), hi2f(a.z), lo2f(a.w), hi2f(a.w)};
      *(float4*)(d + 8) = float4{lo2f(c.x), hi2f(c.x), lo2f(c.y), hi2f(c.y)};
      *(float4*)(d + 12) = float4{lo2f(c.z), hi2f(c.z), lo2f(c.w), hi2f(c.w)};
    }
    wave_lds_sync();
    float hr = 0.f, hi = 0.f;
    for (int t = 0; t < 64; ++t) {
      float bur = 0.f, bui = 0.f;
#pragma unroll
      for (int c = 0; c < 4; ++c) {
        float4 u = *(const float4*)(Us + t * 16 + c * 4);
        bur += bbr[c * 4] * u.x + bbr[c * 4 + 1] * u.y + bbr[c * 4 + 2] * u.z + bbr[c * 4 + 3] * u.w;
        bui += bbi[c * 4] * u.x + bbi[c * 4 + 1] * u.y + bbi[c * 4 + 2] * u.z + bbi[c * 4 + 3] * u.w;
      }
      float nr = abr * hr - abi * hi + bur, ni = abr * hi + abi * hr + bui;
      hr = nr; hi = ni;
    }
    E[(size_t)it * 64 + lane] = float2{hr, hi};
  }
}

DI void s5_pass3(const Params& p, int i, char* smem) {
  const int lane = otid() & 63, wid = otid() >> 6, fr = lane & 15, fq = lane >> 4;
  float* Us = (float*)smem + wid * 1024;
  u16* Hs = (u16*)(smem + 16384) + wid * (16 * 136);
  const u16* PE = (const u16*)(p.ws + WS_PE);
  const float* AB = (const float*)(p.ws + WS_AB); const float* BBR = (const float*)(p.ws + WS_BBR); const float* BBI = (const float*)(p.ws + WS_BBI);
  const u16* CT = (const u16*)(p.ws + WS_CT);
  const float2* E = (const float2*)(p.ws + WS_E);
  u16* G = (u16*)(p.ws + WS_G);
  for (int it = obid() * 4 + wid; it < 8192 + 4096; it += gridDim.x * 4) {
    const bool smp = it >= 8192;
    int g, chunk, b, count; size_t t0;
    if (!smp) { g = it & 31; chunk = (it >> 5) & 31; b = it >> 10; count = 64; t0 = (size_t)b * 2048 + chunk * 64; }
    else { int r = it - 8192; g = r & 31; b = r >> 5; chunk = 0; count = 1; t0 = (size_t)TP + b; }
    const size_t pi = ((size_t)i * 32 + g) * 64 + lane;
    float bbr[16], bbi[16];
#pragma unroll
    for (int c = 0; c < 4; ++c) {
      float4 a = *(const float4*)(BBR + pi * 16 + c * 4), bb = *(const float4*)(BBI + pi * 16 + c * 4);
      bbr[c * 4] = a.x; bbr[c * 4 + 1] = a.y; bbr[c * 4 + 2] = a.z; bbr[c * 4 + 3] = a.w;
      bbi[c * 4] = bb.x; bbi[c * 4 + 1] = bb.y; bbi[c * 4 + 2] = bb.z; bbi[c * 4 + 3] = bb.w;
    }
    const float abr = AB[pi * 2], abi = AB[pi * 2 + 1];
    float hr = 0.f, hi = 0.f;
    if (!smp) {
      float qr = abr, qi = abi;
#pragma unroll
      for (int s = 0; s < 6; ++s) { float nr = qr * qr - qi * qi, ni = 2.f * qr * qi; qr = nr; qi = ni; }
      for (int j = 0; j < chunk; ++j) {
        float2 e = E[(((size_t)b * 32 + j) * 32 + g) * 64 + lane];
        float nr = qr * hr - qi * hi + e.x, ni = qr * hi + qi * hr + e.y;
        hr = nr; hi = ni;
      }
    } else {
      const size_t so = (((size_t)i * 128 + b) * 32 + g) * 64 + lane;
      float h0r = p.in[2][so], h0i = p.in[3][so];
      hr = h0r; hi = h0i;
    }
    bf16x8 ctf[4];
#pragma unroll
    for (int ks = 0; ks < 4; ++ks) ctf[ks] = *(const bf16x8*)(CT + (((size_t)i * 32 + g) * 16 + fr) * 128 + ks * 32 + fq * 8);
    const float4 d4 = *(const float4*)(p.in[16] + (size_t)i * 512 + g * 16 + fq * 4);
    wave_lds_sync();
    {
      float* d = Us + lane * 16;
      if (lane < count) {
        const u16* row = PE + (t0 + lane) * 1280 + g * 16;
        uint4 a = *(const uint4*)row, c = *(const uint4*)(row + 8);
        *(float4*)(d) = float4{lo2f(a.x), hi2f(a.x), lo2f(a.y), hi2f(a.y)};
        *(float4*)(d + 4) = float4{lo2f(a.z), hi2f(a.z), lo2f(a.w), hi2f(a.w)};
        *(float4*)(d + 8) = float4{lo2f(c.x), hi2f(c.x), lo2f(c.y), hi2f(c.y)};
        *(float4*)(d + 12) = float4{lo2f(c.z), hi2f(c.z), lo2f(c.w), hi2f(c.w)};
      } else {
        *(float4*)(d) = float4{0, 0, 0, 0}; *(float4*)(d + 4) = float4{0, 0, 0, 0};
        *(float4*)(d + 8) = float4{0, 0, 0, 0}; *(float4*)(d + 12) = float4{0, 0, 0, 0};
      }
    }
    wave_lds_sync();
    const int nsub = (count + 15) >> 4;
    for (int sub = 0; sub < nsub; ++sub) {
      for (int tt = 0; tt < 16; ++tt) {
        const int t = sub * 16 + tt;
        float wr_ = 0.f, wi_ = 0.f;
        if (t < count) {
          float bur = 0.f, bui = 0.f;
#pragma unroll
          for (int c = 0; c < 4; ++c) {
            float4 u = *(const float4*)(Us + t * 16 + c * 4);
            bur += bbr[c * 4] * u.x + bbr[c * 4 + 1] * u.y + bbr[c * 4 + 2] * u.z + bbr[c * 4 + 3] * u.w;
            bui += bbi[c * 4] * u.x + bbi[c * 4 + 1] * u.y + bbi[c * 4 + 2] * u.z + bbi[c * 4 + 3] * u.w;
          }
          float nr = abr * hr - abi * hi + bur, ni = abr * hi + abi * hr + bui;
          hr = nr; hi = ni; wr_ = hr; wi_ = hi;
        }
        Hs[tt * 136 + lane] = f2bf(wr_);
        Hs[tt * 136 + 64 + lane] = f2bf(wi_);
      }
      wave_lds_sync();
      f32x4 acc = f32x4{0.f, 0.f, 0.f, 0.f};
#pragma unroll
      for (int ks = 0; ks < 4; ++ks) {
        bf16x8 hf = *(const bf16x8*)(Hs + fr * 136 + ks * 32 + fq * 8);
        acc = mfma16(ctf[ks], hf, acc);
      }
      const int t = sub * 16 + fr;
      if (t < count) {
        float4 u4 = *(const float4*)(Us + t * 16 + fq * 4);
        float y0 = gelu_tanh(acc[0] + d4.x * u4.x), y1 = gelu_tanh(acc[1] + d4.y * u4.y);
        float y2 = gelu_tanh(acc[2] + d4.z * u4.z), y3 = gelu_tanh(acc[3] + d4.w * u4.w);
        st_bf4(G + (t0 + t) * 512 + g * 16 + fq * 4, y0, y1, y2, y3);
      }
      wave_lds_sync();
    }
    if (smp) {
      const size_t so = (((size_t)i * 128 + b) * 32 + g) * 64 + lane;
      p.out[O_SS5RE + so] = hr; p.out[O_SS5IM + so] = hi;
    } else if (chunk == 31) {
      const size_t so = (((size_t)i * 8 + b) * 32 + g) * 64 + lane;
      p.out[O_PS5RE + so] = hr; p.out[O_PS5IM + so] = hi;
    }
  }
}

constexpr int VTS = 264;
DI void swa_prompt(const Params& p, int i, char* smem) {
  const int tid = otid(), lane = tid & 63, w = tid >> 6, fr = lane & 15, fq = lane >> 4;
  u16* Vt = (u16*)smem;
  const u16* PE = (const u16*)(p.ws + WS_PE);
  u16* CAT = (u16*)(p.ws + WS_CAT);
  for (int it = obid(); it < 1024; it += gridDim.x) {
    const int qb = it & 15, h = (it >> 4) & 7, b = it >> 7, kvh = h >> 2;
    const float slope = exp2f(-(float)(h + 1));
    const float sink = p.in[18][i * 8 + h];
    __syncthreads();
    {
      const int l = qb * 128 - 128 + tid;
      u32x4 v[8];
      if (l >= 0) {
        const u16* row = PE + ((size_t)b * 2048 + l) * 1280 + 1152 + kvh * 64;
#pragma unroll
        for (int c = 0; c < 8; ++c) v[c] = *(const u32x4*)(row + c * 8);
      } else {
#pragma unroll
        for (int c = 0; c < 8; ++c) v[c] = u32x4{0, 0, 0, 0};
      }
#pragma unroll
      for (int c = 0; c < 8; ++c) {
#pragma unroll
        for (int q = 0; q < 4; ++q) {
          Vt[(c * 8 + 2 * q) * VTS + tid] = (u16)(v[c][q] & 0xffff);
          Vt[(c * 8 + 2 * q + 1) * VTS + tid] = (u16)(v[c][q] >> 16);
        }
      }
    }
    __syncthreads();
#pragma unroll 1
    for (int qt = 0; qt < 2; ++qt) {
      const int rq = 32 * w + 16 * qt, kt0 = 2 * w + qt;
      const size_t qtok = (size_t)b * 2048 + qb * 128 + rq + fr;
      bf16x8 qf[2];
#pragma unroll
      for (int ks = 0; ks < 2; ++ks) qf[ks] = *(const bf16x8*)(PE + qtok * 1280 + 512 + h * 64 + ks * 32 + fq * 8);
      f32x4 s[9];
#pragma unroll
      for (int c = 0; c < 9; ++c) {
        s[c] = f32x4{0.f, 0.f, 0.f, 0.f};
        const int l = qb * 128 - 128 + (kt0 + c) * 16 + fr;
#pragma unroll
        for (int ks = 0; ks < 2; ++ks) {
          bf16x8 kf = bf16x8{0, 0, 0, 0, 0, 0, 0, 0};
          if (l >= 0) kf = *(const bf16x8*)(PE + ((size_t)b * 2048 + l) * 1280 + 1024 + kvh * 64 + ks * 32 + fq * 8);
          s[c] = mfma16(kf, qf[ks], s[c]);
        }
      }
      const int r = rq + fr;
      float mx = -1e30f;
#pragma unroll
      for (int c = 0; c < 9; ++c)
#pragma unroll
        for (int j = 0; j < 4; ++j) {
          const int kl = (kt0 + c) * 16 + fq * 4 + j;
          const int dist = 128 + r - kl;
          const bool valid = dist >= 0 && dist < 128 && (qb * 128 - 128 + kl) >= 0;
          float sc = valid ? s[c][j] * 0.125f - slope * (float)dist : -1e30f;
          s[c][j] = sc; mx = fmaxf(mx, sc);
        }
      mx = fmaxf(mx, __shfl_xor(mx, 16)); mx = fmaxf(mx, __shfl_xor(mx, 32));
      const float m = fmaxf(mx, sink);
      float sum = 0.f;
#pragma unroll
      for (int c = 0; c < 9; ++c)
#pragma unroll
        for (int j = 0; j < 4; ++j) { float e = __expf(s[c][j] - m); s[c][j] = e; sum += e; }
      sum += __shfl_xor(sum, 16); sum += __shfl_xor(sum, 32);
      const float inv = 1.f / (sum + __expf(sink - m));
      f32x4 o[4];
#pragma unroll
      for (int d = 0; d < 4; ++d) o[d] = f32x4{0.f, 0.f, 0.f, 0.f};
#pragma unroll
      for (int pr = 0; pr < 5; ++pr) {
        const int ia = 2 * pr, ib = 2 * pr + 1;
        uint4 pk;
        pk.x = pack2(s[ia][0], s[ia][1]); pk.y = pack2(s[ia][2], s[ia][3]);
        if (ib < 9) { pk.z = pack2(s[ib < 9 ? ib : 8][0], s[ib < 9 ? ib : 8][1]); pk.w = pack2(s[ib < 9 ? ib : 8][2], s[ib < 9 ? ib : 8][3]); }
        else { pk.z = 0; pk.w = 0; }
        const bf16x8 pf = mk8(pk);
        int ta = kt0 + ia, tb = kt0 + ib; if (tb > 15) tb = 15;
#pragma unroll
        for (int d = 0; d < 4; ++d) {
          const u16* vr = Vt + (d * 16 + fr) * VTS;
          uint2 va = *(const uint2*)(vr + ta * 16 + fq * 4), vb = *(const uint2*)(vr + tb * 16 + fq * 4);
          o[d] = mfma16(mk8(uint4{va.x, va.y, vb.x, vb.y}), pf, o[d]);
        }
      }
#pragma unroll
      for (int d = 0; d < 4; ++d)
        st_bf4(CAT + qtok * 1024 + 512 + h * 64 + d * 16 + fq * 4, o[d][0] * inv, o[d][1] * inv, o[d][2] * inv, o[d][3] * inv);
    }
  }
}

DI void swa_sample(const Params& p, int i, char* smem) {
  const int lane = otid() & 63, wid = otid() >> 6;
  float* Ps = (float*)smem + wid * 128;
  const u16* PE = (const u16*)(p.ws + WS_PE);
  u16* CAT = (u16*)(p.ws + WS_CAT);
  for (int it = obid() * 4 + wid; it < 1024; it += gridDim.x * 4) {
    const int h = it & 7, s = it >> 3, kvh = h >> 2;
    const float slope = exp2f(-(float)(h + 1));
    const float sink = p.in[18][i * 8 + h];
    const size_t tok = (size_t)TP + s;
    const u16* qrow = PE + tok * 1280 + 512 + h * 64;
    const u16* knew = PE + tok * 1280 + 1024 + kvh * 64;
    const u16* vnew = PE + tok * 1280 + 1152 + kvh * 64;
    const float* kc = p.in[4] + (((size_t)i * 128 + s) * 128) * 128 + kvh * 64;
    const float* vc = p.in[5] + (((size_t)i * 128 + s) * 128) * 128 + kvh * 64;
    float sc[2];
#pragma unroll
    for (int hh = 0; hh < 2; ++hh) {
      const int id = lane + hh * 64;
      float dot = 0.f;
      if (id < 127) {
        const float* kr = kc + (size_t)(id + 1) * 128;
        for (int d = 0; d < 64; d += 4) {
          float4 kv = *(const float4*)(kr + d);
          uint2 qq = *(const uint2*)(qrow + d);
          dot += kv.x * lo2f(qq.x) + kv.y * hi2f(qq.x) + kv.z * lo2f(qq.y) + kv.w * hi2f(qq.y);
        }
      } else {
        for (int d = 0; d < 64; d += 4) {
          uint2 kk = *(const uint2*)(knew + d);
          uint2 qq = *(const uint2*)(qrow + d);
          dot += lo2f(kk.x) * lo2f(qq.x) + hi2f(kk.x) * hi2f(qq.x) + lo2f(kk.y) * lo2f(qq.y) + hi2f(kk.y) * hi2f(qq.y);
        }
      }
      sc[hh] = dot * 0.125f - slope * (float)(127 - id);
    }
    float mx = fmaxf(sc[0], sc[1]);
#pragma unroll
    for (int o = 32; o > 0; o >>= 1) mx = fmaxf(mx, __shfl_xor(mx, o));
    const float m = fmaxf(mx, sink);
    float e0 = __expf(sc[0] - m), e1 = __expf(sc[1] - m);
    float sum = e0 + e1;
#pragma unroll
    for (int o = 32; o > 0; o >>= 1) sum += __shfl_xor(sum, o);
    const float inv = 1.f / (sum + __expf(sink - m));
    wave_lds_sync();
    Ps[lane] = e0 * inv; Ps[lane + 64] = e1 * inv;
    wave_lds_sync();
    float o = 0.f;
    for (int id = 0; id < 127; ++id) o += Ps[id] * vc[(size_t)(id + 1) * 128 + lane];
    o += Ps[127] * bf2f(vnew[lane]);
    CAT[tok * 1024 + 512 + h * 64 + lane] = f2bf(o);
  }
}

DI void phase_e_glu(const Params& p, int i, char* smem) {
  const u16* G = (const u16*)(p.ws + WS_G);
  const u16* W = (const u16*)(p.ws + WS_WGLU) + (size_t)i * 512 * 512;
  u16* CAT = (u16*)(p.ws + WS_CAT);
  for (int t = obid(); t < 129 * 4; t += gridDim.x) {
    const int mt = t / 4, nt = t % 4;
    gemm_tile(G, 512, W, 512, 512, mt * 128, nt * 128, (u16*)smem, [&](int tok, int n, f32x4 v, int, int) {
      uint2 gg = *(const uint2*)(G + (size_t)tok * 512 + n);
      float g0 = lo2f(gg.x), g1 = hi2f(gg.x), g2 = lo2f(gg.y), g3 = hi2f(gg.y);
      st_bf4(CAT + (size_t)tok * 1024 + n, g0 * sigmoidf_(v[0]), g1 * sigmoidf_(v[1]), g2 * sigmoidf_(v[2]), g3 * sigmoidf_(v[3]));
    });
  }
}

DI void phase_outproj(const Params& p, const u16* A, int K, const u16* W, bool use_ssq, char* smem) {
  const float* X = (const float*)(p.ws + WS_X);
  float* R = (float*)(p.ws + WS_R);
  const float* SSQ = (const float*)(p.ws + WS_SSQ);
  for (int t = obid(); t < 129 * 8; t += gridDim.x) {
    const int mt = t / 8, nt = t % 8;
    gemm_tile(A, K, W, K, K, mt * 128, nt * 128, (u16*)smem, [&](int tok, int n, f32x4 v, int, int) {
      float sc = 1.f;
      if (use_ssq) {
        float ssum = 0.f;
#pragma unroll
        for (int q = 0; q < 8; ++q) { float4 s4 = *(const float4*)(SSQ + (size_t)tok * 32 + q * 4); ssum += (s4.x + s4.y) + (s4.z + s4.w); }
        sc = rsqrtf(ssum * (1.f / 2048.f) + 1e-5f);
      }
      float4 x = *(const float4*)(X + (size_t)tok * 1024 + n);
      *(float4*)(R + (size_t)tok * 1024 + n) = float4{ALPHA * x.x + sc * v[0], ALPHA * x.y + sc * v[1], ALPHA * x.z + sc * v[2], ALPHA * x.w + sc * v[3]};
    });
  }
}

DI void phase_ln1(const Params& p, int layer) {
  const int lane = otid() & 63, wid = otid() >> 6;
  const float* R = (const float*)(p.ws + WS_R);
  float* X = (float*)(p.ws + WS_X); u16* Xb = (u16*)(p.ws + WS_XB);
  const float* gam = p.in[28] + (size_t)layer * 1024; const float* bet = p.in[29] + (size_t)layer * 1024;
  for (int tok = obid() * 4 + wid; tok < T; tok += gridDim.x * 4) {
    float4 v[4];
    float s = 0.f;
#pragma unroll
    for (int c = 0; c < 4; ++c) { v[c] = *(const float4*)(R + (size_t)tok * 1024 + c * 256 + lane * 4); s += v[c].x + v[c].y + v[c].z + v[c].w; }
#pragma unroll
    for (int o = 32; o > 0; o >>= 1) s += __shfl_xor(s, o);
    const float mu = s * (1.f / 1024.f);
    float q = 0.f;
#pragma unroll
    for (int c = 0; c < 4; ++c) { float a = v[c].x - mu, b = v[c].y - mu, cc = v[c].z - mu, d = v[c].w - mu; q += a * a + b * b + cc * cc + d * d; }
#pragma unroll
    for (int o = 32; o > 0; o >>= 1) q += __shfl_xor(q, o);
    const float rstd = rsqrtf(q * (1.f / 1024.f) + 1e-5f);
#pragma unroll
    for (int c = 0; c < 4; ++c) {
      const int col = c * 256 + lane * 4;
      float4 g = *(const float4*)(gam + col), bb = *(const float4*)(bet + col);
      float4 o = float4{(v[c].x - mu) * rstd * g.x + bb.x, (v[c].y - mu) * rstd * g.y + bb.y, (v[c].z - mu) * rstd * g.z + bb.z, (v[c].w - mu) * rstd * g.w + bb.w};
      *(float4*)(X + (size_t)tok * 1024 + col) = o;
      st_bf4(Xb + (size_t)tok * 1024 + col, o.x, o.y, o.z, o.w);
    }
  }
}

DI unsigned sortkey(float f) { unsigned u = __float_as_uint(f); return u ^ ((u >> 31) ? 0xffffffffu : 0x80000000u); }
DI float unsortkey(unsigned k) { unsigned u = (k & 0x80000000u) ? (k ^ 0x80000000u) : ~k; return __uint_as_float(u); }

constexpr int QSS = 136;
DI unsigned umax_(unsigned a, unsigned b) { return a > b ? a : b; }
DI unsigned umin_(unsigned a, unsigned b) { return a < b ? a : b; }
DI void sort16_desc(unsigned (&a)[16]) {
#pragma unroll
  for (int k = 2; k <= 16; k <<= 1)
#pragma unroll
    for (int j = k >> 1; j > 0; j >>= 1)
#pragma unroll
      for (int i = 0; i < 16; ++i) {
        const int l = i ^ j;
        if (l > i) {
          const bool up = (i & k) == 0;
          const unsigned lo = umin_(a[i], a[l]), hi = umax_(a[i], a[l]);
          a[i] = up ? hi : lo; a[l] = up ? lo : hi;
        }
      }
}
DI void merge16_desc(unsigned (&a)[16]) {
#pragma unroll
  for (int j = 8; j > 0; j >>= 1)
#pragma unroll
    for (int i = 0; i < 16; ++i) {
      const int l = i ^ j;
      if (l > i) { const unsigned lo = umin_(a[i], a[l]), hi = umax_(a[i], a[l]); a[i] = hi; a[l] = lo; }
    }
}
constexpr int PEER_LST_OFF = GEMM_SMEM;
DI void phase_peer1(const Params& p, int layer, char* smem) {
  const int tid = otid(), lane = tid & 63, w = tid >> 6, fr = lane & 15, fq = lane >> 4;
  const u16* Xb = (const u16*)(p.ws + WS_XB);
  const u16* WQ = (const u16*)(p.ws + WS_WQ) + (size_t)layer * 2048 * 1024;
  u16* Qs = (u16*)smem;
  unsigned* Ls = (unsigned*)(smem + PEER_LST_OFF);
  int* IDX = (int*)(p.ws + WS_IDXP); float* GATE = (float*)(p.ws + WS_GATE);
  for (int it = obid(); it < 129 * 8; it += gridDim.x) {
    const int mt = it >> 3, h = it & 7;
#pragma unroll 1
    for (int half = 0; half < 2; ++half) {
      const int m0 = mt * 128, n0 = h * 256 + half * 128;
      gemm_tile<true>(Xb, 1024, WQ, 1024, 1024, m0, n0, (u16*)smem, [&](int tok, int n, f32x4 v, int, int) {
        st_bf4(Qs + (tok - m0) * QSS + (n - n0), v[0], v[1], v[2], v[3]);
      });
      __syncthreads();
      const u16* KT = (const u16*)(p.ws + (half ? WS_K2 : WS_K1)) + ((size_t)layer * 8 + h) * 128 * 128;
#pragma unroll 1
      for (int tt = 0; tt < 2; ++tt) {
        bf16x8 qf[4];
#pragma unroll
        for (int ks = 0; ks < 4; ++ks) qf[ks] = *(const bf16x8*)(Qs + (32 * w + tt * 16 + fr) * QSS + ks * 32 + fq * 8);
        unsigned k[32];
#pragma unroll
        for (int kt = 0; kt < 8; ++kt) {
          f32x4 sc = f32x4{0.f, 0.f, 0.f, 0.f};
#pragma unroll
          for (int ks = 0; ks < 4; ++ks) {
            bf16x8 kf = *(const bf16x8*)(KT + (size_t)(kt * 16 + fr) * 128 + ks * 32 + fq * 8);
            sc = mfma16(kf, qf[ks], sc);
          }
#pragma unroll
          for (int j = 0; j < 4; ++j) k[kt * 4 + j] = (sortkey(sc[j]) & ~127u) | (unsigned)(kt * 16 + fq * 4 + j);
          if (kt & 1) __builtin_amdgcn_sched_barrier(0);
        }
        unsigned* lp = Ls + (32 * w + tt * 16 + fr) * 32 + half * 16;
        {
          unsigned A[16], B[16];
#pragma unroll
          for (int q = 0; q < 16; ++q) { A[q] = k[q]; B[q] = k[16 + q]; }
          sort16_desc(A); sort16_desc(B);
#pragma unroll
          for (int q = 0; q < 16; ++q) A[q] = umax_(A[q], B[15 - q]);
          merge16_desc(A);
#pragma unroll
          for (int q = 0; q < 16; ++q) B[q] = __shfl_xor(A[15 - q], 16);
#pragma unroll
          for (int q = 0; q < 16; ++q) A[q] = umax_(A[q], B[q]);
          merge16_desc(A);
#pragma unroll
          for (int q = 0; q < 16; ++q) B[q] = __shfl_xor(A[15 - q], 32);
#pragma unroll
          for (int q = 0; q < 16; ++q) A[q] = umax_(A[q], B[q]);
          merge16_desc(A);
          if (fq == 0) {
#pragma unroll
            for (int q = 0; q < 4; ++q) *(u32x4*)(lp + q * 4) = u32x4{A[q * 4], A[q * 4 + 1], A[q * 4 + 2], A[q * 4 + 3]};
          }
        }
      }
    }
    wave_lds_sync();
#pragma unroll 1
    for (int tt = 0; tt < 2; ++tt) {
      const unsigned* lp = Ls + (32 * w + tt * 16 + fr) * 32;
      unsigned A[16], B[16];
      unsigned l2[16];
#pragma unroll
      for (int j = 0; j < 16; ++j) { l2[j] = lp[16 + j]; B[j] = 0u; }
#pragma unroll
      for (int m = 0; m < 4; ++m) {
        const unsigned a = lp[4 * m + fq];
        const float av = unsortkey(a & ~127u); const unsigned ai = a & 127u;
        const int J = m == 0 ? 16 : m == 1 ? 3 : 1;
        const int base = m == 0 ? 0 : m == 1 ? 16 : m == 2 ? 19 : 20;
#pragma unroll
        for (int j = 0; j < J; ++j) {
          const unsigned b = l2[j];
          const float sj = av + unsortkey(b & ~127u);
          const unsigned kk = (sortkey(sj) & ~0x3fffu) | (ai << 7) | (b & 127u);
          if (base + j < 16) A[base + j] = kk; else B[base + j - 16] = kk;
        }
      }
      sort16_desc(A); sort16_desc(B);
#pragma unroll
      for (int q = 0; q < 16; ++q) A[q] = umax_(A[q], B[15 - q]);
      merge16_desc(A);
#pragma unroll
      for (int q = 0; q < 16; ++q) B[q] = __shfl_xor(A[15 - q], 16);
#pragma unroll
      for (int q = 0; q < 16; ++q) A[q] = umax_(A[q], B[q]);
      merge16_desc(A);
#pragma unroll
      for (int q = 0; q < 16; ++q) B[q] = __shfl_xor(A[15 - q], 32);
#pragma unroll
      for (int q = 0; q < 16; ++q) A[q] = umax_(A[q], B[q]);
      merge16_desc(A);
      const size_t tok = (size_t)mt * 128 + 32 * w + tt * 16 + fr;
      int* ip = IDX + tok * 128; float* gp = GATE + tok * 128 + h * 16;
      if (fq == 0) {
        const float mxs = unsortkey(A[0] & ~0x3fffu);
#pragma unroll
        for (int r = 0; r < 16; ++r) {
          ip[(r & 7) * 16 + 2 * h + (r >> 3)] = (int)(A[r] & 0x3fffu);
          gp[r] = __expf(unsortkey(A[r] & ~0x3fffu) - mxs);
        }
      }
    }
    wave_lds_sync();
  }
}

typedef __attribute__((ext_vector_type(2))) float f32x2;
DI void dec16(u32x4 r, f32x2 (&o)[8]) {
#pragma unroll
  for (int q = 0; q < 4; ++q) { o[2 * q] = __builtin_amdgcn_cvt_pk_f32_fp8((int)r[q], false); o[2 * q + 1] = __builtin_amdgcn_cvt_pk_f32_fp8((int)r[q], true); }
}
DI float dpp_f(float v, const int ctrl_sel) {
  const int x = __builtin_bit_cast(int, v);
  int r;
  if (ctrl_sel == 0) r = __builtin_amdgcn_update_dpp(0, x, 0xB1, 0xF, 0xF, true);
  else if (ctrl_sel == 1) r = __builtin_amdgcn_update_dpp(0, x, 0x4E, 0xF, 0xF, true);
  else if (ctrl_sel == 2) r = __builtin_amdgcn_update_dpp(0, x, 0x141, 0xF, 0xF, true);
  else r = __builtin_amdgcn_update_dpp(0, x, 0x140, 0xF, 0xF, true);
  return __builtin_bit_cast(float, r);
}
DI float wave_sum_uniform(float v) {
  v += dpp_f(v, 0); v += dpp_f(v, 1); v += dpp_f(v, 2); v += dpp_f(v, 3);
  const int x = __builtin_bit_cast(int, v);
  const float r0 = __builtin_bit_cast(float, __builtin_amdgcn_readlane(x, 0)), r1 = __builtin_bit_cast(float, __builtin_amdgcn_readlane(x, 16));
  const float r2 = __builtin_bit_cast(float, __builtin_amdgcn_readlane(x, 32)), r3 = __builtin_bit_cast(float, __builtin_amdgcn_readlane(x, 48));
  return (r0 + r1) + (r2 + r3);
}
DI float row16_sum(float v) { v += dpp_f(v, 0); v += dpp_f(v, 1); v += dpp_f(v, 2); v += dpp_f(v, 3); return v; }

DI void phase_peer3u(const Params& p, int layer) {
  const int lane = otid() & 63, wid = otid() >> 6;
  const unsigned char* UB = (const unsigned char*)(p.ws + WS_UB);
  const int* IDXP = (const int*)(p.ws + WS_IDXP); const float* GATE = (const float*)(p.ws + WS_GATE);
  const u16* Xb = (const u16*)(p.ws + WS_XB);
  float* ACTP = (float*)(p.ws + WS_ACTP); float* HP = (float*)(p.ws + WS_IDX);
  const int r = lane >> 3, c = lane & 7;
  const bool b0 = c & 1, b1 = c & 2, b2 = c & 4;
  const int itbase = (b0 ? 8 : 0) + (b1 ? 4 : 0) + (b2 ? 2 : 0);
  const int stride = gridDim.x * 4;
#pragma unroll 1
  for (int cb = 0; cb < 8; ++cb) {
    int tok = obid() * 4 + wid;
    int idp[16]; u32x4 xa, xb; f32x2 hp = f32x2{0.f, 0.f};
    if (tok < T) {
#pragma unroll
      for (int q = 0; q < 4; ++q) { const int4 iv = *(const int4*)(IDXP + (size_t)tok * 128 + r * 16 + q * 4); idp[q * 4] = iv.x; idp[q * 4 + 1] = iv.y; idp[q * 4 + 2] = iv.z; idp[q * 4 + 3] = iv.w; }
      xa = *(const u32x4*)(Xb + (size_t)tok * 1024 + cb * 128 + c * 16); xb = *(const u32x4*)(Xb + (size_t)tok * 1024 + cb * 128 + c * 16 + 8);
      if (cb > 0) hp = *(const f32x2*)(HP + (size_t)tok * 128 + r * 16 + itbase);
    }
#pragma unroll 1
    while (tok < T) {
      u32x4 rr[16];
#pragma unroll
      for (int it = 0; it < 16; ++it) rr[it] = *(const u32x4*)(UB + (size_t)cb * 2097152 + (size_t)idp[it] * 128 + c * 16);
      const int tokn = tok + stride;
      int idn[16]; u32x4 xan = xa, xbn = xb; f32x2 hpn = f32x2{0.f, 0.f};
#pragma unroll
      for (int q = 0; q < 16; ++q) idn[q] = 0;
      if (tokn < T) {
#pragma unroll
        for (int q = 0; q < 4; ++q) { const int4 iv = *(const int4*)(IDXP + (size_t)tokn * 128 + r * 16 + q * 4); idn[q * 4] = iv.x; idn[q * 4 + 1] = iv.y; idn[q * 4 + 2] = iv.z; idn[q * 4 + 3] = iv.w; }
        xan = *(const u32x4*)(Xb + (size_t)tokn * 1024 + cb * 128 + c * 16); xbn = *(const u32x4*)(Xb + (size_t)tokn * 1024 + cb * 128 + c * 16 + 8);
        if (cb > 0) hpn = *(const f32x2*)(HP + (size_t)tokn * 128 + r * 16 + itbase);
      }
      f32x2 x2[8];
#pragma unroll
      for (int q = 0; q < 4; ++q) { x2[q] = f32x2{lo2f(xa[q]), hi2f(xa[q])}; x2[4 + q] = f32x2{lo2f(xb[q]), hi2f(xb[q])}; }
      float v[16];
#pragma unroll
      for (int it = 0; it < 16; ++it) {
        f32x2 d[8]; dec16(rr[it], d);
        f32x2 a2 = d[0] * x2[0];
#pragma unroll
        for (int k = 1; k < 8; ++k) a2 += d[k] * x2[k];
        v[it] = a2.x + a2.y;
      }
      float w8[8];
#pragma unroll
      for (int k = 0; k < 8; ++k) { const float send = b0 ? v[k] : v[8 + k]; const float keep = b0 ? v[8 + k] : v[k]; w8[k] = keep + dpp_f(send, 0); }
      float w4[4];
#pragma unroll
      for (int k = 0; k < 4; ++k) { const float send = b1 ? w8[k] : w8[4 + k]; const float keep = b1 ? w8[4 + k] : w8[k]; w4[k] = keep + dpp_f(send, 1); }
      float w2[2];
#pragma unroll
      for (int k = 0; k < 2; ++k) { const float send = b2 ? w4[k] : w4[2 + k]; const float keep = b2 ? w4[2 + k] : w4[k]; w2[k] = keep + __shfl_xor(send, 4); }
      const float h0 = hp.x + w2[0], h1 = hp.y + w2[1];
      if (cb < 7) {
        *(f32x2*)(HP + (size_t)tok * 128 + r * 16 + itbase) = f32x2{h0, h1};
      } else {
        const int hc = itbase >> 1;
        const float ga = GATE[(size_t)tok * 128 + hc * 16 + r], gb = GATE[(size_t)tok * 128 + hc * 16 + 8 + r];
        float den = ga + gb;
        den += __builtin_bit_cast(float, __builtin_amdgcn_update_dpp(0, __builtin_bit_cast(int, den), 0x128, 0xF, 0xF, true));
        den += __shfl_xor(den, 16); den += __shfl_xor(den, 32);
        const float sc = 1.f / (den * V8_SCALE);
        *(f32x2*)(ACTP + (size_t)tok * 128 + r * 16 + itbase) = f32x2{gelu_tanh(h0 * (1.f / U8_SCALE)) * ga * sc, gelu_tanh(h1 * (1.f / U8_SCALE)) * gb * sc};
      }
#pragma unroll
      for (int q = 0; q < 16; ++q) idp[q] = idn[q];
      xa = xan; xb = xbn; hp = hpn; tok = tokn;
    }
  }
}

DI void phase_peer3v(const Params& p, int layer) {
  const int lane = otid() & 63, wid = otid() >> 6;
  const unsigned char* VB = (const unsigned char*)(p.ws + WS_VB);
  const float* ACTP = (const float*)(p.ws + WS_ACTP); const int* IDXP = (const int*)(p.ws + WS_IDXP);
  float* Y = (float*)(p.ws + WS_R);
  const int r = lane >> 3, c = lane & 7;
  const int stride = gridDim.x * 4;
#pragma unroll 1
  for (int cb = 0; cb < 8; ++cb) {
    int tok = obid() * 4 + wid;
    int idp[16]; float ap[16];
#pragma unroll
    for (int q = 0; q < 16; ++q) { idp[q] = 0; ap[q] = 0.f; }
    if (tok < T) {
#pragma unroll
      for (int q = 0; q < 4; ++q) {
        const int4 iv = *(const int4*)(IDXP + (size_t)tok * 128 + r * 16 + q * 4);
        const float4 av = *(const float4*)(ACTP + (size_t)tok * 128 + r * 16 + q * 4);
        idp[q * 4] = iv.x; idp[q * 4 + 1] = iv.y; idp[q * 4 + 2] = iv.z; idp[q * 4 + 3] = iv.w;
        ap[q * 4] = av.x; ap[q * 4 + 1] = av.y; ap[q * 4 + 2] = av.z; ap[q * 4 + 3] = av.w;
      }
    }
#pragma unroll 1
    while (tok < T) {
      u32x4 rr[16];
#pragma unroll
      for (int it = 0; it < 16; ++it) rr[it] = *(const u32x4*)(VB + (size_t)cb * 2097152 + (size_t)idp[it] * 128 + c * 16);
      const int tokn = tok + stride;
      int idn[16]; float an[16];
#pragma unroll
      for (int q = 0; q < 16; ++q) { idn[q] = 0; an[q] = 0.f; }
      if (tokn < T) {
#pragma unroll
        for (int q = 0; q < 4; ++q) {
          const int4 iv = *(const int4*)(IDXP + (size_t)tokn * 128 + r * 16 + q * 4);
          const float4 av = *(const float4*)(ACTP + (size_t)tokn * 128 + r * 16 + q * 4);
          idn[q * 4] = iv.x; idn[q * 4 + 1] = iv.y; idn[q * 4 + 2] = iv.z; idn[q * 4 + 3] = iv.w;
          an[q * 4] = av.x; an[q * 4 + 1] = av.y; an[q * 4 + 2] = av.z; an[q * 4 + 3] = av.w;
        }
      }
      f32x2 acc[8];
#pragma unroll
      for (int k = 0; k < 8; ++k) acc[k] = f32x2{0.f, 0.f};
#pragma unroll
      for (int it = 0; it < 16; ++it) {
        f32x2 d[8]; dec16(rr[it], d);
        const f32x2 a2 = f32x2{ap[it], ap[it]};
#pragma unroll
        for (int k = 0; k < 8; ++k) acc[k] += d[k] * a2;
      }
      float v[16];
#pragma unroll
      for (int k = 0; k < 8; ++k) { v[2 * k] = acc[k].x; v[2 * k + 1] = acc[k].y; }
#pragma unroll
      for (int k = 0; k < 16; ++k) v[k] += __builtin_bit_cast(float, __builtin_amdgcn_update_dpp(0, __builtin_bit_cast(int, v[k]), 0x128, 0xF, 0xF, true));
      const bool b4 = lane & 16, b5 = lane & 32;
      float w8[8];
#pragma unroll
      for (int k = 0; k < 8; ++k) { const float send = b4 ? v[k] : v[8 + k]; const float keep = b4 ? v[8 + k] : v[k]; w8[k] = keep + __shfl_xor(send, 16); }
      float z[4];
#pragma unroll
      for (int k = 0; k < 4; ++k) { const float send = b5 ? w8[k] : w8[4 + k]; const float keep = b5 ? w8[4 + k] : w8[k]; z[k] = keep + __shfl_xor(send, 32); }
      if ((lane & 8) == 0) *(float4*)(Y + (size_t)tok * 1024 + cb * 128 + c * 16 + (b4 ? 8 : 0) + (b5 ? 4 : 0)) = float4{z[0], z[1], z[2], z[3]};
#pragma unroll
      for (int q = 0; q < 16; ++q) { idp[q] = idn[q]; ap[q] = an[q]; }
      tok = tokn;
    }
  }
}

DI void phase_peer3n(const Params& p, int layer) {
  const int lane = otid() & 63, wid = otid() >> 6;
  const float* Y = (const float*)(p.ws + WS_R);
  float* X = (float*)(p.ws + WS_X); u16* Xb = (u16*)(p.ws + WS_XB);
  const float* gam = p.in[30] + (size_t)layer * 1024; const float* bet = p.in[31] + (size_t)layer * 1024;
  const bool last = layer == 3;
  for (int tok = obid() * 4 + wid; tok < T; tok += gridDim.x * 4) {
    float4 v[4];
    float s = 0.f;
#pragma unroll
    for (int cc = 0; cc < 4; ++cc) {
      const size_t o = (size_t)tok * 1024 + cc * 256 + lane * 4;
      const float4 y = *(const float4*)(Y + o), x = *(const float4*)(X + o);
      v[cc] = float4{ALPHA * x.x + y.x, ALPHA * x.y + y.y, ALPHA * x.z + y.z, ALPHA * x.w + y.w};
      s += v[cc].x + v[cc].y + v[cc].z + v[cc].w;
    }
#pragma unroll
    for (int o = 32; o > 0; o >>= 1) s += __shfl_xor(s, o);
    const float mu = s * (1.f / 1024.f);
    float q = 0.f;
#pragma unroll
    for (int cc = 0; cc < 4; ++cc) { float a = v[cc].x - mu, b = v[cc].y - mu, c2 = v[cc].z - mu, d = v[cc].w - mu; q += a * a + b * b + c2 * c2 + d * d; }
#pragma unroll
    for (int o = 32; o > 0; o >>= 1) q += __shfl_xor(q, o);
    const float rstd = rsqrtf(q * (1.f / 1024.f) + 1e-5f);
#pragma unroll
    for (int cc = 0; cc < 4; ++cc) {
      const int col = cc * 256 + lane * 4;
      float4 g = *(const float4*)(gam + col), bb = *(const float4*)(bet + col);
      float4 o = float4{(v[cc].x - mu) * rstd * g.x + bb.x, (v[cc].y - mu) * rstd * g.y + bb.y, (v[cc].z - mu) * rstd * g.z + bb.z, (v[cc].w - mu) * rstd * g.w + bb.w};
      if (last) *(float4*)(p.out + O_Y + (size_t)tok * 1024 + col) = o;
      else { *(float4*)(X + (size_t)tok * 1024 + col) = o; st_bf4(Xb + (size_t)tok * 1024 + col, o.x, o.y, o.z, o.w); }
    }
  }
}

DI void phase_o_inproj(const Params& p, int i, char* smem) {
  const u16* Xb = (const u16*)(p.ws + WS_XB);
  const u16* W = (const u16*)(p.ws + WS_WINO) + (size_t)i * 5248 * 1024;
  u16* Z = (u16*)(p.ws + WS_Z); u16* XBCR = (u16*)(p.ws + WS_XBCR); float* DTR = (float*)(p.ws + WS_DTR);
  float* out = p.out;
  for (int t = obid(); t < 129 * 41; t += gridDim.x) {
    const int mt = t / 41, nt = t % 41;
    gemm_tile(Xb, 1024, W, 1024, 1024, mt * 128, nt * 128, (u16*)smem, [&](int tok, int n, f32x4 v, int, int) {
      if (n < 2048) st_bf4(Z + (size_t)tok * 2048 + n, v[0], v[1], v[2], v[3]);
      else if (n < 5120) {
        const int c = n - 2048;
        st_bf4(XBCR + (size_t)tok * 3072 + c, v[0], v[1], v[2], v[3]);
        if (tok >= TP) *(float4*)(out + O_SCONV + (((size_t)i * 128 + (tok - TP)) * 3 + 2) * 3072 + c) = float4{v[0], v[1], v[2], v[3]};
        else {
          const int b = tok >> 11, l = tok & 2047;
          if (l >= 2045) *(float4*)(out + O_PCONV + (((size_t)i * 8 + b) * 3 + (l - 2045)) * 3072 + c) = float4{v[0], v[1], v[2], v[3]};
        }
      } else if (n < 5152) *(float4*)(DTR + (size_t)tok * 32 + (n - 5120)) = float4{v[0], v[1], v[2], v[3]};
    });
  }
}

DI void phase_o_conv(const Params& p, int i, char* smem) {
  const int tid = otid();
  const size_t gtid = (size_t)obid() * 256 + tid, gsz = (size_t)gridDim.x * 256;
  const u16* XBCR = (const u16*)(p.ws + WS_XBCR);
  u16* XS = (u16*)(p.ws + WS_XS); u16* BM = (u16*)(p.ws + WS_BM); u16* CM = (u16*)(p.ws + WS_CM);
  u16* XST = (u16*)(p.ws + WS_XST); u16* BMT = (u16*)(p.ws + WS_BMT);
  const float* cw = p.in[21] + (size_t)i * 4 * 3072; const float* cb = p.in[22] + (size_t)i * 3072;
  for (int unit = obid(); unit < 64 * 24; unit += gridDim.x) {
    const int cbk = unit % 24, tbk = unit / 24;
    const int cg = tid & 15, tr = tid >> 4;
    const int ch = cbk * 128 + cg * 8, t0 = tbk * 256 + tr * 16, l0 = t0 & 2047, b = t0 >> 11;
    float w[4][8], bs[8];
#pragma unroll
    for (int k = 0; k < 4; ++k) {
      const float4 wa = *(const float4*)(cw + (size_t)k * 3072 + ch), wb = *(const float4*)(cw + (size_t)k * 3072 + ch + 4);
      w[k][0] = wa.x; w[k][1] = wa.y; w[k][2] = wa.z; w[k][3] = wa.w; w[k][4] = wb.x; w[k][5] = wb.y; w[k][6] = wb.z; w[k][7] = wb.w;
    }
    {
      const float4 ba = *(const float4*)(cb + ch), bb = *(const float4*)(cb + ch + 4);
      bs[0] = ba.x; bs[1] = ba.y; bs[2] = ba.z; bs[3] = ba.w; bs[4] = bb.x; bs[5] = bb.y; bs[6] = bb.z; bs[7] = bb.w;
    }
    float x0[8], x1[8], x2[8];
    {
      u32x4 r0 = u32x4{0, 0, 0, 0}, r1 = r0, r2 = r0;
      if (l0 >= 3) {
        r0 = *(const u32x4*)(XBCR + (size_t)(t0 - 3) * 3072 + ch);
        r1 = *(const u32x4*)(XBCR + (size_t)(t0 - 2) * 3072 + ch);
        r2 = *(const u32x4*)(XBCR + (size_t)(t0 - 1) * 3072 + ch);
      }
#pragma unroll
      for (int q = 0; q < 4; ++q) { x0[2 * q] = lo2f(r0[q]); x0[2 * q + 1] = hi2f(r0[q]); x1[2 * q] = lo2f(r1[q]); x1[2 * q + 1] = hi2f(r1[q]); x2[2 * q] = lo2f(r2[q]); x2[2 * q + 1] = hi2f(r2[q]); }
    }
#pragma unroll
    for (int half = 0; half < 2; ++half) {
      u32x4 rows[8];
#pragma unroll
      for (int k = 0; k < 8; ++k) rows[k] = *(const u32x4*)(XBCR + (size_t)(t0 + half * 8 + k) * 3072 + ch);
      unsigned outp[8][4];
#pragma unroll
      for (int k = 0; k < 8; ++k) {
        float cur[8], y[8];
#pragma unroll
        for (int q = 0; q < 4; ++q) { cur[2 * q] = lo2f(rows[k][q]); cur[2 * q + 1] = hi2f(rows[k][q]); }
#pragma unroll
        for (int c = 0; c < 8; ++c) {
          y[c] = siluf_(bs[c] + w[0][c] * x0[c] + w[1][c] * x1[c] + w[2][c] * x2[c] + w[3][c] * cur[c]);
          x0[c] = x1[c]; x1[c] = x2[c]; x2[c] = cur[c];
        }
        u32x4 o; o[0] = pack2(y[0], y[1]); o[1] = pack2(y[2], y[3]); o[2] = pack2(y[4], y[5]); o[3] = pack2(y[6], y[7]);
        const size_t tok = (size_t)t0 + half * 8 + k;
        if (ch < 2048) *(u32x4*)(XS + tok * 2048 + ch) = o;
        else if (ch < 2560) *(u32x4*)(BM + tok * 512 + (ch - 2048)) = o;
        else *(u32x4*)(CM + tok * 512 + (ch - 2560)) = o;
#pragma unroll
        for (int c = 0; c < 8; ++c) {
          const unsigned hv = (c & 1) ? (o[c >> 1] >> 16) : (o[c >> 1] & 0xffffu);
          if (k & 1) outp[c][k >> 1] |= hv << 16; else outp[c][k >> 1] = hv;
        }
      }
      if (ch < 2560) {
        const int l = l0 + half * 8, chunk = l >> 7, so = l & 127;
#pragma unroll
        for (int c = 0; c < 8; ++c) {
          const u32x4 o = u32x4{outp[c][0], outp[c][1], outp[c][2], outp[c][3]};
          if (ch < 2048) *(u32x4*)(XST + (((size_t)b * 16 + chunk) * 2048 + ch + c) * 128 + so) = o;
          else *(u32x4*)(BMT + (((size_t)b * 16 + chunk) * 512 + (ch - 2048) + c) * 128 + so) = o;
        }
      }
    }
  }
  for (size_t e = gtid; e < (size_t)128 * 3072; e += gsz) {
    const int s = (int)(e / 3072), ch = (int)(e % 3072);
    const float* st = p.in[7] + ((size_t)i * 128 + s) * 3 * 3072 + ch;
    const size_t tok = (size_t)TP + s;
    float y = cb[ch] + cw[ch] * st[0] + cw[3072 + ch] * st[3072] + cw[2 * 3072 + ch] * st[2 * 3072] + cw[3 * 3072 + ch] * bf2f(XBCR[tok * 3072 + ch]);
    const u16 yb = f2bf(siluf_(y));
    if (ch < 2048) XS[tok * 2048 + ch] = yb;
    else if (ch < 2560) BM[tok * 512 + ch - 2048] = yb;
    else CM[tok * 512 + ch - 2560] = yb;
  }
  {
    const float* DTR = (const float*)(p.ws + WS_DTR); float* DT = (float*)(p.ws + WS_DT);
    const float* bias = p.in[23] + (size_t)i * 32;
    for (size_t e = gtid; e < (size_t)T * 32; e += gsz) {
      float x = DTR[e] + bias[e & 31];
      DT[e] = x > 20.f ? x : log1pf(expf(x));
    }
  }
}

DI void chunk_scan(const float* DT, size_t tok0, int h, float a, float* acs, float* dts, float* tot) {
  const int tid = otid(), lane = tid & 63;
  float d = 0.f, v = 0.f;
  __syncthreads();
  if (tid < 128) {
    d = DT[(tok0 + tid) * 32 + h];
    v = d * a;
#pragma unroll
    for (int o = 1; o < 64; o <<= 1) { float n = __shfl_up(v, o); if (lane >= o) v += n; }
    if (tid == 63) tot[0] = v;
  }
  __syncthreads();
  if (tid < 128) {
    if (tid >= 64) v += tot[0];
    acs[tid] = v; dts[tid] = d;
  }
  __syncthreads();
}

DI void phase_o_states(const Params& p, int i, char* smem) {
  const int tid = otid(), lane = tid & 63, w = tid >> 6, fr = lane & 15, fq = lane >> 4;
  float* acs = (float*)smem; float* dts = acs + 128; float* wgt = dts + 128; float* tot = wgt + 128;
  const float* DT = (const float*)(p.ws + WS_DT);
  const u16* XST = (const u16*)(p.ws + WS_XST); const u16* BMT = (const u16*)(p.ws + WS_BMT);
  float* ST = (float*)(p.ws + WS_ST); float* DEC = (float*)(p.ws + WS_DEC);
  for (int it = obid(); it < 4096; it += gridDim.x) {
    const int h = it & 31, chunk = (it >> 5) & 15, b = it >> 9, g = h >> 3;
    const float a = -expf(p.in[24][i * 32 + h]);
    const size_t tok0 = (size_t)b * 2048 + chunk * 128;
    chunk_scan(DT, tok0, h, a, acs, dts, tot);
    const float lastv = acs[127];
    if (tid < 128) wgt[tid] = __expf(lastv - acs[tid]) * dts[tid];
    if (tid == 0) DEC[((size_t)b * 16 + chunk) * 32 + h] = __expf(lastv);
    __syncthreads();
    const size_t bc = (size_t)b * 16 + chunk;
    f32x4 acc[4][2];
#pragma unroll
    for (int pt = 0; pt < 4; ++pt) { acc[pt][0] = f32x4{0.f, 0.f, 0.f, 0.f}; acc[pt][1] = f32x4{0.f, 0.f, 0.f, 0.f}; }
#pragma unroll
    for (int ks = 0; ks < 4; ++ks) {
      const int s0 = ks * 32 + fq * 8;
      const float4 wa = *(const float4*)(wgt + s0), wb = *(const float4*)(wgt + s0 + 4);
      bf16x8 bmf[2];
#pragma unroll
      for (int nt = 0; nt < 2; ++nt) bmf[nt] = *(const bf16x8*)(BMT + ((bc * 512 + g * 128 + 32 * w + nt * 16 + fr) * 128 + s0));
#pragma unroll
      for (int pt = 0; pt < 4; ++pt) {
        uint4 xr = *(const uint4*)(XST + ((bc * 2048 + h * 64 + pt * 16 + fr) * 128 + s0));
        uint4 xw;
        xw.x = pack2(lo2f(xr.x) * wa.x, hi2f(xr.x) * wa.y); xw.y = pack2(lo2f(xr.y) * wa.z, hi2f(xr.y) * wa.w);
        xw.z = pack2(lo2f(xr.z) * wb.x, hi2f(xr.z) * wb.y); xw.w = pack2(lo2f(xr.w) * wb.z, hi2f(xr.w) * wb.w);
        const bf16x8 xf = mk8(xw);
        acc[pt][0] = mfma16(bmf[0], xf, acc[pt][0]);
        acc[pt][1] = mfma16(bmf[1], xf, acc[pt][1]);
      }
    }
#pragma unroll
    for (int pt = 0; pt < 4; ++pt)
#pragma unroll
      for (int nt = 0; nt < 2; ++nt)
        *(float4*)(ST + (((bc * 32 + h) * 64 + pt * 16 + fr) * 128 + 32 * w + nt * 16 + fq * 4)) = float4{acc[pt][nt][0], acc[pt][nt][1], acc[pt][nt][2], acc[pt][nt][3]};
  }
}

DI void phase_o_scan(const Params& p, int i) {
  const size_t gtid = (size_t)obid() * 256 + otid(), gsz = (size_t)gridDim.x * 256;
  const float* ST = (const float*)(p.ws + WS_ST); const float* DEC = (const float*)(p.ws + WS_DEC);
  u16* SINB = (u16*)(p.ws + WS_SINB);
  for (size_t e = gtid; e < (size_t)524288; e += gsz) {
    const int n4 = (int)(e & 31), pp = (int)((e >> 5) & 63), h = (int)((e >> 11) & 31), b = (int)(e >> 16);
    float4 carry = float4{0.f, 0.f, 0.f, 0.f};
    for (int c = 0; c < 16; ++c) {
      const size_t ad = ((((size_t)b * 16 + c) * 32 + h) * 64 + pp) * 128 + n4 * 4;
      const float dec = DEC[((size_t)b * 16 + c) * 32 + h];
      const float4 tmp = *(const float4*)(ST + ad);
      st_bf4(SINB + ad, carry.x, carry.y, carry.z, carry.w);
      carry = float4{dec * carry.x + tmp.x, dec * carry.y + tmp.y, dec * carry.z + tmp.z, dec * carry.w + tmp.w};
    }
    *(float4*)(p.out + O_PSSD + ((((size_t)i * 8 + b) * 32 + h) * 64 + pp) * 128 + n4 * 4) = carry;
  }
}

constexpr int OY_XT = 8192;
constexpr int OY_XTS = 144;
constexpr int OY_S = OY_XT + 64 * OY_XTS * 2;
constexpr int OY_SS = 136;
constexpr int OY_CB = OY_S + 64 * OY_SS * 2;
DI void phase_o_y(const Params& p, int i, char* smem) {
  const int tid = otid(), lane = tid & 63, w = tid >> 6, fr = lane & 15, fq = lane >> 4;
  float* acs = (float*)smem;
  float* dts = acs + 1024;
  u16* XT = (u16*)(smem + OY_XT);
  u16* Ssm = (u16*)(smem + OY_S);
  float* tot = (float*)smem;
  uint2* CBs = (uint2*)(smem + OY_CB) + w * 512;
  const float* DT = (const float*)(p.ws + WS_DT);
  const u16* XST = (const u16*)(p.ws + WS_XST); const u16* XS = (const u16*)(p.ws + WS_XS);
  const u16* BM = (const u16*)(p.ws + WS_BM); const u16* CM = (const u16*)(p.ws + WS_CM); const u16* Z = (const u16*)(p.ws + WS_Z);
  const u16* SINB = (const u16*)(p.ws + WS_SINB);
  u16* YG = (u16*)(p.ws + WS_YG); float* SSQ = (float*)(p.ws + WS_SSQ);
  for (int it = obid(); it < 512; it += gridDim.x) {
    {
      const int g = it & 3, chunk = (it >> 2) & 15, b = it >> 6;
      const size_t tok0 = (size_t)b * 2048 + chunk * 128;
      const size_t bc = (size_t)b * 16 + chunk;
      __syncthreads();
      {
        const int hh = tid >> 5, j = tid & 31, h = g * 8 + hh;
        const float a = -expf(p.in[24][i * 32 + h]);
        float d[4], v[4];
#pragma unroll
        for (int k = 0; k < 4; ++k) { d[k] = DT[(tok0 + 4 * j + k) * 32 + h]; v[k] = d[k] * a; }
        v[1] += v[0]; v[2] += v[1]; v[3] += v[2];
        float run = v[3];
#pragma unroll
        for (int o = 1; o < 32; o <<= 1) { const float n = __shfl_up(run, o, 32); if (j >= o) run += n; }
        const float off = run - v[3];
#pragma unroll
        for (int k = 0; k < 4; ++k) { acs[hh * 128 + 4 * j + k] = v[k] + off; dts[hh * 128 + 4 * j + k] = d[k]; }
      }
      const int ttA = w, ttB = 7 - w;
      bf16x8 cmfA[4], cmfB[4];
#pragma unroll
      for (int ks = 0; ks < 4; ++ks) {
        cmfA[ks] = *(const bf16x8*)(CM + (tok0 + ttA * 16 + fr) * 512 + g * 128 + ks * 32 + fq * 8);
        cmfB[ks] = *(const bf16x8*)(CM + (tok0 + ttB * 16 + fr) * 512 + g * 128 + ks * 32 + fq * 8);
      }
      uint2 cbA[4];
#pragma unroll
      for (int st = 0; st < 8; ++st) {
        f32x4 ca = f32x4{0.f, 0.f, 0.f, 0.f}, cbv = f32x4{0.f, 0.f, 0.f, 0.f};
        if (st <= ttB) {
#pragma unroll
          for (int ks = 0; ks < 4; ++ks) {
            const bf16x8 bmf = *(const bf16x8*)(BM + (tok0 + st * 16 + fr) * 512 + g * 128 + ks * 32 + fq * 8);
            cbv = mfma16(bmf, cmfB[ks], cbv);
            if (st < 4 && st <= ttA) ca = mfma16(bmf, cmfA[ks], ca);
          }
        }
        CBs[st * 64 + lane] = uint2{pack2(cbv[0], cbv[1]), pack2(cbv[2], cbv[3])};
        if (st < 4) cbA[st] = uint2{pack2(ca[0], ca[1]), pack2(ca[2], ca[3])};
        if (st & 1) __builtin_amdgcn_sched_barrier(0);
      }
      u32x4 px[4], ps[4];
      {
        const u16* xsrc = XST + (bc * 2048 + (size_t)(g * 8) * 64) * 128;
        const u16* ssrc = SINB + ((bc * 32 + g * 8) * 64) * 128;
#pragma unroll
        for (int k = 0; k < 4; ++k) { px[k] = *(const u32x4*)(xsrc + (size_t)(tid + 256 * k) * 8); ps[k] = *(const u32x4*)(ssrc + (size_t)(tid + 256 * k) * 8); }
      }
#pragma unroll 1
      for (int hh = 0; hh < 8; ++hh) {
        const int h = g * 8 + hh;
        const float Dh = p.in[25][i * 32 + h];
        __syncthreads();
#pragma unroll
        for (int k = 0; k < 4; ++k) { const int e = (tid + 256 * k) * 8; *(u32x4*)(XT + (e >> 7) * OY_XTS + (e & 127)) = px[k]; *(u32x4*)(Ssm + (e >> 7) * OY_SS + (e & 127)) = ps[k]; }
        __syncthreads();
        if (hh < 7) {
          const u16* xsrc = XST + (bc * 2048 + (size_t)(h + 1) * 64) * 128;
          const u16* ssrc = SINB + ((bc * 32 + h + 1) * 64) * 128;
#pragma unroll
          for (int k = 0; k < 4; ++k) { px[k] = *(const u32x4*)(xsrc + (size_t)(tid + 256 * k) * 8); ps[k] = *(const u32x4*)(ssrc + (size_t)(tid + 256 * k) * 8); }
        }
        const float* ah = acs + hh * 128; const float* dh = dts + hh * 128;
#pragma unroll
        for (int q = 0; q < 2; ++q) {
          const int tt = q == 0 ? ttA : ttB;
          const int tl = tt * 16 + fr;
          f32x4 acc[4];
#pragma unroll
          for (int pt = 0; pt < 4; ++pt) acc[pt] = f32x4{0.f, 0.f, 0.f, 0.f};
#pragma unroll
          for (int ks = 0; ks < 4; ++ks)
#pragma unroll
            for (int pt = 0; pt < 4; ++pt) {
              const bf16x8 sf = *(const bf16x8*)(Ssm + (pt * 16 + fr) * OY_SS + ks * 32 + fq * 8);
              acc[pt] = mfma16(sf, q == 0 ? cmfA[ks] : cmfB[ks], acc[pt]);
              if (pt == 3) __builtin_amdgcn_sched_barrier(0);
            }
          const float at = ah[tl];
          const float ea = __expf(at);
#pragma unroll
          for (int pt = 0; pt < 4; ++pt) { acc[pt][0] *= ea; acc[pt][1] *= ea; acc[pt][2] *= ea; acc[pt][3] *= ea; }
#pragma unroll
          for (int sp = 0; sp < (q == 0 ? 2 : 4); ++sp) {
            if (2 * sp <= tt) {
              uint4 mk;
#pragma unroll
              for (int half = 0; half < 2; ++half) {
                const int st = 2 * sp + half;
                const uint2 cbp = q == 0 ? cbA[st < 4 ? st : 0] : CBs[st * 64 + lane];
                const float cb[4] = {lo2f(cbp.x), hi2f(cbp.x), lo2f(cbp.y), hi2f(cbp.y)};
                float mv[4];
#pragma unroll
                for (int j = 0; j < 4; ++j) {
                  const int sl = st * 16 + fq * 4 + j;
                  float m = 0.f;
                  if (sl <= tl) m = cb[j] * __expf(at - ah[sl]) * dh[sl];
                  mv[j] = m;
                }
                if (half == 0) { mk.x = pack2(mv[0], mv[1]); mk.y = pack2(mv[2], mv[3]); }
                else { mk.z = pack2(mv[0], mv[1]); mk.w = pack2(mv[2], mv[3]); }
                __builtin_amdgcn_sched_barrier(0);
              }
              const bf16x8 mf = mk8(mk);
#pragma unroll
              for (int pt = 0; pt < 4; ++pt) {
                const u16* xr = XT + (pt * 16 + fr) * OY_XTS;
                const uint2 xa = *(const uint2*)(xr + (2 * sp) * 16 + fq * 4), xb = *(const uint2*)(xr + (2 * sp + 1) * 16 + fq * 4);
                acc[pt] = mfma16(mk8(uint4{xa.x, xa.y, xb.x, xb.y}), mf, acc[pt]);
              }
              __builtin_amdgcn_sched_barrier(0);
            }
          }
          __builtin_amdgcn_sched_barrier(0);
          const size_t tok = tok0 + tl;
          float ss = 0.f;
#pragma unroll
          for (int pt = 0; pt < 4; ++pt) {
            const int col = h * 64 + pt * 16 + fq * 4;
            uint2 xv = *(const uint2*)(XS + tok * 2048 + col), zv = *(const uint2*)(Z + tok * 2048 + col);
            float y0 = (acc[pt][0] + Dh * lo2f(xv.x)) * siluf_(lo2f(zv.x));
            float y1 = (acc[pt][1] + Dh * hi2f(xv.x)) * siluf_(hi2f(zv.x));
            float y2 = (acc[pt][2] + Dh * lo2f(xv.y)) * siluf_(lo2f(zv.y));
            float y3 = (acc[pt][3] + Dh * hi2f(xv.y)) * siluf_(hi2f(zv.y));
            st_bf4(YG + tok * 2048 + col, y0, y1, y2, y3);
            ss += y0 * y0 + y1 * y1 + y2 * y2 + y3 * y3;
          }
          ss += __shfl_xor(ss, 16); ss += __shfl_xor(ss, 32);
          if (fq == 0) SSQ[tok * 32 + h] = ss;
          __builtin_amdgcn_sched_barrier(0);
        }
      }
    }
  }
  __syncthreads();
  for (int it = obid(); it < 4096; it += gridDim.x) {
    {
      const int r = it, h = r & 31, s = r >> 5, g = h >> 3;
      const float a = -expf(p.in[24][i * 32 + h]);
      const float Dh = p.in[25][i * 32 + h];
      const size_t tok = (size_t)TP + s;
      const int pp = tid >> 2, nq = tid & 3;
      const float dtv = DT[tok * 32 + h];
      const float dA = __expf(dtv * a);
      const float xv = bf2f(XS[tok * 2048 + h * 64 + pp]);
      const size_t ad = ((((size_t)i * 128 + s) * 32 + h) * 64 + pp) * 128 + nq * 32;
      const float dx = dtv * xv;
      float yp = 0.f;
#pragma unroll
      for (int k = 0; k < 8; ++k) {
        float4 s0 = *(const float4*)(p.in[6] + ad + 4 * k);
        uint2 bv = *(const uint2*)(BM + tok * 512 + g * 128 + nq * 32 + 4 * k), cv = *(const uint2*)(CM + tok * 512 + g * 128 + nq * 32 + 4 * k);
        float4 nw = float4{dA * s0.x + dx * lo2f(bv.x), dA * s0.y + dx * hi2f(bv.x), dA * s0.z + dx * lo2f(bv.y), dA * s0.w + dx * hi2f(bv.y)};
        *(float4*)(p.out + O_SSSD + ad + 4 * k) = nw;
        yp += nw.x * lo2f(cv.x) + nw.y * hi2f(cv.x) + nw.z * lo2f(cv.y) + nw.w * hi2f(cv.y);
      }
      yp += __shfl_xor(yp, 1); yp += __shfl_xor(yp, 2);
      const float yg = (yp + Dh * xv) * siluf_(bf2f(Z[tok * 2048 + h * 64 + pp]));
      float ss = 0.f;
      if (nq == 0) { YG[tok * 2048 + h * 64 + pp] = f2bf(yg); ss = yg * yg; }
#pragma unroll
      for (int o = 32; o > 0; o >>= 1) ss += __shfl_xor(ss, o);
      __syncthreads();
      if (lane == 0) tot[w] = ss;
      __syncthreads();
      if (tid == 0) SSQ[tok * 32 + h] = (tot[0] + tot[1]) + (tot[2] + tot[3]);
    }
  }
}

constexpr int SMEM_BYTES = 61440;
#ifndef PROBE_ID
#define PROBE_ID 0
#endif
#define TIMED(id, ...) { long long t0_ = 0; if (PROBE_ID == (id)) t0_ = wall_clock64(); __VA_ARGS__; if (PROBE_ID == (id)) tacc += wall_clock64() - t0_; }
__global__ void __launch_bounds__(256, 2) mega_kernel(Params p) {
  __shared__ __attribute__((aligned(16))) char smem[SMEM_BYTES];
  __shared__ uint4 xb_words;
  if (threadIdx.x == 0) xb_words = make_uint4(0u, 0u, 0u, 0u);
  __syncthreads();
  XcdBarrier bar = xcd_barrier_post((unsigned*)(p.ws + WS_BAR), (volatile LAS unsigned*)&xb_words);
  long long tacc = 0;
  TIMED(1, phase_prep(p, smem); xcd_barrier(bar); if (p.ws == nullptr) cg::this_grid().sync();)
  for (int layer = 0; layer < 4; ++layer) {
    const int i = layer >> 1;
    if ((layer & 1) == 0) {
      TIMED(2, convert_tables(p, layer); phase_e_inproj(p, i, smem); xcd_barrier(bar);)
      TIMED(3,
        s5_pass1(p, i, smem);
        __syncthreads();
        swa_prompt(p, i, smem);
        __syncthreads();
        swa_sample(p, i, smem);
        xcd_barrier(bar);
        s5_pass3(p, i, smem);
        xcd_barrier(bar);
        phase_e_glu(p, i, smem);
        xcd_barrier(bar);)
      TIMED(4, phase_outproj(p, (const u16*)(p.ws + WS_CAT), 1024, (const u16*)(p.ws + WS_WOUTE) + (size_t)i * 1024 * 1024, false, smem);
        xcd_barrier(bar);)
    } else {
      TIMED(2, convert_tables(p, layer); phase_o_inproj(p, i, smem); xcd_barrier(bar);)
      TIMED(51, phase_o_conv(p, i, smem); xcd_barrier(bar);)
      TIMED(52, phase_o_states(p, i, smem); xcd_barrier(bar);)
      TIMED(53, phase_o_scan(p, i); xcd_barrier(bar);)
      TIMED(54, phase_o_y(p, i, smem); xcd_barrier(bar);)
      TIMED(4, phase_outproj(p, (const u16*)(p.ws + WS_YG), 2048, (const u16*)(p.ws + WS_WOUTO) + (size_t)i * 1024 * 2048, true, smem);
        xcd_barrier(bar);)
    }
    TIMED(4, phase_ln1(p, layer); xcd_barrier(bar);)
    TIMED(6, phase_peer1(p, layer, smem); xcd_barrier(bar);)
    TIMED(71, phase_peer3u(p, layer); xcd_barrier(bar);)
    TIMED(72, phase_peer3v(p, layer); xcd_barrier(bar);)
    TIMED(73, phase_peer3n(p, layer); xcd_barrier(bar);)
  }
  if (PROBE_ID != 0 && blockIdx.x == 0 && threadIdx.x == 0) {
    const long long t0 = wall_clock64();
    while (wall_clock64() - t0 < tacc) __builtin_amdgcn_s_sleep(8);
  }
}

extern "C" void kernel_launch(void* const* d_in, const int* in_sizes, int n_in, void* d_out, int out_size, void* d_ws,
                              size_t ws_size, hipStream_t stream) {
  static int grid_blocks = 0;
  if (!grid_blocks) {
    int dev = 0, cus = 0, per_cu = 0;
    hipGetDevice(&dev);
    hipDeviceGetAttribute(&cus, hipDeviceAttributeMultiprocessorCount, dev);
    hipOccupancyMaxActiveBlocksPerMultiprocessor(&per_cu, mega_kernel, 256, 0);
    if (per_cu > 2) per_cu = 2;
    if (per_cu < 1) per_cu = 1;
    grid_blocks = cus * per_cu;
  }
  if (ws_size < WS_END) { fprintf(stderr, "workspace too small: %zu < %zu\n", ws_size, (size_t)WS_END); return; }
  Params p{};
  for (int k = 0; k < 37; ++k) p.in[k] = (const float*)d_in[k];
  p.out = (float*)d_out;
  p.ws = (char*)d_ws;
  hipMemsetAsync((char*)d_ws + WS_BAR, 0, 16384, stream);
  void* args[] = {&p};
  hipError_t e = hipLaunchCooperativeKernel((void*)mega_kernel, dim3(grid_blocks), dim3(256), args, 0, stream);
  if (e != hipSuccess) fprintf(stderr, "cooperative launch failed: %s (grid %d)\n", hipGetErrorString(e), grid_blocks);
}
```
